# Optimizing an MI355X kernel written in HIP

```python
import jax, jax.numpy as jnp
from jax import lax
import numpy as np

D_MODEL = 2048
BATCH = 8
SEQ = 2048
DEPTH = 4

CHUNK = 64
D_MIX = D_MODEL
HEAD_DIM = 128
W_ATTN = D_MIX // 2
H_ATTN = W_ATTN // HEAD_DIM
W_RET = D_MIX - W_ATTN
H_RET = W_RET // HEAD_DIM
LEFT_CHUNKS = 8
BAND = (LEFT_CHUNKS + 1) * CHUNK
REL_CLIP = 128
N_REL = 2 * REL_CLIP + 1
ROPE_BASE = 10000.0
IN_COLS = 3 * W_ATTN + 4 * W_RET
PEER_HEADS = 8
PEER_DQ = 256
N_KEYS = 128
N_EXPERTS = N_KEYS * N_KEYS
PEER_TOPK = 16
PEER_TOKEN_BLOCK = 128
EPS = 1e-6
NEG_INF = -1e30

kernel_name = "hybrid_chunkattn_retention_peer"


def rms_norm(x, g):
    xf = x.astype(jnp.float32)
    y = xf * lax.rsqrt(jnp.mean(xf * xf, axis=-1, keepdims=True) + EPS)
    return (y * g.astype(jnp.float32)).astype(x.dtype)


def split_heads(t, n_heads):
    b, s, _ = t.shape
    return t.reshape(b, s, n_heads, HEAD_DIM).transpose(0, 2, 1, 3)


def merge_heads(t):
    b, h, s, d = t.shape
    return t.transpose(0, 2, 1, 3).reshape(b, s, h * d)


def rotary(x, pos):
    half = x.shape[-1] // 2
    inv_freq = ROPE_BASE ** (-jnp.arange(half, dtype=jnp.float32) / half)
    ang = pos.astype(jnp.float32)[:, None] * inv_freq[None, :]
    cos, sin = jnp.cos(ang), jnp.sin(ang)
    xf = x.astype(jnp.float32)
    x1, x2 = xf[..., :half], xf[..., half:]
    return jnp.concatenate([x1 * cos - x2 * sin, x2 * cos + x1 * sin], axis=-1).astype(x.dtype)


def chunked_rel_attention(q, k, v, rel_bias):
    b, h, s, dh = q.shape
    n_chunks = s // CHUNK
    pad = LEFT_CHUNKS * CHUNK
    k_pad = jnp.pad(k, ((0, 0), (0, 0), (pad, 0), (0, 0)))
    v_pad = jnp.pad(v, ((0, 0), (0, 0), (pad, 0), (0, 0)))
    q_off = jnp.arange(CHUNK)[:, None] + pad
    k_off = jnp.arange(BAND)[None, :]
    rel = jnp.clip(q_off - k_off, -REL_CLIP, REL_CLIP) + REL_CLIP
    bias = rel_bias[:, rel].astype(jnp.float32)
    scale = dh ** -0.5

    def one_chunk(c):
        start = c * CHUNK
        qc = lax.dynamic_slice_in_dim(q, start, CHUNK, axis=2)
        kb = lax.dynamic_slice_in_dim(k_pad, start, BAND, axis=2)
        vb = lax.dynamic_slice_in_dim(v_pad, start, BAND, axis=2)
        sc = jnp.einsum('bhqd,bhkd->bhqk', qc, kb, preferred_element_type=jnp.float32) * scale + bias
        valid = (start + k_off - pad) >= 0
        sc = jnp.where(valid[None, None], sc, NEG_INF)
        p = jax.nn.softmax(sc, axis=-1)
        return jnp.einsum('bhqk,bhkd->bhqd', p.astype(vb.dtype), vb)

    out = lax.map(one_chunk, jnp.arange(n_chunks))
    return out.transpose(1, 2, 0, 3, 4).reshape(b, h, s, dh)


def retention_chunkwise(q, k, v):
    b, h, s, dh = q.shape
    nc = s // CHUNK
    log_gamma = jnp.log1p(-(2.0 ** (-5.0 - jnp.arange(h, dtype=jnp.float32))))
    pos = jnp.arange(CHUNK, dtype=jnp.float32)
    diff = pos[:, None] - pos[None, :]
    decay_intra = jnp.where(diff >= 0, jnp.exp(jnp.maximum(diff, 0.0) * log_gamma[:, None, None]), 0.0)
    q_decay = jnp.exp((pos + 1.0)[None, :] * log_gamma[:, None])
    k_decay = jnp.exp((CHUNK - 1.0 - pos)[None, :] * log_gamma[:, None])
    chunk_decay = jnp.exp(CHUNK * log_gamma)

    qc = q.astype(jnp.float32).reshape(b, h, nc, CHUNK, dh)
    kc = k.astype(jnp.float32).reshape(b, h, nc, CHUNK, dh) * (dh ** -0.5)
    vc = v.astype(jnp.float32).reshape(b, h, nc, CHUNK, dh)

    scores = jnp.einsum('bhnqd,bhnkd->bhnqk', qc, kc) * decay_intra[None, :, None]
    o_intra = jnp.einsum('bhnqk,bhnkd->bhnqd', scores, vc)

    kv = jnp.einsum('bhnkd,bhnke->bhnde', kc * k_decay[None, :, None, :, None], vc)

    def step(state, kv_n):
        return chunk_decay[None, :, None, None] * state + kv_n, state

    state0 = jnp.zeros((b, h, dh, dh), jnp.float32)
    _, states = lax.scan(step, state0, jnp.moveaxis(kv, 2, 0))
    o_cross = jnp.einsum('bhnqd,nbhde->bhnqe', qc * q_decay[None, :, None, :, None], states)
    return (o_intra + o_cross).reshape(b, h, s, dh)


def peer_ffn(h, wq, sub_keys, u_tab, v_tab):
    t = h.shape[0]
    q = (h @ wq).reshape(t, PEER_HEADS, 2, PEER_DQ // 2)
    s = jnp.einsum('thpd,hpkd->thpk', q, sub_keys, preferred_element_type=jnp.float32)
    s_top, i_top = lax.top_k(s, PEER_TOPK)
    cand = (s_top[:, :, 0, :, None] + s_top[:, :, 1, None, :]).reshape(t, PEER_HEADS, PEER_TOPK * PEER_TOPK)
    g_top, c_idx = lax.top_k(cand, PEER_TOPK)
    i1 = jnp.take_along_axis(i_top[:, :, 0], c_idx // PEER_TOPK, axis=-1)
    i2 = jnp.take_along_axis(i_top[:, :, 1], c_idx % PEER_TOPK, axis=-1)
    n_sel = PEER_HEADS * PEER_TOPK
    experts = (i1 * N_KEYS + i2).reshape(t, n_sel)
    gates = jax.nn.softmax(g_top, axis=-1).reshape(t, n_sel)

    nb = t // PEER_TOKEN_BLOCK

    def block(args):
        hb, eb, gb = args
        u = u_tab[eb]
        v = v_tab[eb]
        a = jax.nn.gelu(jnp.einsum('td,ted->te', hb, u, preferred_element_type=jnp.float32), approximate=False)
        return jnp.einsum('te,ted->td', (gb * a).astype(v.dtype), v)

    out = lax.map(block, (h.reshape(nb, PEER_TOKEN_BLOCK, -1),
                          experts.reshape(nb, PEER_TOKEN_BLOCK, n_sel),
                          gates.reshape(nb, PEER_TOKEN_BLOCK, n_sel)))
    return out.reshape(t, -1)


def hybrid_layer(x, norm1_g, w_in, qa_g, ka_g, rel_bias, attn_g, ret_g, w_out,
                 norm2_g, peer_wq, peer_keys, peer_u, peer_v):
    b, s, d = x.shape
    hn = rms_norm(x, norm1_g)
    proj = hn @ w_in
    qa, ka, va, qr, kr, vr, gr = jnp.split(
        proj, [W_ATTN, 2 * W_ATTN, 3 * W_ATTN, 3 * W_ATTN + W_RET,
               3 * W_ATTN + 2 * W_RET, 3 * W_ATTN + 3 * W_RET], axis=-1)

    qa = rms_norm(split_heads(qa, H_ATTN), qa_g)
    ka = rms_norm(split_heads(ka, H_ATTN), ka_g)
    oa = chunked_rel_attention(qa, ka, split_heads(va, H_ATTN), rel_bias)
    oa = merge_heads(rms_norm(oa, attn_g.reshape(H_ATTN, 1, HEAD_DIM)))

    pos = jnp.arange(s)
    qr = rotary(split_heads(qr, H_RET), pos)
    kr = rotary(split_heads(kr, H_RET), pos)
    orr = retention_chunkwise(qr, kr, split_heads(vr, H_RET))
    orr = merge_heads(rms_norm(orr, ret_g.reshape(H_RET, 1, HEAD_DIM))).astype(x.dtype)
    orr = jax.nn.silu(gr) * orr

    x = x + jnp.concatenate([oa, orr], axis=-1) @ w_out

    h2 = rms_norm(x, norm2_g).reshape(b * s, d)
    x = x + peer_ffn(h2, peer_wq, peer_keys, peer_u, peer_v).reshape(b, s, d)
    return x


def setup_inputs(seed: int = 0) -> dict:
    key = jax.random.key(seed)
    ks = jax.random.split(key, 15)

    def nrm(k, shape, scale):
        return jax.random.normal(k, shape, jnp.float32) * scale

    def gain(k, shape):
        return 1.0 + 0.01 * jax.random.normal(k, shape, jnp.float32)

    return {
        "x": nrm(ks[0], (BATCH, SEQ, D_MODEL), 1.0),
        "norm1_g": gain(ks[1], (DEPTH, D_MODEL)),
        "w_in": nrm(ks[2], (DEPTH, D_MODEL, IN_COLS), D_MODEL ** -0.5),
        "qa_norm_g": gain(ks[3], (DEPTH, HEAD_DIM)),
        "ka_norm_g": gain(ks[4], (DEPTH, HEAD_DIM)),
        "rel_bias": nrm(ks[5], (DEPTH, H_ATTN, N_REL), 0.1),
        "attn_out_g": gain(ks[6], (DEPTH, W_ATTN)),
        "ret_out_g": gain(ks[7], (DEPTH, W_RET)),
        "w_out": nrm(ks[8], (DEPTH, D_MIX, D_MODEL), D_MIX ** -0.5),
        "norm2_g": gain(ks[9], (DEPTH, D_MODEL)),
        "peer_wq": nrm(ks[10], (DEPTH, D_MODEL, PEER_HEADS * PEER_DQ), D_MODEL ** -0.5),
        "peer_subkeys": nrm(ks[11], (DEPTH, PEER_HEADS, 2, N_KEYS, PEER_DQ // 2), (PEER_DQ // 2) ** -0.5),
        "peer_u": nrm(ks[12], (DEPTH, N_EXPERTS, D_MODEL), D_MODEL ** -0.5),
        "peer_v": nrm(ks[13], (DEPTH, N_EXPERTS, D_MODEL), 0.5 * PEER_HEADS ** -0.5),
    }


def reference(x, norm1_g, w_in, qa_norm_g, ka_norm_g, rel_bias, attn_out_g, ret_out_g,
              w_out, norm2_g, peer_wq, peer_subkeys, peer_u, peer_v):
    for l in range(DEPTH):
        x = hybrid_layer(x, norm1_g[l], w_in[l], qa_norm_g[l], ka_norm_g[l], rel_bias[l],
                         attn_out_g[l], ret_out_g[l], w_out[l], norm2_g[l],
                         peer_wq[l], peer_subkeys[l], peer_u[l], peer_v[l])
    return x
```

```cpp
#include <hip/hip_runtime.h>
#include <cstdio>
#include <cstdint>

#ifndef MK_ONE_LAUNCH
#define MK_ONE_LAUNCH 1
#endif

namespace pg8 {
#define PG8_LAS __attribute__((address_space(3)))
typedef unsigned short bf16_t;
typedef short bf16x8 __attribute__((ext_vector_type(8)));
typedef float f32x4 __attribute__((ext_vector_type(4)));
typedef unsigned u32x4 __attribute__((ext_vector_type(4)));
constexpr int BM = 256, BK = 64, HALF = 128, HTB = HALF * BK * 2  , STAGE_BYTES = 8 * HTB, NXCD = 8, WGM = 8;

__host__ __device__ __forceinline__ int lds_byte(int r, int c) { const int st = (r >> 4) * 2 + (c >> 5), rr = r & 15, cc = c & 31, ob = rr * 64 + cc * 2; return st * 1024 + (ob ^ (((ob >> 9) & 1) << 5)); }
__host__ __device__ __forceinline__ void stage_rc(int b, int& R, int& C) { const int st = b / 1024, sb = b % 1024, swz = sb ^ (((sb >> 9) & 1) << 5); R = (st >> 1) * 16 + swz / 64; C = (st & 1) * 32 + (swz % 64) / 2; }
__host__ __device__ __forceinline__ int perm32(int rho) { const int n = rho >> 4, i = rho & 15; return 8 * (i >> 2) + 4 * n + (i & 3); }

struct Unit { int pm, pn; };
struct Gemm { const bf16_t* A; const bf16_t* Bt; int M, N, K; };

struct StaticOrder {
    int nM, nN, nwg, G, c;
    __host__ __device__ void init(int M, int N, int G_, int c_) { nM = M / BM; nN = N / BM; nwg = nM * nN; G = G_; c = c_; }
    __host__ __device__ bool next(int i, Unit& u) const {
        const long L = (long)i * G + c; if (L >= nwg) return false;
        int wgid = (int)L; { const int q = nwg / NXCD, r = nwg % NXCD, xcd = wgid % NXCD, off = wgid / NXCD; wgid = (xcd < r ? xcd * (q + 1) : r * (q + 1) + (xcd - r) * q) + off; }
        const int nig = WGM * nN, gid = wgid / nig, fm = gid * WGM, gsz = (nM - fm) < WGM ? (nM - fm) : WGM;
        u.pm = fm + ((wgid % nig) % gsz); u.pn = (wgid % nig) / gsz; return true;
    }
    __device__ __forceinline__ void a_ready(const Unit&) const {}
    __device__ __forceinline__ void done(const Unit&) const {}
};
__device__ __forceinline__ unsigned cvt_pk_bf16(float lo, float hi) { unsigned r; asm volatile("v_cvt_pk_bf16_f32 %0, %1, %2" : "=v"(r) : "v"(lo), "v"(hi)); return r; }

typedef float f32x2 __attribute__((ext_vector_type(2)));
constexpr int MT = 16384, MS = 2048;
constexpr int TOKC = 5120;
constexpr int TOKP = 5248, SWPP = 16512, QPP = 2176;
constexpr float KSCALE = 0.08838834764831845f;
__device__ __forceinline__ float lg2gamma(int h) {
    return h == 0 ? -0.04580368961312479f : h == 1 ? -0.02272007650008353f : h == 2 ? -0.011315313227834146f : h == 3 ? -0.005646563141142063f :
           h == 4 ? -0.0028205190623786626f : h == 5 ? -0.0014095702546713536f : h == 6 ? -0.0007046129765893727f : -0.0003522634716290214f;
}

struct EpiTok {
    static constexpr bool PERM = true, AFTER_DRAIN = false;
    bf16_t* O; const f32x2* cs; float* ssq;
    __device__ __forceinline__ void operator()(const f32x4 (&acc)[2][2][4][2], const Unit& u, int wr, int wc, int fr, int fq) const {
        const int row0 = u.pm * BM + wr * 64 + fr, kind = u.pn >> 2;
#pragma unroll
        for (int ai = 0; ai < 2; ++ai)
#pragma unroll
            for (int m = 0; m < 4; ++m) {
                const int row = row0 + ai * HALF + m * 16, pos = row & (MS - 1);
#pragma unroll
                for (int bj = 0; bj < 2; ++bj) {
                    const int c0 = u.pn * BM + bj * HALF + wc * 32 + 8 * fq;
                    f32x4 v0 = acc[ai][bj][m][0], v1 = acc[ai][bj][m][1];
                    if (kind <= 1) {
                        float s = (v0[0] * v0[0] + v0[1] * v0[1]) + (v0[2] * v0[2] + v0[3] * v0[3]) + (v1[0] * v1[0] + v1[1] * v1[1]) + (v1[2] * v1[2] + v1[3] * v1[3]);
                        s += __shfl_xor(s, 16); s += __shfl_xor(s, 32);
                        const int head = (u.pn & 3) * 2 + bj;
                        if (fq == 0) ssq[(size_t)((kind * 8 + head) * 4 + wc) * MT + row] = s;
                    } else if (kind <= 3) {
                        const int i0 = (c0 & 127) >> 1;
                        const f32x4 csa = *(const f32x4*)(cs + (size_t)pos * 64 + i0), csb = *(const f32x4*)(cs + (size_t)pos * 64 + i0 + 2);
                        const float sc = (kind == 3) ? KSCALE : 1.0f;
                        f32x4 w0, w1;
                        w0[0] = (v0[0] * csa[0] - v0[1] * csa[1]) * sc; w0[1] = (v0[1] * csa[0] + v0[0] * csa[1]) * sc;
                        w0[2] = (v0[2] * csa[2] - v0[3] * csa[3]) * sc; w0[3] = (v0[3] * csa[2] + v0[2] * csa[3]) * sc;
                        w1[0] = (v1[0] * csb[0] - v1[1] * csb[1]) * sc; w1[1] = (v1[1] * csb[0] + v1[0] * csb[1]) * sc;
                        w1[2] = (v1[2] * csb[2] - v1[3] * csb[3]) * sc; w1[3] = (v1[3] * csb[2] + v1[2] * csb[3]) * sc;
                        v0 = w0; v1 = w1;
                    } else {
#pragma unroll
                        for (int j = 0; j < 4; ++j) { v0[j] = v0[j] * __builtin_amdgcn_rcpf(1.0f + __builtin_amdgcn_exp2f(-1.4426950408889634f * v0[j]));
                                                      v1[j] = v1[j] * __builtin_amdgcn_rcpf(1.0f + __builtin_amdgcn_exp2f(-1.4426950408889634f * v1[j])); }
                    }
                    u32x4 w; w.x = cvt_pk_bf16(v0[0], v0[1]); w.y = cvt_pk_bf16(v0[2], v0[3]); w.z = cvt_pk_bf16(v1[0], v1[1]); w.w = cvt_pk_bf16(v1[2], v1[3]);
                    *(u32x4*)(O + (size_t)row * TOKP + c0) = w;
                }
            }
    }
};
struct EpiRes {
    static constexpr bool PERM = false, AFTER_DRAIN = false;
    const float* R32; const bf16_t* R16; bf16_t* XB; float* ss2;
    __device__ __forceinline__ void operator()(const f32x4 (&acc)[2][2][4][2], const Unit& u, int wr, int wc, int fr, int fq) const {
        const int row0 = u.pm * BM + wr * 64 + fr, col0 = u.pn * BM + wc * 32 + 4 * fq;
#pragma unroll
        for (int ai = 0; ai < 2; ++ai)
#pragma unroll
            for (int m = 0; m < 4; ++m) { const int row = row0 + ai * HALF + m * 16; const size_t ro = (size_t)row * 2048 + col0;
                float s = 0.f;
#pragma unroll
                for (int bj = 0; bj < 2; ++bj)
#pragma unroll
                    for (int n = 0; n < 2; ++n) { f32x4 r;
                        if (R32) r = *(const f32x4*)(R32 + ro + bj * HALF + n * 16);
                        else { typedef unsigned u32x2_t __attribute__((ext_vector_type(2))); const u32x2_t rw = *(const u32x2_t*)(R16 + ro + bj * HALF + n * 16); const unsigned r0 = rw.x, r1 = rw.y;
                            r = (f32x4){__builtin_bit_cast(float, r0 << 16), __builtin_bit_cast(float, r0 & 0xffff0000u), __builtin_bit_cast(float, r1 << 16), __builtin_bit_cast(float, r1 & 0xffff0000u)}; }
                        const f32x4 v = acc[ai][bj][m][n] + r;
                        typedef unsigned u32x2_s __attribute__((ext_vector_type(2))); u32x2_s w; w.x = cvt_pk_bf16(v[0], v[1]); w.y = cvt_pk_bf16(v[2], v[3]);
                        *(u32x2_s*)(XB + ro + bj * HALF + n * 16) = w;
                        s += (v[0] * v[0] + v[1] * v[1]) + (v[2] * v[2] + v[3] * v[3]); }
                s += __shfl_xor(s, 16); s += __shfl_xor(s, 32);
                if (fq == 0) ss2[(size_t)(u.pn * 4 + wc) * MT + row] = s; }
    }
};
struct EpiB16 {
    static constexpr bool PERM = true, AFTER_DRAIN = false;
    bf16_t* O; int ldc;
    __device__ __forceinline__ void operator()(const f32x4 (&acc)[2][2][4][2], const Unit& u, int wr, int wc, int fr, int fq) const {
        const int row0 = u.pm * BM + wr * 64 + fr, col0 = u.pn * BM + wc * 32 + 8 * fq;
#pragma unroll
        for (int ai = 0; ai < 2; ++ai)
#pragma unroll
            for (int m = 0; m < 4; ++m) { bf16_t* rowp = O + (size_t)(row0 + ai * HALF + m * 16) * ldc + col0;
#pragma unroll
                for (int bj = 0; bj < 2; ++bj) { const f32x4 v0 = acc[ai][bj][m][0], v1 = acc[ai][bj][m][1];
                    u32x4 w; w.x = cvt_pk_bf16(v0[0], v0[1]); w.y = cvt_pk_bf16(v0[2], v0[3]); w.z = cvt_pk_bf16(v1[0], v1[1]); w.w = cvt_pk_bf16(v1[2], v1[3]);
                    *(u32x4*)(rowp + bj * HALF) = w; } }
    }
};
template <class Epi, class Sched, bool ALIGN_EPI = false, bool SP2 = false>
__device__ __forceinline__ void gemm_phase(PG8_LAS unsigned char* lds, const Gemm g, const Sched& S, const Epi& E, int wave_in) {
    int tid_ = wave_in * 64 + (int)__builtin_amdgcn_mbcnt_hi(~0u, __builtin_amdgcn_mbcnt_lo(~0u, 0u)); asm volatile("" : "+v"(tid_));
    const int tid = tid_, wid = __builtin_amdgcn_readfirstlane(tid >> 6), lane = tid & 63, wr = wid >> 2, wc = wid & 3, fr = lane & 15, fq = lane >> 4;
    const int K = g.K, nt = K / BK;
    unsigned voffA[2], voffB[2];
#pragma unroll
    for (int i = 0; i < 2; ++i) { int R, C; stage_rc(tid * 16 + i * 8192, R, C); const int Rb = Epi::PERM ? ((R & ~31) + perm32(R & 31)) : R;
        voffA[i] = (unsigned)(R * K + C) * 2u; voffB[i] = (unsigned)(Rb * K + C) * 2u; }
    const size_t kstep = (size_t)(BK * 2);
    const size_t hstep = (size_t)HALF * K * 2;
    const size_t tstep = 2 * hstep;
    const unsigned ldsw = (unsigned)wid * 1024u;
    const int aoff = lds_byte(wr * 64 + fr, fq * 8), boff = lds_byte(wc * 32 + fr, fq * 8);
#define PG8_SA(b, h) (((b) * 2 + (h)) * HTB)
#define PG8_SB(b, h) ((4 + (b) * 2 + (h)) * HTB)
#define PG8_STAGE(bufoff, gbase, voff) do { _Pragma("unroll") for (int _i = 0; _i < 2; ++_i) \
        __builtin_amdgcn_global_load_lds((const unsigned*)((const char*)(gbase) + (voff)[_i]), (PG8_LAS unsigned*)(lds + (bufoff) + ldsw + _i * 8192), 16, 0, 0); } while (0)
#define PG8_LDA(dst, b, h) do { _Pragma("unroll") for (int m = 0; m < 4; ++m) _Pragma("unroll") for (int k = 0; k < 2; ++k) dst[m][k] = *(const PG8_LAS bf16x8*)(lds + PG8_SA(b, h) + aoff + m * 2048 + k * 1024); } while (0)
#define PG8_LDB(dst, b, h) do { _Pragma("unroll") for (int n = 0; n < 2; ++n) _Pragma("unroll") for (int k = 0; k < 2; ++k) dst[n][k] = *(const PG8_LAS bf16x8*)(lds + PG8_SB(b, h) + boff + n * 2048 + k * 1024); } while (0)
#define PG8_MMA(ai, bj, At, Bt) do { __builtin_amdgcn_s_setprio(1); _Pragma("unroll") for (int m = 0; m < 4; ++m) _Pragma("unroll") for (int n = 0; n < 2; ++n) _Pragma("unroll") for (int k = 0; k < 2; ++k) \
        acc[ai][bj][m][n] = __builtin_amdgcn_mfma_f32_16x16x32_bf16(Bt[n][k], At[m][k], acc[ai][bj][m][n], 0, 0, 0); __builtin_amdgcn_s_setprio(0); } while (0)
#define PG8_WAIT_V(n) asm volatile("s_waitcnt vmcnt(" #n ")" ::: "memory")
#define PG8_WAIT_L(n) asm volatile("s_waitcnt lgkmcnt(" #n ")" ::: "memory")
#define PG8_BAR __builtin_amdgcn_s_barrier()
#define PG8_SCHED __builtin_amdgcn_sched_barrier(0)
    Unit cur, nxt; int ui = 0;
    if (!S.next(0, cur)) return;
    f32x4 acc[2][2][4][2];
#pragma unroll
    for (int a = 0; a < 2; ++a)
#pragma unroll
        for (int b = 0; b < 2; ++b)
#pragma unroll
            for (int m = 0; m < 4; ++m)
#pragma unroll
                for (int n = 0; n < 2; ++n) acc[a][b][m][n] = (f32x4){0.f, 0.f, 0.f, 0.f};
    bf16x8 At[4][2], B0[2][2], B1[2][2];
    const char* cA = (const char*)g.A + (size_t)cur.pm * tstep; const char* cB = (const char*)g.Bt + (size_t)cur.pn * tstep;
    S.a_ready(cur);
    if constexpr (SP2) {
        PG8_STAGE(PG8_SB(0, 0), cB, voffB); PG8_STAGE(PG8_SB(0, 1), cB + hstep, voffB); PG8_STAGE(PG8_SA(0, 0), cA, voffA); PG8_STAGE(PG8_SA(0, 1), cA + hstep, voffA);
        if (wr == 1) PG8_BAR;
        PG8_WAIT_V(2); PG8_BAR;
        PG8_STAGE(PG8_SB(1, 0), cB + kstep, voffB); PG8_STAGE(PG8_SA(1, 0), cA + kstep, voffA); PG8_STAGE(PG8_SB(1, 1), cB + hstep + kstep, voffB);
        PG8_WAIT_V(6); PG8_BAR;
    } else {
        PG8_STAGE(PG8_SB(0, 0), cB, voffB); PG8_STAGE(PG8_SA(0, 0), cA, voffA); PG8_STAGE(PG8_SB(0, 1), cB + hstep, voffB); PG8_STAGE(PG8_SA(0, 1), cA + hstep, voffA);
        if (wr == 1) PG8_BAR;
        PG8_WAIT_V(4); PG8_BAR;
        PG8_STAGE(PG8_SB(1, 0), cB + kstep, voffB); PG8_STAGE(PG8_SA(1, 0), cA + kstep, voffA); PG8_STAGE(PG8_SB(1, 1), cB + hstep + kstep, voffB);
        PG8_WAIT_V(6); PG8_BAR;
    }
    for (;;) {
        const bool has_next = S.next(ui + 1, nxt);
        const char* nA = has_next ? (const char*)g.A + (size_t)nxt.pm * tstep : cA; const char* nB = has_next ? (const char*)g.Bt + (size_t)nxt.pn * tstep : cB;
        for (int t = 0; t < nt; t += 2) {
            const bool last = (t == nt - 2);
            const char* a1 = cA + (size_t)(t + 1) * kstep;
            const char* a2 = last ? nA : cA + (size_t)(t + 2) * kstep; const char* b2 = last ? nB : cB + (size_t)(t + 2) * kstep;
            const char* a3 = a2 + kstep; const char* b3 = b2 + kstep;
            if (last && has_next) S.a_ready(nxt);
            if constexpr (SP2) {
            PG8_LDB(B0, 0, 0); PG8_LDB(B1, 0, 1); PG8_SCHED; PG8_LDA(At, 0, 0); PG8_STAGE(PG8_SA(1, 1), a1 + hstep, voffA);
            PG8_WAIT_V(8); PG8_WAIT_L(0); PG8_BAR; PG8_MMA(0, 0, At, B0); PG8_MMA(0, 1, At, B1); PG8_BAR; PG8_SCHED;
            PG8_LDA(At, 0, 1); PG8_STAGE(PG8_SB(0, 0), b2, voffB); PG8_STAGE(PG8_SB(0, 1), b2 + hstep, voffB); PG8_STAGE(PG8_SA(0, 0), a2, voffA);
            PG8_WAIT_V(8); PG8_WAIT_L(0); PG8_BAR; PG8_MMA(1, 0, At, B0); PG8_MMA(1, 1, At, B1); PG8_BAR; PG8_SCHED;
            PG8_LDB(B0, 1, 0); PG8_LDB(B1, 1, 1); PG8_SCHED; PG8_LDA(At, 1, 0); PG8_STAGE(PG8_SA(0, 1), a2 + hstep, voffA);
            PG8_WAIT_V(8); PG8_WAIT_L(0); PG8_BAR; PG8_MMA(0, 0, At, B0); PG8_MMA(0, 1, At, B1); PG8_BAR; PG8_SCHED;
            PG8_LDA(At, 1, 1); PG8_STAGE(PG8_SB(1, 0), b3, voffB); PG8_STAGE(PG8_SB(1, 1), b3 + hstep, voffB); PG8_STAGE(PG8_SA(1, 0), a3, voffA);
            PG8_WAIT_V(8); PG8_WAIT_L(0); PG8_BAR; PG8_MMA(1, 0, At, B0); PG8_MMA(1, 1, At, B1); PG8_BAR; PG8_SCHED;
            } else {
            PG8_LDB(B0, 0, 0); PG8_SCHED; PG8_LDA(At, 0, 0); PG8_STAGE(PG8_SA(1, 1), a1 + hstep, voffA);
            PG8_WAIT_L(8); PG8_BAR; PG8_WAIT_L(0); PG8_MMA(0, 0, At, B0); PG8_BAR; PG8_SCHED;
            PG8_LDB(B1, 0, 1); PG8_STAGE(PG8_SB(0, 0), b2, voffB);
            PG8_BAR; PG8_WAIT_L(0); PG8_MMA(0, 1, At, B1); PG8_BAR;
            PG8_LDA(At, 0, 1); PG8_STAGE(PG8_SA(0, 0), a2, voffA);
            PG8_BAR; PG8_WAIT_L(0); PG8_MMA(1, 0, At, B0); PG8_BAR; PG8_SCHED;
            PG8_STAGE(PG8_SB(0, 1), b2 + hstep, voffB);
            PG8_WAIT_V(6); PG8_BAR; PG8_MMA(1, 1, At, B1); PG8_BAR;
            PG8_LDB(B0, 1, 0); PG8_SCHED; PG8_LDA(At, 1, 0); PG8_STAGE(PG8_SA(0, 1), a2 + hstep, voffA);
            PG8_WAIT_L(8); PG8_BAR; PG8_WAIT_L(0); PG8_MMA(0, 0, At, B0); PG8_BAR; PG8_SCHED;
            PG8_LDB(B1, 1, 1); PG8_STAGE(PG8_SB(1, 0), b3, voffB);
            PG8_BAR; PG8_WAIT_L(0); PG8_MMA(0, 1, At, B1); PG8_BAR;
            PG8_LDA(At, 1, 1); PG8_STAGE(PG8_SA(1, 0), a3, voffA);
            PG8_BAR; PG8_WAIT_L(0); PG8_MMA(1, 0, At, B0); PG8_BAR; PG8_SCHED;
            PG8_STAGE(PG8_SB(1, 1), b3 + hstep, voffB);
            PG8_WAIT_V(6); PG8_BAR; PG8_MMA(1, 1, At, B1); PG8_BAR;
            }
        }
        if constexpr (ALIGN_EPI) { if (wr == 0) PG8_BAR; }
        if constexpr (!Epi::AFTER_DRAIN) { E(acc, cur, wr, wc, fr, fq); S.done(cur); }
        if (!has_next) break;
#pragma unroll
        for (int a = 0; a < 2; ++a)
#pragma unroll
            for (int b = 0; b < 2; ++b)
#pragma unroll
                for (int m = 0; m < 4; ++m)
#pragma unroll
                    for (int n = 0; n < 2; ++n) acc[a][b][m][n] = (f32x4){0.f, 0.f, 0.f, 0.f};
        cur = nxt; cA = nA; cB = nB; ++ui;
        if constexpr (ALIGN_EPI) { if (wr == 1) PG8_BAR; }
    }
    PG8_WAIT_V(0);
    if constexpr (!ALIGN_EPI) { if (wr == 0) PG8_BAR; }
    PG8_BAR;
    if constexpr (Epi::AFTER_DRAIN) { E.fused(acc, cur, wr, wc, fr, fq, lds, wid, lane); S.done(cur); }
#undef PG8_SA
#undef PG8_SB
#undef PG8_STAGE
#undef PG8_LDA
#undef PG8_LDB
#undef PG8_MMA
#undef PG8_WAIT_V
#undef PG8_WAIT_L
#undef PG8_BAR
#undef PG8_SCHED
}
}

constexpr int NWAVES = 8;
constexpr int T = 16384, D = 2048, S = 2048, NBATCH = 8, CH = 64, NCH = 32, NH = 8, HD = 128, DEPTH = 4, NEXP = 16384;
constexpr int TOKC = pg8::TOKC, SWPR = 2048, TOKP = pg8::TOKP, SWPP = pg8::SWPP, QPP = pg8::QPP;
constexpr int TK_QA = 0, TK_KA = 1024, TK_QR = 2048, TK_KR = 3072, TK_GR = 4096;
constexpr int SW_VA = 0, SW_VR = 1024;
constexpr float EPS = 1e-6f, LOG2E = 1.4426950408889634f;
constexpr int PH_PER_LAYER = 8, N_PHASES = 1 + DEPTH * PH_PER_LAYER;

constexpr size_t MiB = 1u << 20;
constexpr size_t WS_CTL = 0, CTL_ZERO_BYTES = 1 * MiB;
constexpr size_t WS_ROPE_TOK = 1 * MiB, WS_ROPE_TR = 2 * MiB, WS_KEYS = 3 * MiB, WS_SSQ = 5 * MiB, WS_EXP = 9 * MiB, WS_GATE = 17 * MiB, WS_SS2 = 25 * MiB;
constexpr size_t WS_WTOK = 32 * MiB, WS_WSWP = 112 * MiB, WS_WOUT = 160 * MiB, WS_WQ = 192 * MiB;
constexpr size_t WS_HN = 224 * MiB, WS_TOK = 288 * MiB, WS_SWP = 456 * MiB, WS_ST = 556 * MiB, WS_MIX = 620 * MiB, WS_XR = 684 * MiB, WS_QP = 812 * MiB, WS_H2 = 884 * MiB;
constexpr size_t WS_UB = 948 * MiB, WS_VB = 1012 * MiB, WS_SU = 1076 * MiB, WS_SV = 1077 * MiB, WS_END = 1078 * MiB;
static_assert(WS_KEYS + (size_t)DEPTH * 16 * 128 * 128 * 2 <= WS_SSQ && WS_SSQ + (size_t)16 * 4 * T * 4 <= WS_EXP && WS_EXP + (size_t)T * 128 * 4 <= WS_GATE && WS_GATE + (size_t)T * 128 * 4 <= WS_SS2 && WS_SS2 + (size_t)32 * T * 4 <= WS_WTOK, "ws map 1");
static_assert(WS_WTOK + (size_t)DEPTH * TOKC * D * 2 <= WS_WSWP && WS_WSWP + (size_t)DEPTH * SWPR * D * 2 <= WS_WOUT && WS_WOUT + (size_t)DEPTH * D * D * 2 <= WS_WQ && WS_WQ + (size_t)DEPTH * D * D * 2 <= WS_HN, "ws map 2");
static_assert(WS_HN + (size_t)T * D * 2 <= WS_TOK && WS_TOK + (size_t)T * TOKP * 2 <= WS_SWP && WS_SWP + (size_t)SWPR * SWPP * 2 <= WS_ST && WS_ST + (size_t)64 * 32 * 128 * 128 * 2 <= WS_MIX, "ws map 3");
static_assert(WS_MIX + (size_t)T * D * 2 <= WS_XR && WS_XR + (size_t)T * D * 2 <= WS_QP && WS_QP + (size_t)T * QPP * 2 <= WS_H2 && WS_H2 + (size_t)T * D * 2 <= WS_UB, "ws map 4");
static_assert(WS_UB + (size_t)DEPTH * NEXP * D / 2 <= WS_VB && WS_VB + (size_t)DEPTH * NEXP * D / 2 <= WS_SU && WS_SU + (size_t)DEPTH * NEXP * 4 <= WS_SV && WS_SV + (size_t)DEPTH * NEXP * 4 <= WS_END, "ws map 5");
constexpr int CW_BAR = 4096;

constexpr int RING_OFF = 0, RING_BYTES = 131072;
constexpr int LDSCTL_OFF = RING_BYTES, MISC_OFF = LDSCTL_OFF + 320;
constexpr int LDS_BYTES = 147456;

#define GAS __attribute__((address_space(1)))
#define LAS __attribute__((address_space(3)))
typedef unsigned short bf16;
typedef short bf16x8 __attribute__((ext_vector_type(8)));
typedef float f32x4 __attribute__((ext_vector_type(4)));
typedef float f32x2 __attribute__((ext_vector_type(2)));
typedef unsigned u32x4 __attribute__((ext_vector_type(4)));
typedef unsigned u32x2 __attribute__((ext_vector_type(2)));
#define LDS_WAIT() asm volatile("s_waitcnt lgkmcnt(0)" ::: "memory")
__device__ __forceinline__ unsigned f2bf(float f) { unsigned u = __builtin_bit_cast(unsigned, f); return (u + 0x7fffu + ((u >> 16) & 1u)) >> 16; }
__device__ __forceinline__ unsigned pk2(float lo, float hi) { return f2bf(lo) | (f2bf(hi) << 16); }
__device__ __forceinline__ float bf_lo(unsigned w) { return __builtin_bit_cast(float, w << 16); }
__device__ __forceinline__ float bf_hi(unsigned w) { return __builtin_bit_cast(float, w & 0xffff0000u); }
__device__ __forceinline__ bf16x8 ld_b8(const bf16* p) { return *(const GAS bf16x8*)p; }
__device__ __forceinline__ u32x4 ld_u4(const void* p) { return *(const GAS u32x4*)p; }
__device__ __forceinline__ u32x2 ld_u2(const void* p) { return *(const GAS u32x2*)p; }
__device__ __forceinline__ f32x4 ld_f4(const float* p) { return *(const GAS f32x4*)p; }
__device__ __forceinline__ void st_u2(void* p, u32x2 v) { *(GAS u32x2*)p = v; }
__device__ __forceinline__ void st_u4(void* p, u32x4 v) { *(GAS u32x4*)p = v; }
__device__ __forceinline__ void st_f4(float* p, f32x4 v) { *(GAS f32x4*)p = v; }
__device__ __forceinline__ f32x4 mfma16(bf16x8 a, bf16x8 b, f32x4 c) { return __builtin_amdgcn_mfma_f32_16x16x32_bf16(a, b, c, 0, 0, 0); }
__device__ __forceinline__ bf16x8 pack8(f32x4 a, f32x4 b) {
    u32x4 w; w.x = pk2(a[0], a[1]); w.y = pk2(a[2], a[3]); w.z = pk2(b[0], b[1]); w.w = pk2(b[2], b[3]); return __builtin_bit_cast(bf16x8, w);
}
__device__ __forceinline__ float wave_sum(float v) {
#pragma unroll
    for (int o = 1; o < 64; o <<= 1) v += __shfl_xor(v, o);
    return v;
}
__device__ __forceinline__ float rq_sum(float v) { v += __shfl_xor(v, 16); v += __shfl_xor(v, 32); return v; }
__device__ __forceinline__ float rq_max(float v) { v = fmaxf(v, __shfl_xor(v, 16)); v = fmaxf(v, __shfl_xor(v, 32)); return v; }
__device__ __forceinline__ int lane_id() { return (int)__builtin_amdgcn_mbcnt_hi(~0u, __builtin_amdgcn_mbcnt_lo(~0u, 0u)); }
__device__ __forceinline__ float fexp2(float x) { return __builtin_amdgcn_exp2f(x); }
__device__ __forceinline__ float frsq(float x) { return __builtin_amdgcn_rsqf(x); }

#define XB_TMO      128
#define XB_XCNT(j)  (256  + 64 * (j))
#define XB_XSUB(j)  (1280 + 64 * (j))
#define XB_XGEN(j)  (2304 + 64 * (j))
#define XB_TOP      3328
#define XB_TOPGEN   3392
#define XCD_BAR_WORDS 3456
#define XB_SPIN_CAP (1u << 20)
__device__ __forceinline__ unsigned xb_ld(unsigned* p)              { return __hip_atomic_load(p, __ATOMIC_RELAXED, __HIP_MEMORY_SCOPE_AGENT); }
__device__ __forceinline__ unsigned xb_add(unsigned* p, unsigned v) { return __hip_atomic_fetch_add(p, v, __ATOMIC_RELAXED, __HIP_MEMORY_SCOPE_AGENT); }
__device__ __forceinline__ unsigned xb_xcc_id() { return (unsigned)__builtin_amdgcn_s_getreg((3 << 11) | 20) & 0xFu; }
#define XB_SPIN(cond, bar) do { unsigned _sp = 0; while (cond) { __builtin_amdgcn_s_sleep(1); \
    if ((++_sp & 255u) == 0u) { if (xb_ld(&(bar)[XB_TMO])) break; if (_sp > XB_SPIN_CAP) { atomicAdd(&(bar)[XB_TMO], 1u); break; } } } } while (0)
struct XcdBarrier { unsigned* bar; unsigned x; volatile LAS unsigned* st; };
__device__ __forceinline__ XcdBarrier xcd_barrier_post(unsigned* bar, volatile LAS unsigned* st) {
    XcdBarrier b; b.bar = bar; b.x = xb_xcc_id(); b.st = st;
    if (threadIdx.x == 0) (void)xb_add(&bar[XB_XCNT(b.x)], 1u);
    return b;
}
__device__ __forceinline__ void xcd_barrier_complete(unsigned* bar, unsigned x, unsigned& nloc, unsigned& nx) {
    const unsigned G = gridDim.x * gridDim.y * gridDim.z;
    unsigned sum, cnt, mine, sp = 0u;
    for (;;) {
        sum = 0u; cnt = 0u; mine = 0u;
#pragma unroll
        for (unsigned j = 0; j < 16; ++j) { const unsigned c = xb_ld(&bar[XB_XCNT(j)]); sum += c; cnt += (c > 0u) ? 1u : 0u; mine = (j == x) ? c : mine; }
        if (sum == G) break;
        __builtin_amdgcn_s_sleep(1);
        if ((++sp & 255u) == 0u) { if (xb_ld(&bar[XB_TMO])) break; if (sp > XB_SPIN_CAP) { atomicAdd(&bar[XB_TMO], 1u); break; } }
    }
    nloc = mine > 0u ? mine : 1u; nx = cnt > 0u ? cnt : 1u;
}
__device__ __forceinline__ void xcd_barrier(const XcdBarrier& b, int wave) {
    asm volatile("s_waitcnt vmcnt(0)" ::: "memory");
    __syncthreads();
    if (wave == 0 && lane_id() == 0) {
        unsigned* bar = b.bar;
        __builtin_amdgcn_s_waitcnt(0);
        unsigned nloc = b.st[0], nx = b.st[1];
        if (nloc == 0u) { xcd_barrier_complete(bar, b.x, nloc, nx); b.st[0] = nloc; b.st[1] = nx; }
        const unsigned old = xb_add(&bar[XB_XSUB(b.x)], 1u);
        const unsigned gen = old / nloc;
        if (old + 1u == (gen + 1u) * nloc) {
            __builtin_amdgcn_fence(__ATOMIC_RELEASE, "agent");
            asm volatile("s_waitcnt vmcnt(0)" ::: "memory");
            const unsigned og = xb_add(&bar[XB_TOP], 1u);
            const unsigned tg = og / nx;
            if (og + 1u == (tg + 1u) * nx) xb_add(&bar[XB_TOPGEN], 1u);
            else XB_SPIN(xb_ld(&bar[XB_TOPGEN]) == tg, bar);
            __builtin_amdgcn_fence(__ATOMIC_ACQUIRE, "agent");
            xb_add(&bar[XB_XGEN(b.x)], 1u);
            asm volatile("s_waitcnt vmcnt(0)" ::: "memory");
        } else {
            XB_SPIN(xb_ld(&bar[XB_XGEN(b.x)]) == gen, bar);
            __builtin_amdgcn_fence(__ATOMIC_ACQUIRE, "agent");
            asm volatile("s_waitcnt vmcnt(0)" ::: "memory");
        }
    }
    __syncthreads();
}

struct Frame {
    LAS unsigned char* lds;
    int wave, G, gw, ngw;
    const float *x, *norm1_g, *w_in, *qa_g, *ka_g, *rel_bias, *attn_g, *ret_g, *w_out, *norm2_g, *peer_wq, *peer_keys, *peer_u, *peer_v;
    float* out; unsigned char* ws;
};

template <class DstFn>
__device__ __forceinline__ void transpose_item(const float* W, int K, int N, LAS float* scr, int item, int lane, DstFn dst, const float* kscale = nullptr) {
    const int nblk = N / 32, kb = item / nblk, nb = item % nblk, k0 = 64 * kb, n0 = 32 * nb;
#pragma unroll
    for (int i = 0; i < 32; ++i) { const int kk = 2 * i + (lane >> 5); float wv = *(const GAS float*)(W + (size_t)(k0 + kk) * N + n0 + (lane & 31));
        if (kscale) wv *= *(const GAS float*)(kscale + k0 + kk);
        scr[kk * 33 + (lane & 31)] = wv; }
    LDS_WAIT(); asm volatile("" ::: "memory");
    const int c = lane & 7;
#pragma unroll
    for (int j = 0; j < 4; ++j) { const int n = (lane >> 3) + 8 * j; const LAS float* s = scr + (8 * c) * 33 + n;
        u32x4 o; o.x = pk2(s[0 * 33], s[1 * 33]); o.y = pk2(s[2 * 33], s[3 * 33]); o.z = pk2(s[4 * 33], s[5 * 33]); o.w = pk2(s[6 * 33], s[7 * 33]);
        dst(n0 + n, k0 + 8 * c, o); }
    LDS_WAIT(); asm volatile("" ::: "memory");
}
__device__ __forceinline__ void rms_row_to_bf16(const float* xrow, const float* g, bf16* orow, int lane) {
    asm volatile("" : "+v"(lane));
    f32x4 v[8]; float s = 0.f;
#pragma unroll
    for (int j = 0; j < 8; ++j) { v[j] = ld_f4(xrow + (j * 64 + lane) * 4); s += (v[j][0] * v[j][0] + v[j][1] * v[j][1]) + (v[j][2] * v[j][2] + v[j][3] * v[j][3]); }
    const float rstd = frsq(wave_sum(s) * (1.f / D) + EPS);
#pragma unroll
    for (int j = 0; j < 8; ++j) { const f32x4 gg = ld_f4(g + (j * 64 + lane) * 4);
        u32x2 o; o.x = pk2(v[j][0] * rstd * gg[0], v[j][1] * rstd * gg[1]); o.y = pk2(v[j][2] * rstd * gg[2], v[j][3] * rstd * gg[3]);
        st_u2(orow + (j * 64 + lane) * 4, o); }
}
__device__ __forceinline__ void row_to_fp4(const float* src, unsigned char* dst, size_t slice_stride, unsigned short* scale_out, int lane) {
    f32x4 v[8]; float mx = 0.f;
#pragma unroll
    for (int q = 0; q < 8; ++q) { v[q] = ld_f4(src + lane * 32 + q * 4);
        mx = fmaxf(mx, fmaxf(fmaxf(__builtin_fabsf(v[q][0]), __builtin_fabsf(v[q][1])), fmaxf(__builtin_fabsf(v[q][2]), __builtin_fabsf(v[q][3])))); }
#pragma unroll
    for (int o = 1; o < 64; o <<= 1) mx = fmaxf(mx, __shfl_xor(mx, o));
    const float sc = mx > 0.f ? bf_lo(f2bf(mx * (1.0f / 6.0f)) ) : 1.0f, inv = 1.0f / sc;
    u32x4 o;
#pragma unroll
    for (int d = 0; d < 4; ++d) { const f32x4 a = v[2 * d] * inv, b = v[2 * d + 1] * inv;
        unsigned w = 0u;
        w = __builtin_amdgcn_cvt_scalef32_pk_fp4_f32(w, a[0], a[1], 1.0f, 0); w = __builtin_amdgcn_cvt_scalef32_pk_fp4_f32(w, a[2], a[3], 1.0f, 1);
        w = __builtin_amdgcn_cvt_scalef32_pk_fp4_f32(w, b[0], b[1], 1.0f, 2); w = __builtin_amdgcn_cvt_scalef32_pk_fp4_f32(w, b[2], b[3], 1.0f, 3);
        o[d] = w; }
    st_u4(dst + (size_t)(lane >> 3) * slice_stride + (lane & 7) * 16, o);
    if (lane == 0) *(GAS unsigned short*)scale_out = (unsigned short)f2bf(sc);
}
__device__ __forceinline__ void p0_prologue(const Frame& F) {
    LAS float* scr = (LAS float*)(F.lds + RING_OFF + F.wave * 16384);
    int lane = lane_id(); asm volatile("" : "+v"(lane));
    bf16* Wtok = (bf16*)(F.ws + WS_WTOK); bf16* Wswp = (bf16*)(F.ws + WS_WSWP); bf16* Wout = (bf16*)(F.ws + WS_WOUT); bf16* Wq = (bf16*)(F.ws + WS_WQ);
    constexpr int IN_COLS = 7168;
    constexpr int I_IN = (D / 64) * (IN_COLS / 32), I_SQ = (D / 64) * (D / 32), I_L = I_IN + 2 * I_SQ, NITEMS = DEPTH * I_L;
    for (int it = F.gw; it < NITEMS; it += F.ngw) {
        const int l = it / I_L; int r = it % I_L;
        if (r < I_IN) {
            bf16* wt = Wtok + (size_t)l * TOKC * D; bf16* wsw = Wswp + (size_t)l * SWPR * D;
            transpose_item(F.w_in + (size_t)l * D * IN_COLS, D, IN_COLS, scr, r, lane, [=](int n, int k, u32x4 o) {
                const int seg = n >> 10, nn = n & 1023, dd = n & 127, dp = (n & 896) + 2 * (dd & 63) + (dd >> 6);
                if (seg == 0) st_u4(wt + (size_t)(TK_QA + nn) * D + k, o);
                else if (seg == 1) st_u4(wt + (size_t)(TK_KA + nn) * D + k, o);
                else if (seg == 2) st_u4(wsw + (size_t)(SW_VA + nn) * D + k, o);
                else if (seg == 3) st_u4(wt + (size_t)(TK_QR + dp) * D + k, o);
                else if (seg == 4) st_u4(wt + (size_t)(TK_KR + dp) * D + k, o);
                else if (seg == 5) st_u4(wsw + (size_t)(SW_VR + nn) * D + k, o);
                else st_u4(wt + (size_t)(TK_GR + nn) * D + k, o);
            });
            continue;
        }
        r -= I_IN;
        if (r < I_SQ) { bf16* wo = Wout + (size_t)l * D * D;
            transpose_item(F.w_out + (size_t)l * D * D, D, D, scr, r, lane, [=](int n, int k, u32x4 o) { st_u4(wo + (size_t)n * D + k, o); }); continue; }
        r -= I_SQ;
        { bf16* wq = Wq + (size_t)l * D * D;
            transpose_item(F.peer_wq + (size_t)l * D * D, D, D, scr, r, lane, [=](int n, int k, u32x4 o) { st_u4(wq + (size_t)n * D + k, o); }, F.norm2_g + l * D); }
    }
    bf16* HN = (bf16*)(F.ws + WS_HN);
    for (int m = F.gw; m < T; m += F.ngw) rms_row_to_bf16(F.x + (size_t)m * D, F.norm1_g, HN + (size_t)m * D, lane);
    {
        unsigned char* UB = (unsigned char*)(F.ws + WS_UB); unsigned char* VB = (unsigned char*)(F.ws + WS_VB);
        unsigned short* SUV = (unsigned short*)(F.ws + WS_SU);
        const int nrows = DEPTH * NEXP;
        for (int r = F.gw; r < 2 * nrows; r += F.ngw) {
            const bool isv = r >= nrows; const int rr = isv ? r - nrows : r;
            row_to_fp4((isv ? F.peer_v : F.peer_u) + (size_t)rr * D, (isv ? VB : UB) + (size_t)(rr / NEXP) * NEXP * (D / 2) + (size_t)(rr % NEXP) * 128, (size_t)NEXP * 128, SUV + 2 * (size_t)rr + (isv ? 1 : 0), lane);
        }
        const size_t nK = (size_t)DEPTH * 16 * 128 * 128 / 8;
        bf16* KB = (bf16*)(F.ws + WS_KEYS);
        const size_t stride = (size_t)F.ngw * 64, start = (size_t)F.gw * 64 + lane;
        for (size_t i = start; i < nK; i += stride) {
            const f32x4 a = ld_f4(F.peer_keys + i * 8), b = ld_f4(F.peer_keys + i * 8 + 4);
            u32x4 o; o.x = pk2(a[0], a[1]); o.y = pk2(a[2], a[3]); o.z = pk2(b[0], b[1]); o.w = pk2(b[2], b[3]); st_u4(KB + i * 8, o);
        }
    }
    {
        f32x2* ct = (f32x2*)(F.ws + WS_ROPE_TOK);
        for (int e = F.gw * 64 + lane; e < S * 64; e += F.ngw * 64) {
            const int pos = e >> 6, i = e & 63;
            const float invf = exp2f(-(float)i * 0.20762050593046014f);
            const double rev = (double)pos * (double)invf * 0.15915494309189535;
            const float fr = (float)(rev - __builtin_floor(rev));
            const f32x2 v = {__builtin_amdgcn_cosf(fr), __builtin_amdgcn_sinf(fr)};
            ct[(size_t)pos * 64 + i] = v;
        }
    }
}

constexpr int A_KP = 272, A_VP = 144;
constexpr int A_KBUF = 0, A_VBUF = A_KBUF + 2 * 64 * A_KP, A_RK = A_VBUF + 2 * 128 * A_VP, A_BIAS = A_RK + 2 * 64 * 4, A_END = A_BIAS + NH * 257 * 4;
static_assert(A_END <= RING_BYTES, "attention LDS map");
__device__ __forceinline__ void attn_wg_task(const Frame& F, int l, int task) {
    int tid = F.wave * 64 + lane_id(); asm volatile("" : "+v"(tid));
    const int lane = tid & 63, c = lane & 15, rq = lane >> 4, wave = F.wave;
    const int cq = task & 7, h = (task >> 3) & 7, b = task >> 6;
    const bf16* TOK = (const bf16*)(F.ws + WS_TOK); const bf16* SWP = (const bf16*)(F.ws + WS_SWP); const float* SSQ = (const float*)(F.ws + WS_SSQ);
    bf16* MIX = (bf16*)(F.ws + WS_MIX);
    LAS unsigned char* lds = F.lds + RING_OFF;
    const LAS float* bh = (const LAS float*)(lds + A_BIAS) + h * 257;
    const int wch = wave >> 1;
    const int qi0 = (wave & 1) * 32 + c;
    const int tq0 = b * S + (4 * cq + wch) * CH + qi0;
    bf16x8 Qf[2][4];
#pragma unroll
    for (int qb = 0; qb < 2; ++qb) {
        const int tq = tq0 + qb * 16;
        float ssq = 0.f;
#pragma unroll
        for (int w = 0; w < 4; ++w) ssq += *(const GAS float*)(SSQ + (size_t)((0 * 8 + h) * 4 + w) * T + tq);
        const float rs = frsq(ssq * (1.f / HD) + EPS) * (pg8::KSCALE * LOG2E);
#pragma unroll
        for (int ks = 0; ks < 4; ++ks) {
            const float* gp = F.qa_g + l * HD + ks * 32 + rq * 8; const float* kp = F.ka_g + l * HD + ks * 32 + rq * 8;
            const f32x4 a0 = ld_f4(gp), a1 = ld_f4(gp + 4), b0 = ld_f4(kp), b1 = ld_f4(kp + 4);
            const u32x4 raw = ld_u4(TOK + (size_t)tq * TOKP + TK_QA + h * HD + ks * 32 + rq * 8);
            u32x4 o;
            o.x = pk2(bf_lo(raw.x) * rs * (a0[0] * b0[0]), bf_hi(raw.x) * rs * (a0[1] * b0[1])); o.y = pk2(bf_lo(raw.y) * rs * (a0[2] * b0[2]), bf_hi(raw.y) * rs * (a0[3] * b0[3]));
            o.z = pk2(bf_lo(raw.z) * rs * (a1[0] * b1[0]), bf_hi(raw.z) * rs * (a1[1] * b1[1])); o.w = pk2(bf_lo(raw.w) * rs * (a1[2] * b1[2]), bf_hi(raw.w) * rs * (a1[3] * b1[3]));
            Qf[qb][ks] = __builtin_bit_cast(bf16x8, o);
        }
    }
    float m_run[2] = {-1e30f, -1e30f}, l_run[2] = {0.f, 0.f};
    f32x4 O[2][8];
#pragma unroll
    for (int qb = 0; qb < 2; ++qb)
#pragma unroll
        for (int db = 0; db < 8; ++db) O[qb][db] = (f32x4){0.f, 0.f, 0.f, 0.f};
    const int p0 = tid, p1 = tid + 512;
    const int kr0 = p0 >> 4, kr1 = p1 >> 4;
    const int kl0 = (kr0 & 32) + ((kr0 >> 2) & 1) * 16 + ((kr0 >> 3) & 3) * 4 + (kr0 & 3), kl1 = (kr1 & 32) + ((kr1 >> 2) & 1) * 16 + ((kr1 >> 3) & 3) * 4 + (kr1 & 3);
    const bf16* gk0 = TOK + (size_t)(b * S + kr0) * TOKP + TK_KA + h * HD + (p0 & 15) * 8; const bf16* gk1 = TOK + (size_t)(b * S + kr1) * TOKP + TK_KA + h * HD + (p1 & 15) * 8;
    const bf16* gv0 = SWP + (size_t)(SW_VA + h * HD + (p0 >> 3)) * SWPP + b * S + (p0 & 7) * 8; const bf16* gv1 = SWP + (size_t)(SW_VA + h * HD + (p1 >> 3)) * SWPP + b * S + (p1 & 7) * 8;
    const int lk0 = A_KBUF + kl0 * A_KP + (p0 & 15) * 16, lk1 = A_KBUF + kl1 * A_KP + (p1 & 15) * 16;
    const int lv0 = A_VBUF + (p0 >> 3) * A_VP + (p0 & 7) * 16, lv1 = A_VBUF + (p1 >> 3) * A_VP + (p1 & 7) * 16;
    const float* gss = SSQ + (size_t)((8 + h) * 4) * T + b * S + (tid & 63);
    u32x4 r0, r1, r2, r3; float rkv = 0.f;
    const int kc0 = 4 * cq - 8, j0 = kc0 < 0 ? -kc0 : 0;
#define A_GLOAD(j) do { const int ko = (kc0 + (j)) * CH; r0 = ld_u4(gk0 + (size_t)ko * TOKP); r1 = ld_u4(gk1 + (size_t)ko * TOKP); r2 = ld_u4(gv0 + ko); r3 = ld_u4(gv1 + ko); \
        if (tid < 64) { float s_ = 0.f; _Pragma("unroll") for (int w = 0; w < 4; ++w) s_ += *(const GAS float*)(gss + (size_t)w * T + ko); rkv = frsq(s_ * (1.f / HD) + EPS); } } while (0)
#define A_LSTORE(bf) do { *(LAS u32x4*)(lds + lk0 + (bf) * 64 * A_KP) = r0; *(LAS u32x4*)(lds + lk1 + (bf) * 64 * A_KP) = r1; *(LAS u32x4*)(lds + lv0 + (bf) * 128 * A_VP) = r2; *(LAS u32x4*)(lds + lv1 + (bf) * 128 * A_VP) = r3; \
        if (tid < 64) ((LAS float*)(lds + A_RK))[(bf) * 64 + tid] = rkv; } while (0)
    __syncthreads();
    A_GLOAD(j0); A_LSTORE(j0 & 1);
    __syncthreads();
    for (int j = j0; j < 12; ++j) {
        if (j < 11) A_GLOAD(j + 1);
        const int tjr = j - wch;
        if (tjr >= 0 && tjr <= 8) {
            const LAS unsigned char* kb = lds + A_KBUF + (j & 1) * 64 * A_KP + c * A_KP + rq * 16;
            const LAS unsigned char* vb = lds + A_VBUF + (j & 1) * 128 * A_VP + c * A_VP + rq * 16;
            const LAS float* rkb = (const LAS float*)(lds + A_RK) + (j & 1) * 64;
            f32x4 sa[2][2][2];
#pragma unroll
            for (int g = 0; g < 2; ++g)
#pragma unroll
                for (int ab = 0; ab < 2; ++ab) { f32x4 a0 = (f32x4){0.f, 0.f, 0.f, 0.f}, a1 = (f32x4){0.f, 0.f, 0.f, 0.f};
#pragma unroll
                    for (int ks = 0; ks < 4; ++ks) { const bf16x8 kf = *(const LAS bf16x8*)(kb + (32 * g + 16 * ab) * A_KP + ks * 64); a0 = mfma16(kf, Qf[0][ks], a0); a1 = mfma16(kf, Qf[1][ks], a1); }
                    sa[0][g][ab] = a0; sa[1][g][ab] = a1; }
            const int relbase = 64 * (8 - tjr);
            float mx[2] = {-1e30f, -1e30f};
            if (tjr <= 5) {
                const float bc = bh[256];
#pragma unroll
                for (int g = 0; g < 2; ++g)
#pragma unroll
                    for (int ab = 0; ab < 2; ++ab) {
                        const f32x4 rk = *(const LAS f32x4*)(rkb + 32 * g + 8 * rq + 4 * ab);
#pragma unroll
                        for (int qb = 0; qb < 2; ++qb)
#pragma unroll
                            for (int e = 0; e < 4; ++e) { const float sv = sa[qb][g][ab][e] * rk[e] + bc; sa[qb][g][ab][e] = sv; mx[qb] = fmaxf(mx[qb], sv); }
                    }
            } else {
#pragma unroll
                for (int g = 0; g < 2; ++g)
#pragma unroll
                    for (int ab = 0; ab < 2; ++ab) {
                        const int kk0 = 32 * g + 8 * rq + 4 * ab;
                        const f32x4 rk = *(const LAS f32x4*)(rkb + kk0);
#pragma unroll
                        for (int qb = 0; qb < 2; ++qb)
#pragma unroll
                            for (int e = 0; e < 4; ++e) {
                                int rel = qi0 + qb * 16 - (kk0 + e) + relbase; rel = rel > 128 ? 128 : (rel < -128 ? -128 : rel);
                                const float sv = sa[qb][g][ab][e] * rk[e] + bh[rel + 128];
                                sa[qb][g][ab][e] = sv; mx[qb] = fmaxf(mx[qb], sv);
                            }
                    }
            }
            bf16x8 Pf[2][2];
            bool moved = false;
            float alpha[2];
#pragma unroll
            for (int qb = 0; qb < 2; ++qb) {
                const float mxr = rq_max(mx[qb]);
                const float mn = fmaxf(m_run[qb], mxr); alpha[qb] = fexp2(m_run[qb] - mn);
                moved = moved || (mn > m_run[qb]);
                float ps = 0.f;
#pragma unroll
                for (int g = 0; g < 2; ++g) {
#pragma unroll
                    for (int ab = 0; ab < 2; ++ab)
#pragma unroll
                        for (int e = 0; e < 4; ++e) { const float p = fexp2(sa[qb][g][ab][e] - mn); sa[qb][g][ab][e] = p; ps += p; }
                    Pf[qb][g] = pack8(sa[qb][g][0], sa[qb][g][1]);
                }
                l_run[qb] = l_run[qb] * alpha[qb] + ps; m_run[qb] = mn;
            }
            if (__any(moved)) {
#pragma unroll
                for (int qb = 0; qb < 2; ++qb)
#pragma unroll
                    for (int db = 0; db < 8; ++db) O[qb][db] *= alpha[qb];
            }
#pragma unroll
            for (int g = 0; g < 2; ++g)
#pragma unroll
                for (int db = 0; db < 8; ++db) { const bf16x8 vf = *(const LAS bf16x8*)(vb + db * 16 * A_VP + g * 64); O[0][db] = mfma16(vf, Pf[0][g], O[0][db]); O[1][db] = mfma16(vf, Pf[1][g], O[1][db]); }
        }
        if (j < 11) A_LSTORE((j + 1) & 1);
        __syncthreads();
    }
#undef A_GLOAD
#undef A_LSTORE
#pragma unroll
    for (int qb = 0; qb < 2; ++qb) {
        const int tq = tq0 + qb * 16;
        const float inv = 1.0f / rq_sum(l_run[qb]);
        float ss = 0.f;
#pragma unroll
        for (int db = 0; db < 8; ++db) { O[qb][db] *= inv; ss += (O[qb][db][0] * O[qb][db][0] + O[qb][db][1] * O[qb][db][1]) + (O[qb][db][2] * O[qb][db][2] + O[qb][db][3] * O[qb][db][3]); }
        const float rstd = frsq(rq_sum(ss) * (1.f / HD) + EPS);
#pragma unroll
        for (int db = 0; db < 8; ++db) {
            const int d0 = h * HD + db * 16 + rq * 4;
            const f32x4 g4 = ld_f4(F.attn_g + l * 1024 + d0);
            u32x2 o; o.x = pk2(O[qb][db][0] * rstd * g4[0], O[qb][db][1] * rstd * g4[1]); o.y = pk2(O[qb][db][2] * rstd * g4[2], O[qb][db][3] * rstd * g4[3]);
            st_u2(MIX + (size_t)tq * D + d0, o);
        }
    }
}

constexpr int SC_PITCH = 36, SC_WAVE_BYTES = 64 * SC_PITCH, SC_OFF = A_END;
static_assert(SC_OFF % 4 == 0 && SC_OFF + NWAVES * SC_WAVE_BYTES <= RING_BYTES, "scan LDS map");
struct ScanOps { u32x4 kp[2]; bf16x8 va[4][2]; };
__device__ __forceinline__ void scan_load(ScanOps& o, const bf16* kg, const bf16* vrow, int n) {
#pragma unroll
    for (int i = 0; i < 2; ++i) o.kp[i] = ld_u4(kg + (size_t)(n * CH + i * 32) * TOKP);
#pragma unroll
    for (int eb = 0; eb < 4; ++eb)
#pragma unroll
        for (int ks = 0; ks < 2; ++ks) o.va[eb][ks] = ld_b8(vrow + (size_t)eb * 16 * SWPP + n * CH + ks * 32);
}
__device__ __forceinline__ void scan_step(f32x4 (&st)[4], const ScanOps& o, const float (&dec)[16], LAS unsigned char* kw, const LAS unsigned char* kr, bf16* sp, int n, float cd) {
#pragma unroll
    for (int eb = 0; eb < 4; ++eb) { u32x2 w; w.x = pk2(st[eb][0], st[eb][1]); w.y = pk2(st[eb][2], st[eb][3]); st_u2(sp + (size_t)n * HD * HD + eb * 16 * HD, w); }
#pragma unroll
    for (int i = 0; i < 2; ++i)
#pragma unroll
        for (int d = 0; d < 4; ++d) *(LAS unsigned*)(kw + i * 32 * SC_PITCH + d * 4) = o.kp[i][d];
    LDS_WAIT(); asm volatile("" ::: "memory");
    bf16x8 ka[2];
#pragma unroll
    for (int ks = 0; ks < 2; ++ks) { u32x4 w;
#pragma unroll
        for (int j = 0; j < 4; ++j) { const unsigned e0 = *(const LAS unsigned short*)(kr + (ks * 32 + 2 * j) * SC_PITCH), e1 = *(const LAS unsigned short*)(kr + (ks * 32 + 2 * j + 1) * SC_PITCH);
            w[j] = pk2(bf_lo(e0) * dec[ks * 8 + 2 * j], bf_lo(e1) * dec[ks * 8 + 2 * j + 1]); }
        ka[ks] = __builtin_bit_cast(bf16x8, w); }
    LDS_WAIT(); asm volatile("" ::: "memory");
#pragma unroll
    for (int eb = 0; eb < 4; ++eb) { st[eb] *= cd;
#pragma unroll
        for (int ks = 0; ks < 2; ++ks) st[eb] = mfma16(ka[ks], o.va[eb][ks], st[eb]); }
}
__device__ __forceinline__ void scan_task(const Frame& F, int task) {
    int lane = lane_id(); asm volatile("" : "+v"(lane));
    const int c = lane & 15, rq = lane >> 4;
    const int eh = task & 1, db = (task >> 1) & 7, h = (task >> 4) & 7, b = task >> 7, bhh = b * NH + h;
    const bf16* TOK = (const bf16*)(F.ws + WS_TOK); const bf16* SWP = (const bf16*)(F.ws + WS_SWP); bf16* ST = (bf16*)(F.ws + WS_ST);
    const bf16* kg = TOK + (size_t)(b * S + (lane >> 1)) * TOKP + TK_KR + h * HD + db * 16 + (lane & 1) * 8;
    const bf16* vrow = SWP + (size_t)(SW_VR + h * HD + eh * 64 + c) * SWPP + b * S + rq * 8;
    bf16* sp = ST + ((size_t)bhh * NCH * HD + eh * 64 + c) * HD + db * 16 + rq * 4;
    LAS unsigned char* kt = F.lds + RING_OFF + SC_OFF + F.wave * SC_WAVE_BYTES;
    LAS unsigned char* kw = kt + (lane >> 1) * SC_PITCH + (lane & 1) * 16;
    const LAS unsigned char* kr = kt + (rq * 8) * SC_PITCH + c * 2;
    f32x4 st[4];
#pragma unroll
    for (int eb = 0; eb < 4; ++eb) st[eb] = (f32x4){0.f, 0.f, 0.f, 0.f};
    const float lg = pg8::lg2gamma(h), cd = fexp2(64.f * lg);
    float dec[16];
#pragma unroll
    for (int i = 0; i < 16; ++i) dec[i] = fexp2((float)(63 - ((i >> 3) * 32 + rq * 8 + (i & 7))) * lg);
    ScanOps o0, o1, o2;
    scan_load(o0, kg, vrow, 0); scan_load(o1, kg, vrow, 1);
    for (int n = 0; n < NCH - 1; n += 3) {
        if (n + 2 < NCH - 1) scan_load(o2, kg, vrow, n + 2);
        scan_step(st, o0, dec, kw, kr, sp, n, cd);
        if (n + 1 < NCH - 1) { if (n + 3 < NCH - 1) scan_load(o0, kg, vrow, n + 3); scan_step(st, o1, dec, kw, kr, sp, n + 1, cd); }
        if (n + 2 < NCH - 1) { if (n + 4 < NCH - 1) scan_load(o1, kg, vrow, n + 4); scan_step(st, o2, dec, kw, kr, sp, n + 2, cd); }
    }
#pragma unroll
    for (int eb = 0; eb < 4; ++eb) { u32x2 w; w.x = pk2(st[eb][0], st[eb][1]); w.y = pk2(st[eb][2], st[eb][3]); st_u2(sp + (size_t)(NCH - 1) * HD * HD + eb * 16 * HD, w); }
}

__device__ __forceinline__ void ret_task(const Frame& F, int l, int task) {
    int lane = lane_id(); asm volatile("" : "+v"(lane));
    const int c = lane & 15, rq = lane >> 4;
    const int qb2 = task & 1, n = (task >> 1) & 31, h = (task >> 6) & 7, b = task >> 9, bhh = b * NH + h;
    const bf16* TOK = (const bf16*)(F.ws + WS_TOK); const bf16* SWP = (const bf16*)(F.ws + WS_SWP); const bf16* ST = (const bf16*)(F.ws + WS_ST);
    bf16* MIX = (bf16*)(F.ws + WS_MIX);
    const int tc0 = b * S + n * CH, tq0 = tc0 + qb2 * 32;
    const float lg = pg8::lg2gamma(h);
    bf16x8 Qf[2][4];
#pragma unroll
    for (int qb = 0; qb < 2; ++qb)
#pragma unroll
        for (int ks = 0; ks < 4; ++ks) Qf[qb][ks] = ld_b8(TOK + (size_t)(tq0 + qb * 16 + c) * TOKP + TK_QR + h * HD + ks * 32 + rq * 8);
    f32x4 acc[2][8];
#pragma unroll
    for (int qb = 0; qb < 2; ++qb)
#pragma unroll
        for (int eb = 0; eb < 8; ++eb) acc[qb][eb] = (f32x4){0.f, 0.f, 0.f, 0.f};
    const bf16* sp = ST + (((size_t)bhh * NCH + n) * HD + c) * HD + rq * 8;
#pragma unroll
    for (int eb = 0; eb < 8; ++eb)
#pragma unroll
        for (int ks = 0; ks < 4; ++ks) { const bf16x8 sf = ld_b8(sp + eb * 16 * HD + ks * 32);
#pragma unroll
            for (int qb = 0; qb < 2; ++qb) acc[qb][eb] = mfma16(sf, Qf[qb][ks], acc[qb][eb]); }
#pragma unroll
    for (int qb = 0; qb < 2; ++qb) { const float f = fexp2((float)(qb2 * 32 + qb * 16 + c + 1) * lg);
#pragma unroll
        for (int eb = 0; eb < 8; ++eb) acc[qb][eb] *= f; }
    for (int g = 0; g <= qb2; ++g) {
        f32x4 sa[2][2];
#pragma unroll
        for (int qb = 0; qb < 2; ++qb)
#pragma unroll
            for (int ab = 0; ab < 2; ++ab) sa[qb][ab] = (f32x4){0.f, 0.f, 0.f, 0.f};
#pragma unroll
        for (int ab = 0; ab < 2; ++ab) {
            const int key = 32 * g + (c >> 2) * 8 + 4 * ab + (c & 3);
            const bf16* kp = TOK + (size_t)(tc0 + key) * TOKP + TK_KR + h * HD + rq * 8;
#pragma unroll
            for (int ks = 0; ks < 4; ++ks) { const bf16x8 kf = ld_b8(kp + ks * 32);
#pragma unroll
                for (int qb = 0; qb < 2; ++qb) sa[qb][ab] = mfma16(kf, Qf[qb][ks], sa[qb][ab]); }
        }
        bf16x8 Pf[2];
#pragma unroll
        for (int qb = 0; qb < 2; ++qb) {
            const int i = qb2 * 32 + qb * 16 + c;
#pragma unroll
            for (int ab = 0; ab < 2; ++ab)
#pragma unroll
                for (int e = 0; e < 4; ++e) { const int diff = i - (32 * g + 8 * rq + 4 * ab + e);
                    sa[qb][ab][e] = diff >= 0 ? sa[qb][ab][e] * fexp2((float)diff * lg) : 0.f; }
            Pf[qb] = pack8(sa[qb][0], sa[qb][1]);
        }
#pragma unroll
        for (int eb = 0; eb < 8; ++eb) { const bf16x8 vf = ld_b8(SWP + (size_t)(SW_VR + h * HD + eb * 16 + c) * SWPP + tc0 + 32 * g + 8 * rq);
#pragma unroll
            for (int qb = 0; qb < 2; ++qb) acc[qb][eb] = mfma16(vf, Pf[qb], acc[qb][eb]); }
    }
#pragma unroll
    for (int qb = 0; qb < 2; ++qb) {
        const int t = tq0 + qb * 16 + c;
        float ss = 0.f;
#pragma unroll
        for (int eb = 0; eb < 8; ++eb) ss += (acc[qb][eb][0] * acc[qb][eb][0] + acc[qb][eb][1] * acc[qb][eb][1]) + (acc[qb][eb][2] * acc[qb][eb][2] + acc[qb][eb][3] * acc[qb][eb][3]);
        const float rstd = frsq(rq_sum(ss) * (1.f / HD) + EPS);
#pragma unroll
        for (int eb = 0; eb < 8; ++eb) {
            const int e0 = h * HD + eb * 16 + rq * 4;
            const f32x4 g4 = ld_f4(F.ret_g + l * 1024 + e0);
            const u32x2 gw = ld_u2(TOK + (size_t)t * TOKP + TK_GR + e0);
            u32x2 o; o.x = pk2(acc[qb][eb][0] * rstd * g4[0] * bf_lo(gw.x), acc[qb][eb][1] * rstd * g4[1] * bf_hi(gw.x));
            o.y = pk2(acc[qb][eb][2] * rstd * g4[2] * bf_lo(gw.y), acc[qb][eb][3] * rstd * g4[3] * bf_hi(gw.y));
            st_u2(MIX + (size_t)t * D + 1024 + e0, o);
        }
    }
}

__device__ __constant__ unsigned char kCandAB[64] = {0, 1, 2, 3, 4, 5, 6, 7, 8, 9, 10, 11, 12, 13, 14, 15, 16, 17, 18, 19, 20, 21, 22, 23, 32, 33, 34, 35, 36, 48, 49, 50, 51, 64, 65, 66, 80, 81, 96, 97,
                                                   112, 113, 128, 144, 160, 176, 192, 208, 224, 240, 0, 0, 0, 0, 0, 0, 0, 0, 0, 0, 0, 0, 0, 0};
template <unsigned MASK> __device__ __forceinline__ float embed_idx(float x, unsigned idx) {
    const unsigned u = __builtin_bit_cast(unsigned, x); const unsigned low = (u >> 31) ? idx : (MASK - idx);
    return __builtin_bit_cast(float, (u & ~MASK) | low);
}
template <unsigned MASK> __device__ __forceinline__ unsigned decode_idx(float y) {
    const unsigned u = __builtin_bit_cast(unsigned, y); const unsigned low = u & MASK; return (u >> 31) ? low : (MASK - low);
}
template <int N> __device__ __forceinline__ void sortdesc(float (&v)[N]) {
#pragma unroll
    for (int k = 2; k <= N; k <<= 1)
#pragma unroll
        for (int j = k >> 1; j > 0; j >>= 1)
#pragma unroll
            for (int i = 0; i < N; ++i) { const int p = i ^ j;
                if (p > i) { const bool desc = ((i & k) == 0); const float a = v[i], b = v[p], hi = fmaxf(a, b), lo = fminf(a, b); v[i] = desc ? hi : lo; v[p] = desc ? lo : hi; } }
}
__device__ __forceinline__ void merge16(float (&v)[16]) {
#pragma unroll
    for (int j = 8; j > 0; j >>= 1)
#pragma unroll
        for (int i = 0; i < 16; ++i) { const int p = i ^ j; if (p > i) { const float a = v[i], b = v[p]; v[i] = fmaxf(a, b); v[p] = fminf(a, b); } }
}
__device__ __forceinline__ void top16_of_group(float (&a)[16]) {
#pragma unroll
    for (int sh = 16; sh <= 32; sh <<= 1) {
        float cc[16];
#pragma unroll
        for (int i = 0; i < 16; ++i) cc[i] = fmaxf(a[i], __shfl_xor(a[15 - i], sh));
        merge16(cc);
#pragma unroll
        for (int i = 0; i < 16; ++i) a[i] = cc[i];
    }
}
constexpr int TL_STRIDE = 17, TL_WAVE_FLOATS = 2 * 16 * TL_STRIDE;
constexpr int KL_PITCH = 272, KL_BYTES = 2 * 128 * KL_PITCH;
static_assert(KL_BYTES + NWAVES * TL_WAVE_FLOATS * 4 <= RING_BYTES, "top-k LDS map");
__device__ __forceinline__ void topk_task(const Frame& F, int l, int tb, int h, const LAS unsigned char* kl, LAS float* tl) {
    int lane = lane_id(); asm volatile("" : "+v"(lane));
    const int c = lane & 15, rq = lane >> 4;
    const int t0 = tb * 16;
    const bf16* QP = (const bf16*)(F.ws + WS_QP);
    int* EXPI = (int*)(F.ws + WS_EXP); float* GATE = (float*)(F.ws + WS_GATE);
    const float NEG = -__builtin_inff();
#pragma unroll
    for (int p = 0; p < 2; ++p) {
        bf16x8 Qf[4];
#pragma unroll
        for (int ks = 0; ks < 4; ++ks) Qf[ks] = ld_b8(QP + (size_t)(t0 + c) * QPP + h * 256 + p * 128 + ks * 32 + rq * 8);
        float v[32];
        const LAS unsigned char* kbase = kl + (p * 128 + c) * KL_PITCH + rq * 16;
#pragma unroll
        for (int kb = 0; kb < 8; ++kb) {
            f32x4 a = (f32x4){0.f, 0.f, 0.f, 0.f};
#pragma unroll
            for (int ks = 0; ks < 4; ++ks) a = mfma16(*(const LAS bf16x8*)(kbase + kb * 16 * KL_PITCH + ks * 64), Qf[ks], a);
#pragma unroll
            for (int e = 0; e < 4; ++e) v[kb * 4 + e] = embed_idx<127u>(a[e], (unsigned)(kb * 16 + rq * 4 + e));
        }
        sortdesc<32>(v);
        float top[16];
#pragma unroll
        for (int i = 0; i < 16; ++i) top[i] = v[i];
        top16_of_group(top);
        if (rq == 0) {
#pragma unroll
            for (int it = 0; it < 16; ++it) tl[(p * 16 + c) * TL_STRIDE + it] = top[it];
        }
    }
    LDS_WAIT(); asm volatile("" ::: "memory");
    const LAS float* t0l = tl + (0 * 16 + c) * TL_STRIDE; const LAS float* t1l = tl + (16 + c) * TL_STRIDE;
    float res[16];
#pragma unroll
    for (int j = 0; j < 16; ++j) {
        const int cid = j * 4 + rq; const unsigned ab = kCandAB[cid < 50 ? cid : 0];
        const float sum = t0l[ab >> 4] + t1l[ab & 15];
        res[j] = (j < 13 && cid < 50) ? embed_idx<63u>(sum, (unsigned)cid) : NEG;
    }
    sortdesc<16>(res);
    top16_of_group(res);
    float rs2 = 0.f;
    { const float* SS2 = (const float*)(F.ws + WS_SS2) + (t0 + c);
#pragma unroll
        for (int i = 0; i < 8; ++i) rs2 += *(const GAS float*)(SS2 + (size_t)(rq * 8 + i) * T); }
    const float lsc = frsq(rq_sum(rs2) * (1.f / D) + EPS) * LOG2E;
    float den = 0.f;
#pragma unroll
    for (int it = 0; it < 16; ++it) den += fexp2((res[it] - res[0]) * lsc);
    const float rden = 1.0f / den;
#pragma unroll
    for (int it = 0; it < 16; ++it) {
        if ((it >> 2) == rq) {
            const unsigned cid = decode_idx<63u>(res[it]); const unsigned ab = kCandAB[cid];
            const unsigned i1 = decode_idx<127u>(t0l[ab >> 4]), i2 = decode_idx<127u>(t1l[ab & 15]);
            const size_t o = (size_t)(t0 + c) * 128 + h * 16 + it;
            *(GAS int*)(EXPI + o) = (int)(i1 * 128u + i2);
            *(GAS float*)(GATE + o) = fexp2((res[it] - res[0]) * lsc) * rden;
        }
    }
    LDS_WAIT(); asm volatile("" ::: "memory");
}

__device__ __forceinline__ float reduce16(const float (&p)[16], int lane) {
    const bool b5 = lane & 32, b4 = lane & 16, b3 = lane & 8, b2 = lane & 4;
    float q[8], r4[4], s2[2];
#pragma unroll
    for (int k = 0; k < 8; ++k) { const float send = b5 ? p[k] : p[k + 8], keep = b5 ? p[k + 8] : p[k]; q[k] = keep + __shfl_xor(send, 32); }
#pragma unroll
    for (int k = 0; k < 4; ++k) { const float send = b4 ? q[k] : q[k + 4], keep = b4 ? q[k + 4] : q[k]; r4[k] = keep + __shfl_xor(send, 16); }
#pragma unroll
    for (int k = 0; k < 2; ++k) { const float send = b3 ? r4[k] : r4[k + 2], keep = b3 ? r4[k + 2] : r4[k]; s2[k] = keep + __shfl_xor(send, 8); }
    const float send = b2 ? s2[0] : s2[1], keep = b2 ? s2[1] : s2[0];
    float v = keep + __shfl_xor(send, 4);
    v += __shfl_xor(v, 1); v += __shfl_xor(v, 2);
    return v;
}
struct RowBuf { u32x4 r[8]; };
__device__ __forceinline__ void rows_load(RowBuf& B, const unsigned char* tab, int ids, int lane_base, int lane) {
#pragma unroll
    for (int r = 0; r < 8; ++r) {
        const int e = __builtin_amdgcn_readlane(ids, lane_base + r);
        B.r[r] = ld_u4(tab + (size_t)e * (D / 2) + lane * 16);
    }
}
__device__ __forceinline__ float dot8f4(unsigned w, const float* hv) {
    const f32x2 a = __builtin_amdgcn_cvt_scalef32_pk_f32_fp4(w, 1.0f, 0), b = __builtin_amdgcn_cvt_scalef32_pk_f32_fp4(w, 1.0f, 1),
                c = __builtin_amdgcn_cvt_scalef32_pk_f32_fp4(w, 1.0f, 2), d = __builtin_amdgcn_cvt_scalef32_pk_f32_fp4(w, 1.0f, 3);
    return ((a[0] * hv[0] + a[1] * hv[1]) + (b[0] * hv[2] + b[1] * hv[3])) + ((c[0] * hv[4] + c[1] * hv[5]) + (d[0] * hv[6] + d[1] * hv[7]));
}
__device__ __forceinline__ float dot32(const u32x4 w, const float* hv) { return (dot8f4(w.x, hv) + dot8f4(w.y, hv + 8)) + (dot8f4(w.z, hv + 16) + dot8f4(w.w, hv + 24)); }
__device__ __forceinline__ void axpy8f4(unsigned w, float s, float* o) {
    const f32x2 a = __builtin_amdgcn_cvt_scalef32_pk_f32_fp4(w, 1.0f, 0), b = __builtin_amdgcn_cvt_scalef32_pk_f32_fp4(w, 1.0f, 1),
                c = __builtin_amdgcn_cvt_scalef32_pk_f32_fp4(w, 1.0f, 2), d = __builtin_amdgcn_cvt_scalef32_pk_f32_fp4(w, 1.0f, 3);
    o[0] += s * a[0]; o[1] += s * a[1]; o[2] += s * b[0]; o[3] += s * b[1]; o[4] += s * c[0]; o[5] += s * c[1]; o[6] += s * d[0]; o[7] += s * d[1];
}
__device__ __forceinline__ void axpy32(const u32x4 w, float s, float* o) { axpy8f4(w.x, s, o); axpy8f4(w.y, s, o + 8); axpy8f4(w.z, s, o + 16); axpy8f4(w.w, s, o + 24); }
constexpr size_t XSL_BYTES = (size_t)NEXP * 128;
constexpr int XW_S = 0, XW_SQ = 8192, XW_RS = 10240, XW_B = 10304, XW_ID = 10816, XW_BYTES = 13312;
constexpr int XZ_OFF = NWAVES * XW_BYTES, XZ_BYTES = 512;
constexpr int XG_OFF = XZ_OFF + XZ_BYTES;
typedef int i32x8 __attribute__((ext_vector_type(8)));
struct URows { u32x4 r[16]; };
__device__ __forceinline__ f32x4 reduce32to4(const float (&p)[32], int lane) {
    const bool b5 = (lane & 32) != 0, b4 = (lane & 16) != 0, b3 = (lane & 8) != 0;
    float q[16], r8[8]; f32x4 o;
#pragma unroll
    for (int k = 0; k < 16; ++k) { const float send = b5 ? p[k] : p[k + 16], keep = b5 ? p[k + 16] : p[k]; q[k] = keep + __shfl_xor(send, 32); }
#pragma unroll
    for (int k = 0; k < 8; ++k) { const float send = b4 ? q[k] : q[k + 8], keep = b4 ? q[k + 8] : q[k]; r8[k] = keep + __shfl_xor(send, 16); }
#pragma unroll
    for (int k = 0; k < 4; ++k) { const float send = b3 ? r8[k] : r8[k + 4], keep = b3 ? r8[k + 4] : r8[k]; o[k] = keep + __shfl_xor(send, 8); }
    return o;
}
#define XFENCE() asm volatile("" ::: "memory")
__device__ __forceinline__ u32x4 ldo_u4(const void* base, unsigned off) { return *(const GAS u32x4*)((const GAS unsigned char*)base + off); }
__device__ __forceinline__ u32x2 ldo_u2(const void* base, unsigned off) { return *(const GAS u32x2*)((const GAS unsigned char*)base + off); }
__device__ __forceinline__ void sto_u2(void* base, unsigned off, u32x2 v) { *(GAS u32x2*)((GAS unsigned char*)base + off) = v; }
__device__ __forceinline__ void sto_f4(void* base, unsigned off, f32x4 v) { *(GAS f32x4*)((GAS unsigned char*)base + off) = v; }
__device__ __forceinline__ void expert_phase(const Frame& F, int l, int xcc, LAS unsigned char* wl, const LAS unsigned char* zb) {
    int lane = lane_id(); asm volatile("" : "+v"(lane));
    const int c = lane & 15, rq = lane >> 4, rr = lane >> 3, pc = lane & 7;
    LAS float* SA = (LAS float*)(wl + XW_S); LAS float* SQ = (LAS float*)(wl + XW_SQ); LAS float* RS = (LAS float*)(wl + XW_RS); LAS unsigned char* BI = wl + XW_B; LAS unsigned char* IDL = wl + XW_ID;
    const unsigned char* UBl = (const unsigned char*)(F.ws + WS_UB) + (size_t)l * NEXP * (D / 2); const unsigned char* VBl = (const unsigned char*)(F.ws + WS_VB) + (size_t)l * NEXP * (D / 2);
    const unsigned* SUV = (const unsigned*)(F.ws + WS_SU) + (size_t)l * NEXP;
    const bf16* X1 = (const bf16*)(F.ws + WS_H2); bf16* XR = (bf16*)(F.ws + WS_XR);
    const int* EXPI = (const int*)(F.ws + WS_EXP); const float* GATE = (const float*)(F.ws + WS_GATE);
    const LAS float* G2 = (const LAS float*)(zb + XZ_BYTES);
    for (int tb = F.gw; tb < T; tb += 8 * F.ngw) {
        auto tok = [&](int k) { const int t = tb + k * F.ngw; return t < T ? t : tb; };
        auto slice_of = [&](int i) { return ((i >> 3) + xcc) & 7; };
        {
            float zf = 0.f; asm volatile("" : "+v"(zf)); const f32x4 z = (f32x4){zf, zf, zf, zf};
#pragma unroll
            for (int i = 0; i < 8; ++i) *(LAS f32x4*)(SA + (i * 64 + lane) * 4) = z;
#pragma unroll
            for (int i = 0; i < 2; ++i) *(LAS f32x4*)(SQ + (i * 64 + lane) * 4) = z;
#pragma unroll
            for (int k = 0; k < 8; ++k) { const u32x2 e2 = ldo_u2(EXPI + (size_t)tok(k) * 128, 8u * lane); *(LAS unsigned*)(IDL + k * 256 + lane * 4) = e2.x | (e2.y << 16); }
            const float* SS2 = (const float*)(F.ws + WS_SS2);
            float ss[8];
#pragma unroll
            for (int k = 0; k < 8; ++k) ss[k] = *(const GAS float*)(SS2 + (size_t)(lane & 31) * T + tok(k));
#pragma unroll
            for (int k = 0; k < 8; ++k) { const float tot = wave_sum(ss[k]) * 0.5f; if (lane == 0) RS[k] = frsq(tot * (1.f / D) + EPS); }
            LDS_WAIT(); XFENCE();
        }
#ifndef U_REP
#define U_REP 1
#endif
#ifndef V_REP
#define V_REP 1
#endif
        for (int urep = 0; urep < U_REP; ++urep) {
            if (urep) { float zf = 0.f; asm volatile("" : "+v"(zf)); const f32x4 z = (f32x4){zf, zf, zf, zf};
#pragma unroll
                for (int i = 0; i < 8; ++i) *(LAS f32x4*)(SA + (i * 64 + lane) * 4) = z;
                LDS_WAIT(); XFENCE(); }
            const LAS unsigned char* bbase = c < 2 ? BI + c * 128 + rq * 32 : zb;
            LAS unsigned char* bw = BI + (lane >> 5) * 256 + (((lane & 31) >> 2) & 3) * 32 + ((lane & 31) >> 4) * 16 + (lane & 3) * 4;
            auto u_x = [&](int i) { return ldo_u2(X1 + (size_t)tok(i & 7) * D + slice_of(i) * 256, 8u * lane); };
            struct HRows { u32x4 r[8]; };
            auto u_rows_h = [&](int hs, HRows& H) {
                const int i = hs >> 1, mg = hs & 1;
                const unsigned char* Usl = UBl + (size_t)slice_of(i) * XSL_BYTES;
                const u32x2 id = *(const LAS u32x2*)(IDL + (i & 7) * 256 + c * 16 + mg * 8);
#ifdef U_PROBE_MASK
                const unsigned pm = (U_REP > 1 && urep == 0) ? (unsigned)(U_PROBE_MASK) : 0xffffu;
#else
                const unsigned pm = 0xffffu;
#endif
                const unsigned i0 = id.x, i1 = id.y;
#pragma unroll
                for (int mm = 0; mm < 4; ++mm) { const unsigned w = mm < 2 ? i0 : i1; const unsigned e = (mm & 1) ? (w >> 16) : (w & 0xffffu); const unsigned off = (e & pm) * 128u + 16u * rq;
                    H.r[2 * mm] = ldo_u4(Usl, off); H.r[2 * mm + 1] = ldo_u4(Usl + 64, off); }
            };
            i32x8 B0, B1;
            auto u_bbuild = [&](int i, const u32x2& xw) {
                const int k = i & 7;
                const f32x4 gg = *(const LAS f32x4*)(G2 + slice_of(i) * 256 + 4 * lane);
                const float rstd = RS[k];
                const float h0 = bf_lo(xw.x) * rstd * gg[0], h1 = bf_hi(xw.x) * rstd * gg[1], h2 = bf_lo(xw.y) * rstd * gg[2], h3 = bf_hi(xw.y) * rstd * gg[3];
                int w = __builtin_amdgcn_cvt_pk_fp8_f32(h0, h1, 0, false); w = __builtin_amdgcn_cvt_pk_fp8_f32(h2, h3, w, true);
                const f32x2 b0 = __builtin_amdgcn_cvt_pk_f32_fp8(w, false), b1 = __builtin_amdgcn_cvt_pk_f32_fp8(w, true);
                int v = __builtin_amdgcn_cvt_pk_fp8_f32(h0 - b0[0], h1 - b0[1], 0, false); v = __builtin_amdgcn_cvt_pk_fp8_f32(h2 - b1[0], h3 - b1[1], v, true);
                *(LAS int*)(bw) = w; *(LAS int*)(bw + 128) = v;
                LDS_WAIT(); XFENCE();
                const u32x4 b0l = *(const LAS u32x4*)(bbase), b0h = *(const LAS u32x4*)(bbase + 16), b1l = *(const LAS u32x4*)(bbase + 256), b1h = *(const LAS u32x4*)(bbase + 272);
                B0 = (i32x8){(int)b0l.x, (int)b0l.y, (int)b0l.z, (int)b0l.w, (int)b0h.x, (int)b0h.y, (int)b0h.z, (int)b0h.w};
                B1 = (i32x8){(int)b1l.x, (int)b1l.y, (int)b1l.z, (int)b1l.w, (int)b1h.x, (int)b1h.y, (int)b1h.z, (int)b1h.w};
            };
            auto u_comp_h = [&](int hs, HRows& H) {
                const int k = (hs >> 1) & 7, mg = hs & 1;
                LAS f32x4* tp = (LAS f32x4*)(SA + k * 256 + (c & 1) * 16 + 4 * rq) + mg * 32;
                f32x4 acc[4];
#pragma unroll
                for (int mm = 0; mm < 4; ++mm) acc[mm] = (f32x4){0.f, 0.f, 0.f, 0.f};
                if (c < 2) {
#pragma unroll
                    for (int mm = 0; mm < 4; ++mm) acc[mm] = tp[mm * 8];
                }
#pragma unroll
                for (int mm = 0; mm < 4; ++mm) {
                    const i32x8 a0 = {(int)H.r[2 * mm].x, (int)H.r[2 * mm].y, (int)H.r[2 * mm].z, (int)H.r[2 * mm].w, 0, 0, 0, 0};
                    const i32x8 a1 = {(int)H.r[2 * mm + 1].x, (int)H.r[2 * mm + 1].y, (int)H.r[2 * mm + 1].z, (int)H.r[2 * mm + 1].w, 0, 0, 0, 0};
                    acc[mm] = __builtin_amdgcn_mfma_scale_f32_16x16x128_f8f6f4(a0, B0, acc[mm], 4, 0, 0, 0x7F7F7F7F, 0, 0x7F7F7F7F);
                    acc[mm] = __builtin_amdgcn_mfma_scale_f32_16x16x128_f8f6f4(a1, B1, acc[mm], 4, 0, 0, 0x7F7F7F7F, 0, 0x7F7F7F7F);
                }
                if (c < 2) {
#pragma unroll
                    for (int mm = 0; mm < 4; ++mm) tp[mm * 8] = acc[mm];
                }
            };
            HRows H0, H1, H2, H3;
            u32x2 xe, xo;
            xe = u_x(0);
            u_rows_h(0, H0); u_rows_h(1, H1); u_rows_h(2, H2);
            xo = u_x(1);
            XFENCE();
#pragma unroll 1
            for (int hs = 0; hs < 128; hs += 4) {
                const int i = hs >> 1;
                const int h3 = hs + 3, h4 = hs + 4 < 128 ? hs + 4 : 127, h5 = hs + 5 < 128 ? hs + 5 : 127, h6 = hs + 6 < 128 ? hs + 6 : 127;
                u_rows_h(h3, H3);
                XFENCE();
                u_bbuild(i, xe); u_comp_h(hs, H0);
                XFENCE();
                u_rows_h(h4, H0); xe = u_x(i + 2 < 64 ? i + 2 : 63);
                XFENCE();
                u_comp_h(hs + 1, H1);
                XFENCE();
                u_rows_h(h5, H1);
                XFENCE();
                u_bbuild(i + 1, xo); u_comp_h(hs + 2, H2);
                XFENCE();
                u_rows_h(h6, H2); xo = u_x(i + 3 < 64 ? i + 3 : 63);
                XFENCE();
                u_comp_h(hs + 3, H3);
                XFENCE();
            }
        }
        LDS_WAIT(); XFENCE();
        {
            unsigned suvq[8][2]; float gtq[8][2];
#pragma unroll
            for (int k = 0; k < 8; ++k)
#pragma unroll
                for (int hf = 0; hf < 2; ++hf) { const unsigned e = *(const LAS unsigned short*)(IDL + k * 256 + (hf * 64 + lane) * 2);
                    suvq[k][hf] = *(const GAS unsigned*)(SUV + e); gtq[k][hf] = *(const GAS float*)(GATE + (size_t)tok(k) * 128 + hf * 64 + lane); }
#pragma unroll
            for (int k = 0; k < 8; ++k) {
                float wq[2];
#pragma unroll
                for (int hf = 0; hf < 2; ++hf) {
                    const unsigned suv = suvq[k][hf];
                    const int kk = hf * 64 + lane;
                    const float a = (SA[k * 256 + (kk & 7) * 32 + (kk >> 3)] + SA[k * 256 + (kk & 7) * 32 + 16 + (kk >> 3)]) * bf_lo(suv);
                    wq[hf] = gtq[k][hf] * bf_hi(suv) * 0.5f * a * (1.0f + erff(a * 0.7071067811865476f));
                }
                XFENCE();
                float wm = fmaxf(__builtin_fabsf(wq[0]), __builtin_fabsf(wq[1]));
#pragma unroll
                for (int o = 1; o < 64; o <<= 1) wm = fmaxf(wm, __shfl_xor(wm, o));
                const float sc = __builtin_bit_cast(float, __builtin_bit_cast(unsigned, fminf(42.0f / fmaxf(wm, 1e-30f), 1.0e18f)) & 0x7f800000u);
                const unsigned h0 = (unsigned)__builtin_bit_cast(unsigned short, (_Float16)(wq[0] * sc)), h1 = (unsigned)__builtin_bit_cast(unsigned short, (_Float16)(wq[1] * sc));
                ((LAS unsigned*)SA)[k * 256 + lane] = h0 | (h0 << 16); ((LAS unsigned*)SA)[k * 256 + 64 + lane] = h1 | (h1 << 16);
                if (lane == 0) RS[8 + k] = 1.0f / sc;
            }
        }
        LDS_WAIT(); XFENCE();
        for (int vrep = 0; vrep < V_REP; ++vrep) {
            if (vrep) { float zf = 0.f; asm volatile("" : "+v"(zf)); const f32x4 z = (f32x4){zf, zf, zf, zf};
#pragma unroll
                for (int i = 0; i < 2; ++i) *(LAS f32x4*)(SQ + (i * 64 + lane) * 4) = z;
                LDS_WAIT(); XFENCE(); }
            auto v_rows = [&](int i, URows& R) {
                const unsigned char* Vsl = VBl + (size_t)slice_of(i) * XSL_BYTES;
                const u32x4 ia = *(const LAS u32x4*)(IDL + (i & 7) * 256 + rr * 32), ib = *(const LAS u32x4*)(IDL + (i & 7) * 256 + rr * 32 + 16);
#pragma unroll
                for (int j = 0; j < 16; ++j) { const unsigned w = j < 8 ? ia[(j >> 1) & 3] : ib[(j >> 1) & 3]; const unsigned e = (j & 1) ? (w >> 16) : (w & 0xffffu);
                    R.r[j] = ldo_u4(Vsl, e * 128u + 16u * pc); }
            };
            auto v_comp = [&](int i, const URows& R) {
                const int k = i & 7, t = tok(k), sl = slice_of(i);
                const unsigned col = 32u * pc + 4u * rr;
                u32x2 xw;
                typedef _Float16 hf2 __attribute__((ext_vector_type(2)));
                const LAS u32x4* wp = (const LAS u32x4*)(SA + k * 256 + 16 * rr);
                const u32x4 wall[4] = {wp[0], wp[1], wp[2], wp[3]};
                unsigned out[16];
#pragma unroll
                for (int j = 0; j < 16; ++j) out[j] = 0u;
#pragma unroll
                for (int j = 0; j < 16; ++j) {
                    if (j == 8) xw = ldo_u2(X1 + (size_t)t * D + sl * 256, 2u * col);
                    u32x4 rj = R.r[j];
                    asm volatile("" : "+v"(rj.x), "+v"(rj.y), "+v"(rj.z), "+v"(rj.w) :: "memory");
                    const unsigned wj = wall[j >> 2][j & 3]; const hf2 w2 = __builtin_bit_cast(hf2, wj);
#pragma unroll
                    for (int d = 0; d < 4; ++d) {
                        const hf2 a = __builtin_amdgcn_cvt_scalef32_pk_f16_fp4(rj[d], 1.0f, 0), b = __builtin_amdgcn_cvt_scalef32_pk_f16_fp4(rj[d], 1.0f, 1),
                                  cc = __builtin_amdgcn_cvt_scalef32_pk_f16_fp4(rj[d], 1.0f, 2), dd = __builtin_amdgcn_cvt_scalef32_pk_f16_fp4(rj[d], 1.0f, 3);
                        out[4 * d] = __builtin_bit_cast(unsigned, __builtin_elementwise_fma(a, w2, __builtin_bit_cast(hf2, out[4 * d])));
                        out[4 * d + 1] = __builtin_bit_cast(unsigned, __builtin_elementwise_fma(b, w2, __builtin_bit_cast(hf2, out[4 * d + 1])));
                        out[4 * d + 2] = __builtin_bit_cast(unsigned, __builtin_elementwise_fma(cc, w2, __builtin_bit_cast(hf2, out[4 * d + 2])));
                        out[4 * d + 3] = __builtin_bit_cast(unsigned, __builtin_elementwise_fma(dd, w2, __builtin_bit_cast(hf2, out[4 * d + 3])));
                    }
                    if ((j & 3) == 3) asm volatile("" : "+v"(out[0]), "+v"(out[1]), "+v"(out[2]), "+v"(out[3]), "+v"(out[4]), "+v"(out[5]), "+v"(out[6]), "+v"(out[7]), "+v"(out[8]), "+v"(out[9]), "+v"(out[10]), "+v"(out[11]), "+v"(out[12]), "+v"(out[13]), "+v"(out[14]), "+v"(out[15]) :: "memory");
                }
                unsigned o2[2];
                {
                    const bool b5 = (lane & 32) != 0, b4 = (lane & 16) != 0, b3 = (lane & 8) != 0;
                    unsigned q8[8], q4[4];
                    auto hadd = [](unsigned x, unsigned y) { return __builtin_bit_cast(unsigned, __builtin_bit_cast(hf2, x) + __builtin_bit_cast(hf2, y)); };
#pragma unroll
                    for (int n = 0; n < 8; ++n) { const unsigned send = b5 ? out[n] : out[n + 8], keep = b5 ? out[n + 8] : out[n]; q8[n] = hadd(keep, (unsigned)__shfl_xor((int)send, 32)); }
#pragma unroll
                    for (int n = 0; n < 4; ++n) { const unsigned send = b4 ? q8[n] : q8[n + 4], keep = b4 ? q8[n + 4] : q8[n]; q4[n] = hadd(keep, (unsigned)__shfl_xor((int)send, 16)); }
#pragma unroll
                    for (int n = 0; n < 2; ++n) { const unsigned send = b3 ? q4[n] : q4[n + 2], keep = b3 ? q4[n + 2] : q4[n]; o2[n] = hadd(keep, (unsigned)__shfl_xor((int)send, 8)); }
                }
                const float isc = RS[8 + k];
                const hf2 oa = __builtin_bit_cast(hf2, o2[0]), ob = __builtin_bit_cast(hf2, o2[1]);
                const float y0 = bf_lo(xw.x) + (float)oa[0] * isc, y1 = bf_hi(xw.x) + (float)oa[1] * isc, y2 = bf_lo(xw.y) + (float)ob[0] * isc, y3 = bf_hi(xw.y) + (float)ob[1] * isc;
                if (l + 1 < DEPTH) {
                    u32x2 w; w.x = pk2(y0, y1); w.y = pk2(y2, y3);
                    sto_u2(XR + (size_t)t * D + sl * 256, 2u * col, w);
                    const float s = (y0 * y0 + y1 * y1) + (y2 * y2 + y3 * y3);
                    (void)__hip_atomic_fetch_add(SQ + k * 64 + lane, s, __ATOMIC_RELAXED, __HIP_MEMORY_SCOPE_WAVEFRONT);
                } else sto_f4(F.out + (size_t)t * D + sl * 256, 4u * col, (f32x4){y0, y1, y2, y3});
            };
            URows RA, RB;
            v_rows(0, RA);
            XFENCE();
#pragma unroll 1
            for (int i = 0; i < 64; i += 2) {
                const int i2 = i + 2 < 64 ? i + 2 : 63;
                v_rows(i + 1, RB);
                XFENCE();
                v_comp(i, RA);
                XFENCE();
                v_rows(i2, RA);
                XFENCE();
                v_comp(i + 1, RB);
                XFENCE();
            }
        }
        if (l + 1 < DEPTH) {
            asm volatile("s_waitcnt vmcnt(0) lgkmcnt(0)" ::: "memory");
            const float* g = F.norm1_g + (l + 1) * D;
            f32x4 ga[4], gb[4]; u32x4 xa[4], xb[4];
#pragma unroll
            for (int q = 0; q < 4; ++q) { ga[q] = ld_f4(g + (q * 64 + lane) * 8); gb[q] = ld_f4(g + (q * 64 + lane) * 8 + 4); xa[q] = ld_u4(XR + (size_t)tok(0) * D + (q * 64 + lane) * 8); }
            auto emit = [&](int k, const u32x4 (&xw)[4]) {
                const float r1 = frsq(wave_sum(SQ[k * 64 + lane]) * (1.f / D) + EPS);
                bf16* HN = (bf16*)(F.ws + WS_HN) + (size_t)tok(k) * D;
#pragma unroll
                for (int q = 0; q < 4; ++q) { const f32x4 a = ga[q], b = gb[q];
                    u32x4 o; o.x = pk2(bf_lo(xw[q].x) * r1 * a[0], bf_hi(xw[q].x) * r1 * a[1]); o.y = pk2(bf_lo(xw[q].y) * r1 * a[2], bf_hi(xw[q].y) * r1 * a[3]);
                    o.z = pk2(bf_lo(xw[q].z) * r1 * b[0], bf_hi(xw[q].z) * r1 * b[1]); o.w = pk2(bf_lo(xw[q].w) * r1 * b[2], bf_hi(xw[q].w) * r1 * b[3]);
                    st_u4(HN + (q * 64 + lane) * 8, o); }
            };
#pragma unroll 1
            for (int k = 0; k < 8; k += 2) {
#pragma unroll
                for (int q = 0; q < 4; ++q) xb[q] = ld_u4(XR + (size_t)tok(k + 1) * D + (q * 64 + lane) * 8);
                XFENCE();
                emit(k, xa);
                XFENCE();
#pragma unroll
                for (int q = 0; q < 4; ++q) xa[q] = ld_u4(XR + (size_t)tok(k + 2 < 8 ? k + 2 : 7) * D + (q * 64 + lane) * 8);
                XFENCE();
                emit(k + 1, xb);
                XFENCE();
            }
        }
        LDS_WAIT(); XFENCE();
    }
}

#ifndef PG8_SP2
#define PG8_SP2 true
#endif
#ifndef PG8_ALIGN
#define PG8_ALIGN true
#endif
struct Args { const float* in[14]; float* out; unsigned char* ws; int ph_lo, ph_hi, use_bar, pad; };
__global__ void __launch_bounds__(NWAVES * 64, 2) hybrid_fwd(Args args) {
    extern __shared__ __attribute__((aligned(16))) unsigned char lds_raw[];
    Frame F;
    F.lds = (LAS unsigned char*)lds_raw;
    F.wave = __builtin_amdgcn_readfirstlane((int)threadIdx.x >> 6);
    F.G = gridDim.x; F.gw = blockIdx.x * NWAVES + F.wave; F.ngw = F.G * NWAVES;
    F.x = args.in[0]; F.norm1_g = args.in[1]; F.w_in = args.in[2]; F.qa_g = args.in[3]; F.ka_g = args.in[4]; F.rel_bias = args.in[5]; F.attn_g = args.in[6]; F.ret_g = args.in[7];
    F.w_out = args.in[8]; F.norm2_g = args.in[9]; F.peer_wq = args.in[10]; F.peer_keys = args.in[11]; F.peer_u = args.in[12]; F.peer_v = args.in[13];
    F.out = args.out; F.ws = args.ws;
    for (int u = threadIdx.x; u < (LDS_BYTES - LDSCTL_OFF) / 4; u += NWAVES * 64) ((LAS unsigned*)(F.lds + LDSCTL_OFF))[u] = 0u;
    __syncthreads();
    unsigned* barw = (unsigned*)(args.ws + WS_CTL) + CW_BAR;
    XcdBarrier bar; bar.bar = barw; bar.x = 0; bar.st = nullptr;
    if (args.use_bar) bar = xcd_barrier_post(barw, (volatile LAS unsigned*)(F.lds + MISC_OFF) + 8);
    const int lo = args.ph_lo, hi = args.ph_hi;
#define IN(k) (lo <= (k) && (k) < hi)
#define SEAM(k) do { if (IN((k) + 1)) xcd_barrier(bar, F.wave); } while (0)

#ifndef REP_MASK
#define REP_MASK 0
#endif
#ifndef REP_N
#define REP_N 1
#endif
#define REPS(k) (((REP_MASK >> (k)) & 1) ? REP_N : 1)
#ifndef ONLY
#define PH_ON(k) 1
#else
#define PH_ON(k) ((k)==ONLY)
#endif
    if (PH_ON(0) && IN(0)) { for (int rep = 0; rep < REPS(0); ++rep) p0_prologue(F); SEAM(0); }

    for (int l = 0; l < DEPTH; ++l) {
        const int pb = 1 + l * PH_PER_LAYER;
        if (PH_ON(1) && IN(pb + 0)) for (int rep = 0; rep < REPS(1); ++rep) {
            {
                pg8::Gemm g{(const pg8::bf16_t*)(F.ws + WS_HN), (const pg8::bf16_t*)(F.ws + WS_WTOK) + (size_t)l * TOKC * D, T, TOKC, D};
                pg8::StaticOrder So; So.init(T, TOKC, F.G, (int)blockIdx.x);
                pg8::EpiTok E{(pg8::bf16_t*)(F.ws + WS_TOK), (const pg8::f32x2*)(F.ws + WS_ROPE_TOK), (float*)(F.ws + WS_SSQ)};
                pg8::gemm_phase<pg8::EpiTok, pg8::StaticOrder, PG8_ALIGN, PG8_SP2>(F.lds + RING_OFF, g, So, E, F.wave);
            }
            {
                pg8::Gemm g{(const pg8::bf16_t*)(F.ws + WS_WSWP) + (size_t)l * SWPR * D, (const pg8::bf16_t*)(F.ws + WS_HN), SWPR, T, D};
                pg8::StaticOrder So; So.init(SWPR, T, F.G, (int)blockIdx.x);
                pg8::EpiB16 E{(pg8::bf16_t*)(F.ws + WS_SWP), SWPP};
                pg8::gemm_phase<pg8::EpiB16, pg8::StaticOrder, PG8_ALIGN, PG8_SP2>(F.lds + RING_OFF, g, So, E, F.wave);
            }
            SEAM(pb + 0);
        }
        if (PH_ON(2) && IN(pb + 1)) for (int rep = 0; rep < REPS(2); ++rep) {
            LAS float* biasL = (LAS float*)(F.lds + RING_OFF + A_BIAS);
            int tid2 = F.wave * 64 + lane_id(); asm volatile("" : "+v"(tid2));
            for (int i = tid2; i < NH * 257; i += NWAVES * 64) biasL[i] = *(const GAS float*)(F.rel_bias + (size_t)l * NH * 257 + i) * LOG2E;
#ifndef SCAN_REP
#define SCAN_REP 1
#endif
            for (int srep = 0; srep < SCAN_REP; ++srep)
            for (int task = F.gw; task < NBATCH * NH * 8 * 2; task += F.ngw) scan_task(F, task);
            {
                constexpr int NAT = NBATCH * NH * 8;
                const int g = (int)blockIdx.x;
                if (F.G == 256) {
                    const int n = g < 128 ? 1 : 3, first = g < 128 ? g : 128 + (g - 128) * 3;
                    for (int i = 0; i < n; ++i) attn_wg_task(F, l, first + i);
                } else {
                    for (int task = g; task < NAT; task += F.G) attn_wg_task(F, l, task);
                }
            }
            SEAM(pb + 1);
        }
        if (PH_ON(3) && IN(pb + 2)) for (int rep = 0; rep < REPS(3); ++rep) {
            for (int task = F.gw; task < NBATCH * NH * NCH * 2; task += F.ngw) ret_task(F, l, task);
            SEAM(pb + 2);
        }
        if (PH_ON(4) && IN(pb + 3)) for (int rep = 0; rep < REPS(4); ++rep) {
            pg8::Gemm g{(const pg8::bf16_t*)(F.ws + WS_MIX), (const pg8::bf16_t*)(F.ws + WS_WOUT) + (size_t)l * D * D, T, D, D};
            pg8::StaticOrder So; So.init(T, D, F.G, (int)blockIdx.x);
            pg8::EpiRes E{l == 0 ? F.x : (const float*)nullptr, (const pg8::bf16_t*)(F.ws + WS_XR), (pg8::bf16_t*)(F.ws + WS_H2), (float*)(F.ws + WS_SS2)};
            pg8::gemm_phase<pg8::EpiRes, pg8::StaticOrder, PG8_ALIGN, PG8_SP2>(F.lds + RING_OFF, g, So, E, F.wave);
            SEAM(pb + 3);
        }
        if (PH_ON(6) && IN(pb + 5)) for (int rep = 0; rep < REPS(6); ++rep) {
            pg8::Gemm g{(const pg8::bf16_t*)(F.ws + WS_H2), (const pg8::bf16_t*)(F.ws + WS_WQ) + (size_t)l * D * D, T, D, D};
            pg8::StaticOrder So; So.init(T, D, F.G, (int)blockIdx.x);
            pg8::EpiB16 E{(pg8::bf16_t*)(F.ws + WS_QP), QPP};
            pg8::gemm_phase<pg8::EpiB16, pg8::StaticOrder, PG8_ALIGN, PG8_SP2>(F.lds + RING_OFF, g, So, E, F.wave);
            SEAM(pb + 5);
        }
        if (PH_ON(7) && IN(pb + 6)) for (int rep = 0; rep < REPS(7); ++rep) {
            LAS unsigned char* kl = F.lds + RING_OFF; LAS float* tl = (LAS float*)(F.lds + RING_OFF + KL_BYTES) + F.wave * TL_WAVE_FLOATS;
            int tid3 = F.wave * 64 + lane_id(); asm volatile("" : "+v"(tid3));
            const bf16* KEYS = (const bf16*)(F.ws + WS_KEYS) + (size_t)l * 8 * 256 * 128;
            for (int wt = blockIdx.x; wt < 256; wt += F.G) {
                const int tg = wt >> 1, hg = wt & 1;
                for (int hi = 0; hi < 4; ++hi) {
                    const int h = hg * 4 + hi;
                    __syncthreads();
#pragma unroll
                    for (int i = 0; i < 8; ++i) { const int idx = tid3 + 512 * i, row = idx >> 4, c16 = idx & 15;
                        *(LAS u32x4*)(kl + row * KL_PITCH + c16 * 16) = ld_u4(KEYS + ((size_t)h * 256 + row) * 128 + c16 * 8); }
                    __syncthreads();
                    topk_task(F, l, tg * 8 + F.wave, h, kl, tl);
                }
            }
            SEAM(pb + 6);
        }
        if (PH_ON(8) && IN(pb + 7)) for (int rep = 0; rep < REPS(8); ++rep) {
            LAS unsigned char* wl = F.lds + RING_OFF + F.wave * XW_BYTES; const LAS unsigned char* zb = F.lds + RING_OFF + XZ_OFF;
            { int tid4 = F.wave * 64 + lane_id(); asm volatile("" : "+v"(tid4)); for (int i = tid4; i < XZ_BYTES / 4; i += NWAVES * 64) ((LAS unsigned*)zb)[i] = 0u;
              for (int i = tid4; i < D; i += NWAVES * 64) ((LAS float*)(F.lds + RING_OFF + XG_OFF))[i] = *(const GAS float*)(F.norm2_g + l * D + i); }
            __syncthreads();
            expert_phase(F, l, (int)xb_xcc_id(), wl, zb);
            SEAM(pb + 7);
        }
    }
#undef IN
#undef SEAM
}

extern "C" void kernel_launch(void* const* d_in, const int* in_sizes, int n_in, void* d_out, int out_size, void* d_ws, size_t ws_size, hipStream_t stream) {
    static int grid = 0;
    if (grid == 0) {
        if (n_in != 14 || in_sizes[0] != T * D || out_size != T * D || ws_size < WS_END) {
            fprintf(stderr, "kernel_launch: unexpected problem (n_in %d, in0 %d, out %d, ws %zu; need ws >= %zu); nothing launched\n", n_in, n_in > 0 ? in_sizes[0] : -1, out_size, ws_size, (size_t)WS_END); grid = -1; return; }
        int dev = 0, cus = 0, per_cu = 0;
        if (hipGetDevice(&dev) != hipSuccess || hipDeviceGetAttribute(&cus, hipDeviceAttributeMultiprocessorCount, dev) != hipSuccess) { fprintf(stderr, "kernel_launch: device query failed\n"); grid = -1; return; }
        if (hipFuncSetAttribute((const void*)hybrid_fwd, hipFuncAttributeMaxDynamicSharedMemorySize, LDS_BYTES) != hipSuccess) { fprintf(stderr, "kernel_launch: hipFuncSetAttribute failed\n"); grid = -1; return; }
        if (hipOccupancyMaxActiveBlocksPerMultiprocessor(&per_cu, (const void*)hybrid_fwd, NWAVES * 64, LDS_BYTES) != hipSuccess || per_cu < 1)
            fprintf(stderr, "kernel_launch: note: occupancy query reports %d workgroups per CU\n", per_cu);
        (void)hipGetLastError();
        grid = cus;
    }
    if (grid < 0) return;
    if (hipMemsetAsync((char*)d_ws + WS_CTL, 0, CTL_ZERO_BYTES, stream) != hipSuccess) { fprintf(stderr, "kernel_launch: memset failed\n"); return; }
    Args a{};
    for (int i = 0; i < 14; ++i) a.in[i] = (const float*)d_in[i];
    a.out = (float*)d_out; a.ws = (unsigned char*)d_ws; a.pad = 0;
#if MK_ONE_LAUNCH
    a.ph_lo = 0; a.ph_hi = N_PHASES; a.use_bar = 1;
    hipLaunchKernelGGL(hybrid_fwd, dim3(grid), dim3(NWAVES * 64), LDS_BYTES, stream, a);
    { const hipError_t le = hipPeekAtLastError(); if (le != hipSuccess) fprintf(stderr, "kernel_launch: launch failed: %s\n", hipGetErrorName(le)); }
#else
    for (int p = 0; p < N_PHASES; ++p) {
        a.ph_lo = p; a.ph_hi = p + 1; a.use_bar = 0;
        hipLaunchKernelGGL(hybrid_fwd, dim3(grid), dim3(NWAVES * 64), LDS_BYTES, stream, a);
        const hipError_t le = hipPeekAtLastError(); if (le != hipSuccess) { fprintf(stderr, "kernel_launch: launch %d failed: %s\n", p, hipGetErrorName(le)); break; }
    }
#endif
}
```

```cpp
#include <hip/hip_runtime.h>
#include <cstdio>
#include <cstdint>

#ifndef MK_ONE_LAUNCH
#define MK_ONE_LAUNCH 1
#endif

namespace pg8 {
#define PG8_LAS __attribute__((address_space(3)))
typedef unsigned short bf16_t;
typedef short bf16x8 __attribute__((ext_vector_type(8)));
typedef float f32x4 __attribute__((ext_vector_type(4)));
typedef unsigned u32x4 __attribute__((ext_vector_type(4)));
constexpr int BM = 256, BK = 64, HALF = 128, HTB = HALF * BK * 2  , STAGE_BYTES = 8 * HTB, NXCD = 8, WGM = 8;

__host__ __device__ __forceinline__ int lds_byte(int r, int c) { const int st = (r >> 4) * 2 + (c >> 5), rr = r & 15, cc = c & 31, ob = rr * 64 + cc * 2; return st * 1024 + (ob ^ (((ob >> 9) & 1) << 5)); }
__host__ __device__ __forceinline__ void stage_rc(int b, int& R, int& C) { const int st = b / 1024, sb = b % 1024, swz = sb ^ (((sb >> 9) & 1) << 5); R = (st >> 1) * 16 + swz / 64; C = (st & 1) * 32 + (swz % 64) / 2; }
__host__ __device__ __forceinline__ int perm32(int rho) { const int n = rho >> 4, i = rho & 15; return 8 * (i >> 2) + 4 * n + (i & 3); }

struct Unit { int pm, pn; };
struct Gemm { const bf16_t* A; const bf16_t* Bt; int M, N, K; };

struct StaticOrder {
    int nM, nN, nwg, G, c;
    __host__ __device__ void init(int M, int N, int G_, int c_) { nM = M / BM; nN = N / BM; nwg = nM * nN; G = G_; c = c_; }
    __host__ __device__ bool next(int i, Unit& u) const {
        const long L = (long)i * G + c; if (L >= nwg) return false;
        int wgid = (int)L; { const int q = nwg / NXCD, r = nwg % NXCD, xcd = wgid % NXCD, off = wgid / NXCD; wgid = (xcd < r ? xcd * (q + 1) : r * (q + 1) + (xcd - r) * q) + off; }
        const int nig = WGM * nN, gid = wgid / nig, fm = gid * WGM, gsz = (nM - fm) < WGM ? (nM - fm) : WGM;
        u.pm = fm + ((wgid % nig) % gsz); u.pn = (wgid % nig) / gsz; return true;
    }
    __device__ __forceinline__ void a_ready(const Unit&) const {}
    __device__ __forceinline__ void done(const Unit&) const {}
};
__device__ __forceinline__ unsigned cvt_pk_bf16(float lo, float hi) { unsigned r; asm volatile("v_cvt_pk_bf16_f32 %0, %1, %2" : "=v"(r) : "v"(lo), "v"(hi)); return r; }

typedef float f32x2 __attribute__((ext_vector_type(2)));
constexpr int MT = 16384, MS = 2048;
constexpr int TOKC = 5120;
constexpr int TOKP = 5248, SWPP = 16512, QPP = 2176;
constexpr float KSCALE = 0.08838834764831845f;
__device__ __forceinline__ float lg2gamma(int h) {
    return h == 0 ? -0.04580368961312479f : h == 1 ? -0.02272007650008353f : h == 2 ? -0.011315313227834146f : h == 3 ? -0.005646563141142063f :
           h == 4 ? -0.0028205190623786626f : h == 5 ? -0.0014095702546713536f : h == 6 ? -0.0007046129765893727f : -0.0003522634716290214f;
}

struct EpiTok {
    static constexpr bool PERM = true, AFTER_DRAIN = false;
    bf16_t* O; const f32x2* cs; float* ssq; const float* rstd;
    __device__ __forceinline__ void operator()(const f32x4 (&acc)[2][2][4][2], const Unit& u, int wr, int wc, int fr, int fq) const {
        const int row0 = u.pm * BM + wr * 64 + fr, kind = u.pn >> 2;
#pragma unroll
        for (int ai = 0; ai < 2; ++ai)
#pragma unroll
            for (int m = 0; m < 4; ++m) {
                const int row = row0 + ai * HALF + m * 16, pos = row & (MS - 1);
                const float rs = rstd[row];
#pragma unroll
                for (int bj = 0; bj < 2; ++bj) {
                    const int c0 = u.pn * BM + bj * HALF + wc * 32 + 8 * fq;
                    f32x4 v0 = acc[ai][bj][m][0] * rs, v1 = acc[ai][bj][m][1] * rs;
                    if (kind <= 1) {
                        float s = (v0[0] * v0[0] + v0[1] * v0[1]) + (v0[2] * v0[2] + v0[3] * v0[3]) + (v1[0] * v1[0] + v1[1] * v1[1]) + (v1[2] * v1[2] + v1[3] * v1[3]);
                        s += __shfl_xor(s, 16); s += __shfl_xor(s, 32);
                        const int head = (u.pn & 3) * 2 + bj;
                        if (fq == 0) ssq[(size_t)((kind * 8 + head) * 4 + wc) * MT + row] = s;
                    } else if (kind <= 3) {
                        const int i0 = (c0 & 127) >> 1;
                        const f32x4 csa = *(const f32x4*)(cs + (size_t)pos * 64 + i0), csb = *(const f32x4*)(cs + (size_t)pos * 64 + i0 + 2);
                        const float sc = (kind == 3) ? KSCALE : 1.0f;
                        f32x4 w0, w1;
                        w0[0] = (v0[0] * csa[0] - v0[1] * csa[1]) * sc; w0[1] = (v0[1] * csa[0] + v0[0] * csa[1]) * sc;
                        w0[2] = (v0[2] * csa[2] - v0[3] * csa[3]) * sc; w0[3] = (v0[3] * csa[2] + v0[2] * csa[3]) * sc;
                        w1[0] = (v1[0] * csb[0] - v1[1] * csb[1]) * sc; w1[1] = (v1[1] * csb[0] + v1[0] * csb[1]) * sc;
                        w1[2] = (v1[2] * csb[2] - v1[3] * csb[3]) * sc; w1[3] = (v1[3] * csb[2] + v1[2] * csb[3]) * sc;
                        v0 = w0; v1 = w1;
                    } else {
#pragma unroll
                        for (int j = 0; j < 4; ++j) { v0[j] = v0[j] * __builtin_amdgcn_rcpf(1.0f + __builtin_amdgcn_exp2f(-1.4426950408889634f * v0[j]));
                                                      v1[j] = v1[j] * __builtin_amdgcn_rcpf(1.0f + __builtin_amdgcn_exp2f(-1.4426950408889634f * v1[j])); }
                    }
                    u32x4 w; w.x = cvt_pk_bf16(v0[0], v0[1]); w.y = cvt_pk_bf16(v0[2], v0[3]); w.z = cvt_pk_bf16(v1[0], v1[1]); w.w = cvt_pk_bf16(v1[2], v1[3]);
                    *(u32x4*)(O + (size_t)row * TOKP + c0) = w;
                }
            }
    }
};
struct EpiRes {
    static constexpr bool PERM = false, AFTER_DRAIN = false;
    const float* R32; const bf16_t* R16; bf16_t* XB; float* ss2;
    __device__ __forceinline__ void operator()(const f32x4 (&acc)[2][2][4][2], const Unit& u, int wr, int wc, int fr, int fq) const {
        const int row0 = u.pm * BM + wr * 64 + fr, col0 = u.pn * BM + wc * 32 + 4 * fq;
#pragma unroll
        for (int ai = 0; ai < 2; ++ai)
#pragma unroll
            for (int m = 0; m < 4; ++m) { const int row = row0 + ai * HALF + m * 16; const size_t ro = (size_t)row * 2048 + col0;
                float s = 0.f;
#pragma unroll
                for (int bj = 0; bj < 2; ++bj)
#pragma unroll
                    for (int n = 0; n < 2; ++n) { f32x4 r;
                        if (R32) r = *(const f32x4*)(R32 + ro + bj * HALF + n * 16);
                        else { typedef unsigned u32x2_t __attribute__((ext_vector_type(2))); const u32x2_t rw = *(const u32x2_t*)(R16 + ro + bj * HALF + n * 16); const unsigned r0 = rw.x, r1 = rw.y;
                            r = (f32x4){__builtin_bit_cast(float, r0 << 16), __builtin_bit_cast(float, r0 & 0xffff0000u), __builtin_bit_cast(float, r1 << 16), __builtin_bit_cast(float, r1 & 0xffff0000u)}; }
                        const f32x4 v = acc[ai][bj][m][n] + r;
                        typedef unsigned u32x2_s __attribute__((ext_vector_type(2))); u32x2_s w; w.x = cvt_pk_bf16(v[0], v[1]); w.y = cvt_pk_bf16(v[2], v[3]);
                        *(u32x2_s*)(XB + ro + bj * HALF + n * 16) = w;
                        s += (v[0] * v[0] + v[1] * v[1]) + (v[2] * v[2] + v[3] * v[3]); }
                s += __shfl_xor(s, 16); s += __shfl_xor(s, 32);
                if (fq == 0) ss2[(size_t)(u.pn * 4 + wc) * MT + row] = s; }
    }
};
struct EpiB16 {
    static constexpr bool PERM = true, AFTER_DRAIN = false;
    bf16_t* O; int ldc;
    __device__ __forceinline__ void operator()(const f32x4 (&acc)[2][2][4][2], const Unit& u, int wr, int wc, int fr, int fq) const {
        const int row0 = u.pm * BM + wr * 64 + fr, col0 = u.pn * BM + wc * 32 + 8 * fq;
#pragma unroll
        for (int ai = 0; ai < 2; ++ai)
#pragma unroll
            for (int m = 0; m < 4; ++m) { bf16_t* rowp = O + (size_t)(row0 + ai * HALF + m * 16) * ldc + col0;
#pragma unroll
                for (int bj = 0; bj < 2; ++bj) { const f32x4 v0 = acc[ai][bj][m][0], v1 = acc[ai][bj][m][1];
                    u32x4 w; w.x = cvt_pk_bf16(v0[0], v0[1]); w.y = cvt_pk_bf16(v0[2], v0[3]); w.z = cvt_pk_bf16(v1[0], v1[1]); w.w = cvt_pk_bf16(v1[2], v1[3]);
                    *(u32x4*)(rowp + bj * HALF) = w; } }
    }
};
struct EpiSwp {
    static constexpr bool PERM = true, AFTER_DRAIN = false;
    bf16_t* O; int ldc; const float* rstd;
    __device__ __forceinline__ void operator()(const f32x4 (&acc)[2][2][4][2], const Unit& u, int wr, int wc, int fr, int fq) const {
        const int row0 = u.pm * BM + wr * 64 + fr, col0 = u.pn * BM + wc * 32 + 8 * fq;
        f32x4 ra[2], rb[2];
#pragma unroll
        for (int bj = 0; bj < 2; ++bj) { ra[bj] = *(const f32x4*)(rstd + col0 + bj * HALF); rb[bj] = *(const f32x4*)(rstd + col0 + bj * HALF + 4); }
#pragma unroll
        for (int ai = 0; ai < 2; ++ai)
#pragma unroll
            for (int m = 0; m < 4; ++m) { bf16_t* rowp = O + (size_t)(row0 + ai * HALF + m * 16) * ldc + col0;
#pragma unroll
                for (int bj = 0; bj < 2; ++bj) { const f32x4 v0 = acc[ai][bj][m][0] * ra[bj], v1 = acc[ai][bj][m][1] * rb[bj];
                    u32x4 w; w.x = cvt_pk_bf16(v0[0], v0[1]); w.y = cvt_pk_bf16(v0[2], v0[3]); w.z = cvt_pk_bf16(v1[0], v1[1]); w.w = cvt_pk_bf16(v1[2], v1[3]);
                    *(u32x4*)(rowp + bj * HALF) = w; } }
    }
};
template <class Epi, class Sched, bool ALIGN_EPI = false, bool SP2 = false>
__device__ __forceinline__ void gemm_phase(PG8_LAS unsigned char* lds, const Gemm g, const Sched& S, const Epi& E, int wave_in) {
    int tid_ = wave_in * 64 + (int)__builtin_amdgcn_mbcnt_hi(~0u, __builtin_amdgcn_mbcnt_lo(~0u, 0u)); asm volatile("" : "+v"(tid_));
    const int tid = tid_, wid = __builtin_amdgcn_readfirstlane(tid >> 6), lane = tid & 63, wr = wid >> 2, wc = wid & 3, fr = lane & 15, fq = lane >> 4;
    const int K = g.K, nt = K / BK;
    unsigned voffA[2], voffB[2];
#pragma unroll
    for (int i = 0; i < 2; ++i) { int R, C; stage_rc(tid * 16 + i * 8192, R, C); const int Rb = Epi::PERM ? ((R & ~31) + perm32(R & 31)) : R;
        voffA[i] = (unsigned)(R * K + C) * 2u; voffB[i] = (unsigned)(Rb * K + C) * 2u; }
    const size_t kstep = (size_t)(BK * 2);
    const size_t hstep = (size_t)HALF * K * 2;
    const size_t tstep = 2 * hstep;
    const unsigned ldsw = (unsigned)wid * 1024u;
    const int aoff = lds_byte(wr * 64 + fr, fq * 8), boff = lds_byte(wc * 32 + fr, fq * 8);
#define PG8_SA(b, h) (((b) * 2 + (h)) * HTB)
#define PG8_SB(b, h) ((4 + (b) * 2 + (h)) * HTB)
#define PG8_STAGE(bufoff, gbase, voff) do { _Pragma("unroll") for (int _i = 0; _i < 2; ++_i) \
        __builtin_amdgcn_global_load_lds((const unsigned*)((const char*)(gbase) + (voff)[_i]), (PG8_LAS unsigned*)(lds + (bufoff) + ldsw + _i * 8192), 16, 0, 0); } while (0)
#define PG8_LDA(dst, b, h) do { _Pragma("unroll") for (int m = 0; m < 4; ++m) _Pragma("unroll") for (int k = 0; k < 2; ++k) dst[m][k] = *(const PG8_LAS bf16x8*)(lds + PG8_SA(b, h) + aoff + m * 2048 + k * 1024); } while (0)
#define PG8_LDB(dst, b, h) do { _Pragma("unroll") for (int n = 0; n < 2; ++n) _Pragma("unroll") for (int k = 0; k < 2; ++k) dst[n][k] = *(const PG8_LAS bf16x8*)(lds + PG8_SB(b, h) + boff + n * 2048 + k * 1024); } while (0)
#define PG8_MMA(ai, bj, At, Bt) do { __builtin_amdgcn_s_setprio(1); _Pragma("unroll") for (int m = 0; m < 4; ++m) _Pragma("unroll") for (int n = 0; n < 2; ++n) _Pragma("unroll") for (int k = 0; k < 2; ++k) \
        acc[ai][bj][m][n] = __builtin_amdgcn_mfma_f32_16x16x32_bf16(Bt[n][k], At[m][k], acc[ai][bj][m][n], 0, 0, 0); __builtin_amdgcn_s_setprio(0); } while (0)
#define PG8_WAIT_V(n) asm volatile("s_waitcnt vmcnt(" #n ")" ::: "memory")
#define PG8_WAIT_L(n) asm volatile("s_waitcnt lgkmcnt(" #n ")" ::: "memory")
#define PG8_BAR __builtin_amdgcn_s_barrier()
#define PG8_SCHED __builtin_amdgcn_sched_barrier(0)
    Unit cur, nxt; int ui = 0;
    if (!S.next(0, cur)) return;
    f32x4 acc[2][2][4][2];
#pragma unroll
    for (int a = 0; a < 2; ++a)
#pragma unroll
        for (int b = 0; b < 2; ++b)
#pragma unroll
            for (int m = 0; m < 4; ++m)
#pragma unroll
                for (int n = 0; n < 2; ++n) acc[a][b][m][n] = (f32x4){0.f, 0.f, 0.f, 0.f};
    bf16x8 At[4][2], B0[2][2], B1[2][2];
    const char* cA = (const char*)g.A + (size_t)cur.pm * tstep; const char* cB = (const char*)g.Bt + (size_t)cur.pn * tstep;
    S.a_ready(cur);
    if constexpr (SP2) {
        PG8_STAGE(PG8_SB(0, 0), cB, voffB); PG8_STAGE(PG8_SB(0, 1), cB + hstep, voffB); PG8_STAGE(PG8_SA(0, 0), cA, voffA); PG8_STAGE(PG8_SA(0, 1), cA + hstep, voffA);
        if (wr == 1) PG8_BAR;
        PG8_WAIT_V(2); PG8_BAR;
        PG8_STAGE(PG8_SB(1, 0), cB + kstep, voffB); PG8_STAGE(PG8_SA(1, 0), cA + kstep, voffA); PG8_STAGE(PG8_SB(1, 1), cB + hstep + kstep, voffB);
        PG8_WAIT_V(6); PG8_BAR;
    } else {
        PG8_STAGE(PG8_SB(0, 0), cB, voffB); PG8_STAGE(PG8_SA(0, 0), cA, voffA); PG8_STAGE(PG8_SB(0, 1), cB + hstep, voffB); PG8_STAGE(PG8_SA(0, 1), cA + hstep, voffA);
        if (wr == 1) PG8_BAR;
        PG8_WAIT_V(4); PG8_BAR;
        PG8_STAGE(PG8_SB(1, 0), cB + kstep, voffB); PG8_STAGE(PG8_SA(1, 0), cA + kstep, voffA); PG8_STAGE(PG8_SB(1, 1), cB + hstep + kstep, voffB);
        PG8_WAIT_V(6); PG8_BAR;
    }
    for (;;) {
        const bool has_next = S.next(ui + 1, nxt);
        const char* nA = has_next ? (const char*)g.A + (size_t)nxt.pm * tstep : cA; const char* nB = has_next ? (const char*)g.Bt + (size_t)nxt.pn * tstep : cB;
        for (int t = 0; t < nt; t += 2) {
            const bool last = (t == nt - 2);
            const char* a1 = cA + (size_t)(t + 1) * kstep;
            const char* a2 = last ? nA : cA + (size_t)(t + 2) * kstep; const char* b2 = last ? nB : cB + (size_t)(t + 2) * kstep;
            const char* a3 = a2 + kstep; const char* b3 = b2 + kstep;
            if (last && has_next) S.a_ready(nxt);
            if constexpr (SP2) {
            PG8_LDB(B0, 0, 0); PG8_LDB(B1, 0, 1); PG8_SCHED; PG8_LDA(At, 0, 0); PG8_STAGE(PG8_SA(1, 1), a1 + hstep, voffA);
            PG8_WAIT_V(8); PG8_WAIT_L(0); PG8_BAR; PG8_MMA(0, 0, At, B0); PG8_MMA(0, 1, At, B1); PG8_BAR; PG8_SCHED;
            PG8_LDA(At, 0, 1); PG8_STAGE(PG8_SB(0, 0), b2, voffB); PG8_STAGE(PG8_SB(0, 1), b2 + hstep, voffB); PG8_STAGE(PG8_SA(0, 0), a2, voffA);
            PG8_WAIT_V(8); PG8_WAIT_L(0); PG8_BAR; PG8_MMA(1, 0, At, B0); PG8_MMA(1, 1, At, B1); PG8_BAR; PG8_SCHED;
            PG8_LDB(B0, 1, 0); PG8_LDB(B1, 1, 1); PG8_SCHED; PG8_LDA(At, 1, 0); PG8_STAGE(PG8_SA(0, 1), a2 + hstep, voffA);
            PG8_WAIT_V(8); PG8_WAIT_L(0); PG8_BAR; PG8_MMA(0, 0, At, B0); PG8_MMA(0, 1, At, B1); PG8_BAR; PG8_SCHED;
            PG8_LDA(At, 1, 1); PG8_STAGE(PG8_SB(1, 0), b3, voffB); PG8_STAGE(PG8_SB(1, 1), b3 + hstep, voffB); PG8_STAGE(PG8_SA(1, 0), a3, voffA);
            PG8_WAIT_V(8); PG8_WAIT_L(0); PG8_BAR; PG8_MMA(1, 0, At, B0); PG8_MMA(1, 1, At, B1); PG8_BAR; PG8_SCHED;
            } else {
            PG8_LDB(B0, 0, 0); PG8_SCHED; PG8_LDA(At, 0, 0); PG8_STAGE(PG8_SA(1, 1), a1 + hstep, voffA);
            PG8_WAIT_L(8); PG8_BAR; PG8_WAIT_L(0); PG8_MMA(0, 0, At, B0); PG8_BAR; PG8_SCHED;
            PG8_LDB(B1, 0, 1); PG8_STAGE(PG8_SB(0, 0), b2, voffB);
            PG8_BAR; PG8_WAIT_L(0); PG8_MMA(0, 1, At, B1); PG8_BAR;
            PG8_LDA(At, 0, 1); PG8_STAGE(PG8_SA(0, 0), a2, voffA);
            PG8_BAR; PG8_WAIT_L(0); PG8_MMA(1, 0, At, B0); PG8_BAR; PG8_SCHED;
            PG8_STAGE(PG8_SB(0, 1), b2 + hstep, voffB);
            PG8_WAIT_V(6); PG8_BAR; PG8_MMA(1, 1, At, B1); PG8_BAR;
            PG8_LDB(B0, 1, 0); PG8_SCHED; PG8_LDA(At, 1, 0); PG8_STAGE(PG8_SA(0, 1), a2 + hstep, voffA);
            PG8_WAIT_L(8); PG8_BAR; PG8_WAIT_L(0); PG8_MMA(0, 0, At, B0); PG8_BAR; PG8_SCHED;
            PG8_LDB(B1, 1, 1); PG8_STAGE(PG8_SB(1, 0), b3, voffB);
            PG8_BAR; PG8_WAIT_L(0); PG8_MMA(0, 1, At, B1); PG8_BAR;
            PG8_LDA(At, 1, 1); PG8_STAGE(PG8_SA(1, 0), a3, voffA);
            PG8_BAR; PG8_WAIT_L(0); PG8_MMA(1, 0, At, B0); PG8_BAR; PG8_SCHED;
            PG8_STAGE(PG8_SB(1, 1), b3 + hstep, voffB);
            PG8_WAIT_V(6); PG8_BAR; PG8_MMA(1, 1, At, B1); PG8_BAR;
            }
        }
        if constexpr (ALIGN_EPI) { if (wr == 0) PG8_BAR; }
        if constexpr (!Epi::AFTER_DRAIN) { E(acc, cur, wr, wc, fr, fq); S.done(cur); }
        if (!has_next) break;
#pragma unroll
        for (int a = 0; a < 2; ++a)
#pragma unroll
            for (int b = 0; b < 2; ++b)
#pragma unroll
                for (int m = 0; m < 4; ++m)
#pragma unroll
                    for (int n = 0; n < 2; ++n) acc[a][b][m][n] = (f32x4){0.f, 0.f, 0.f, 0.f};
        cur = nxt; cA = nA; cB = nB; ++ui;
        if constexpr (ALIGN_EPI) { if (wr == 1) PG8_BAR; }
    }
    PG8_WAIT_V(0);
    if constexpr (!ALIGN_EPI) { if (wr == 0) PG8_BAR; }
    PG8_BAR;
    if constexpr (Epi::AFTER_DRAIN) { E.fused(acc, cur, wr, wc, fr, fq, lds, wid, lane); S.done(cur); }
#undef PG8_SA
#undef PG8_SB
#undef PG8_STAGE
#undef PG8_LDA
#undef PG8_LDB
#undef PG8_MMA
#undef PG8_WAIT_V
#undef PG8_WAIT_L
#undef PG8_BAR
#undef PG8_SCHED
}
}

constexpr int NWAVES = 8;
constexpr int T = 16384, D = 2048, S = 2048, NBATCH = 8, CH = 64, NCH = 32, NH = 8, HD = 128, DEPTH = 4, NEXP = 16384;
constexpr int TOKC = pg8::TOKC, SWPR = 2048, TOKP = pg8::TOKP, SWPP = pg8::SWPP, QPP = pg8::QPP;
constexpr int TK_QA = 0, TK_KA = 1024, TK_QR = 2048, TK_KR = 3072, TK_GR = 4096;
constexpr int SW_VA = 0, SW_VR = 1024;
constexpr float EPS = 1e-6f, LOG2E = 1.4426950408889634f;
constexpr int PH_PER_LAYER = 8, N_PHASES = 1 + DEPTH * PH_PER_LAYER;

constexpr size_t MiB = 1u << 20;
constexpr size_t WS_CTL = 0, CTL_ZERO_BYTES = 1 * MiB;
constexpr size_t WS_ROPE_TOK = 1 * MiB, WS_ROPE_TR = 2 * MiB, WS_KEYS = 3 * MiB, WS_SSQ = 5 * MiB, WS_EXP = 9 * MiB, WS_GATE = 17 * MiB, WS_SS2 = 25 * MiB;
constexpr size_t WS_WTOK = 32 * MiB, WS_WSWP = 112 * MiB, WS_WOUT = 160 * MiB, WS_WQ = 192 * MiB;
constexpr size_t WS_HN = 224 * MiB, WS_TOK = 288 * MiB, WS_SWP = 456 * MiB, WS_ST = 556 * MiB, WS_MIX = 620 * MiB, WS_XR = 684 * MiB, WS_QP = 812 * MiB, WS_H2 = 884 * MiB;
constexpr size_t WS_UB = 948 * MiB, WS_VB = 1012 * MiB, WS_SU = 1076 * MiB, WS_SV = 1077 * MiB, WS_END = 1078 * MiB;
static_assert(WS_KEYS + (size_t)DEPTH * 16 * 128 * 128 * 2 <= WS_SSQ && WS_SSQ + (size_t)16 * 4 * T * 4 <= WS_EXP && WS_EXP + (size_t)T * 128 * 4 <= WS_GATE && WS_GATE + (size_t)T * 128 * 4 <= WS_SS2 && WS_SS2 + (size_t)32 * T * 4 <= WS_WTOK, "ws map 1");
static_assert(WS_WTOK + (size_t)DEPTH * TOKC * D * 2 <= WS_WSWP && WS_WSWP + (size_t)DEPTH * SWPR * D * 2 <= WS_WOUT && WS_WOUT + (size_t)DEPTH * D * D * 2 <= WS_WQ && WS_WQ + (size_t)DEPTH * D * D * 2 <= WS_HN, "ws map 2");
static_assert(WS_HN + (size_t)T * D * 2 <= WS_TOK && WS_TOK + (size_t)T * TOKP * 2 <= WS_SWP && WS_SWP + (size_t)SWPR * SWPP * 2 <= WS_ST && WS_ST + (size_t)64 * 32 * 128 * 128 * 2 <= WS_MIX, "ws map 3");
static_assert(WS_MIX + (size_t)T * D * 2 <= WS_XR && WS_XR + (size_t)T * D * 2 <= WS_QP && WS_QP + (size_t)T * QPP * 2 <= WS_H2 && WS_H2 + (size_t)T * D * 2 <= WS_UB, "ws map 4");
static_assert(WS_UB + (size_t)DEPTH * NEXP * D / 2 <= WS_VB && WS_VB + (size_t)DEPTH * NEXP * D / 2 <= WS_SU && WS_SU + (size_t)DEPTH * NEXP * 4 <= WS_SV && WS_SV + (size_t)DEPTH * NEXP * 4 <= WS_END, "ws map 5");
constexpr size_t WS_RSTD = WS_SV;
constexpr int CW_BAR = 4096;

constexpr int RING_OFF = 0, RING_BYTES = 131072;
constexpr int LDSCTL_OFF = RING_BYTES, MISC_OFF = LDSCTL_OFF + 320;
constexpr int LDS_BYTES = 147456;

#define GAS __attribute__((address_space(1)))
#define LAS __attribute__((address_space(3)))
typedef unsigned short bf16;
typedef short bf16x8 __attribute__((ext_vector_type(8)));
typedef float f32x4 __attribute__((ext_vector_type(4)));
typedef float f32x2 __attribute__((ext_vector_type(2)));
typedef unsigned u32x4 __attribute__((ext_vector_type(4)));
typedef unsigned u32x2 __attribute__((ext_vector_type(2)));
#define LDS_WAIT() asm volatile("s_waitcnt lgkmcnt(0)" ::: "memory")
__device__ __forceinline__ unsigned f2bf(float f) { unsigned u = __builtin_bit_cast(unsigned, f); return (u + 0x7fffu + ((u >> 16) & 1u)) >> 16; }
__device__ __forceinline__ unsigned pk2(float lo, float hi) { return f2bf(lo) | (f2bf(hi) << 16); }
__device__ __forceinline__ float bf_lo(unsigned w) { return __builtin_bit_cast(float, w << 16); }
__device__ __forceinline__ float bf_hi(unsigned w) { return __builtin_bit_cast(float, w & 0xffff0000u); }
__device__ __forceinline__ bf16x8 ld_b8(const bf16* p) { return *(const GAS bf16x8*)p; }
__device__ __forceinline__ u32x4 ld_u4(const void* p) { return *(const GAS u32x4*)p; }
__device__ __forceinline__ u32x2 ld_u2(const void* p) { return *(const GAS u32x2*)p; }
__device__ __forceinline__ f32x4 ld_f4(const float* p) { return *(const GAS f32x4*)p; }
__device__ __forceinline__ void st_u2(void* p, u32x2 v) { *(GAS u32x2*)p = v; }
__device__ __forceinline__ void st_u4(void* p, u32x4 v) { *(GAS u32x4*)p = v; }
__device__ __forceinline__ void st_f4(float* p, f32x4 v) { *(GAS f32x4*)p = v; }
__device__ __forceinline__ f32x4 mfma16(bf16x8 a, bf16x8 b, f32x4 c) { return __builtin_amdgcn_mfma_f32_16x16x32_bf16(a, b, c, 0, 0, 0); }
__device__ __forceinline__ bf16x8 pack8(f32x4 a, f32x4 b) {
    u32x4 w; w.x = pk2(a[0], a[1]); w.y = pk2(a[2], a[3]); w.z = pk2(b[0], b[1]); w.w = pk2(b[2], b[3]); return __builtin_bit_cast(bf16x8, w);
}
__device__ __forceinline__ float wave_sum(float v) {
#pragma unroll
    for (int o = 1; o < 64; o <<= 1) v += __shfl_xor(v, o);
    return v;
}
__device__ __forceinline__ float rq_sum(float v) { v += __shfl_xor(v, 16); v += __shfl_xor(v, 32); return v; }
__device__ __forceinline__ float rq_max(float v) { v = fmaxf(v, __shfl_xor(v, 16)); v = fmaxf(v, __shfl_xor(v, 32)); return v; }
__device__ __forceinline__ int lane_id() { return (int)__builtin_amdgcn_mbcnt_hi(~0u, __builtin_amdgcn_mbcnt_lo(~0u, 0u)); }
__device__ __forceinline__ float fexp2(float x) { return __builtin_amdgcn_exp2f(x); }
__device__ __forceinline__ float frsq(float x) { return __builtin_amdgcn_rsqf(x); }

#define XB_TMO      128
#define XB_XCNT(j)  (256  + 64 * (j))
#define XB_XSUB(j)  (1280 + 64 * (j))
#define XB_XGEN(j)  (2304 + 64 * (j))
#define XB_TOP      3328
#define XB_TOPGEN   3392
#define XCD_BAR_WORDS 3456
#define XB_SPIN_CAP (1u << 20)
__device__ __forceinline__ unsigned xb_ld(unsigned* p)              { return __hip_atomic_load(p, __ATOMIC_RELAXED, __HIP_MEMORY_SCOPE_AGENT); }
__device__ __forceinline__ unsigned xb_add(unsigned* p, unsigned v) { return __hip_atomic_fetch_add(p, v, __ATOMIC_RELAXED, __HIP_MEMORY_SCOPE_AGENT); }
__device__ __forceinline__ unsigned xb_xcc_id() { return (unsigned)__builtin_amdgcn_s_getreg((3 << 11) | 20) & 0xFu; }
#define XB_SPIN(cond, bar) do { unsigned _sp = 0; while (cond) { __builtin_amdgcn_s_sleep(1); \
    if ((++_sp & 255u) == 0u) { if (xb_ld(&(bar)[XB_TMO])) break; if (_sp > XB_SPIN_CAP) { atomicAdd(&(bar)[XB_TMO], 1u); break; } } } } while (0)
struct XcdBarrier { unsigned* bar; unsigned x; volatile LAS unsigned* st; };
__device__ __forceinline__ XcdBarrier xcd_barrier_post(unsigned* bar, volatile LAS unsigned* st) {
    XcdBarrier b; b.bar = bar; b.x = xb_xcc_id(); b.st = st;
    if (threadIdx.x == 0) (void)xb_add(&bar[XB_XCNT(b.x)], 1u);
    return b;
}
__device__ __forceinline__ void xcd_barrier_complete(unsigned* bar, unsigned x, unsigned& nloc, unsigned& nx) {
    const unsigned G = gridDim.x * gridDim.y * gridDim.z;
    unsigned sum, cnt, mine, sp = 0u;
    for (;;) {
        sum = 0u; cnt = 0u; mine = 0u;
#pragma unroll
        for (unsigned j = 0; j < 16; ++j) { const unsigned c = xb_ld(&bar[XB_XCNT(j)]); sum += c; cnt += (c > 0u) ? 1u : 0u; mine = (j == x) ? c : mine; }
        if (sum == G) break;
        __builtin_amdgcn_s_sleep(1);
        if ((++sp & 255u) == 0u) { if (xb_ld(&bar[XB_TMO])) break; if (sp > XB_SPIN_CAP) { atomicAdd(&bar[XB_TMO], 1u); break; } }
    }
    nloc = mine > 0u ? mine : 1u; nx = cnt > 0u ? cnt : 1u;
}
__device__ __forceinline__ void xcd_barrier(const XcdBarrier& b, int wave) {
    asm volatile("s_waitcnt vmcnt(0)" ::: "memory");
    __syncthreads();
    if (wave == 0 && lane_id() == 0) {
        unsigned* bar = b.bar;
        __builtin_amdgcn_s_waitcnt(0);
        unsigned nloc = b.st[0], nx = b.st[1];
        if (nloc == 0u) { xcd_barrier_complete(bar, b.x, nloc, nx); b.st[0] = nloc; b.st[1] = nx; }
        const unsigned old = xb_add(&bar[XB_XSUB(b.x)], 1u);
        const unsigned gen = old / nloc;
        if (old + 1u == (gen + 1u) * nloc) {
            __builtin_amdgcn_fence(__ATOMIC_RELEASE, "agent");
            asm volatile("s_waitcnt vmcnt(0)" ::: "memory");
            const unsigned og = xb_add(&bar[XB_TOP], 1u);
            const unsigned tg = og / nx;
            if (og + 1u == (tg + 1u) * nx) xb_add(&bar[XB_TOPGEN], 1u);
            else XB_SPIN(xb_ld(&bar[XB_TOPGEN]) == tg, bar);
            __builtin_amdgcn_fence(__ATOMIC_ACQUIRE, "agent");
            xb_add(&bar[XB_XGEN(b.x)], 1u);
            asm volatile("s_waitcnt vmcnt(0)" ::: "memory");
        } else {
            XB_SPIN(xb_ld(&bar[XB_XGEN(b.x)]) == gen, bar);
            __builtin_amdgcn_fence(__ATOMIC_ACQUIRE, "agent");
            asm volatile("s_waitcnt vmcnt(0)" ::: "memory");
        }
    }
    __syncthreads();
}

struct Frame {
    LAS unsigned char* lds;
    int wave, G, gw, ngw;
    const float *x, *norm1_g, *w_in, *qa_g, *ka_g, *rel_bias, *attn_g, *ret_g, *w_out, *norm2_g, *peer_wq, *peer_keys, *peer_u, *peer_v;
    float* out; unsigned char* ws;
};

template <class DstFn>
__device__ __forceinline__ void transpose_item(const float* W, int K, int N, LAS float* scr, int item, int lane, DstFn dst, const float* kscale = nullptr) {
    const int nblk = N / 32, kb = item / nblk, nb = item % nblk, k0 = 64 * kb, n0 = 32 * nb;
#pragma unroll
    for (int i = 0; i < 32; ++i) { const int kk = 2 * i + (lane >> 5); float wv = *(const GAS float*)(W + (size_t)(k0 + kk) * N + n0 + (lane & 31));
        scr[kk * 33 + (lane & 31)] = wv; }
    LDS_WAIT(); asm volatile("" ::: "memory");
    const int c = lane & 7;
    f32x4 ka = (f32x4){1.f, 1.f, 1.f, 1.f}, kb4 = ka;
    if (kscale) { ka = ld_f4(kscale + k0 + 8 * c); kb4 = ld_f4(kscale + k0 + 8 * c + 4); }
#pragma unroll
    for (int j = 0; j < 4; ++j) { const int n = (lane >> 3) + 8 * j; const LAS float* s = scr + (8 * c) * 33 + n;
        u32x4 o; o.x = pk2(s[0 * 33] * ka[0], s[1 * 33] * ka[1]); o.y = pk2(s[2 * 33] * ka[2], s[3 * 33] * ka[3]); o.z = pk2(s[4 * 33] * kb4[0], s[5 * 33] * kb4[1]); o.w = pk2(s[6 * 33] * kb4[2], s[7 * 33] * kb4[3]);
        dst(n0 + n, k0 + 8 * c, o); }
    LDS_WAIT(); asm volatile("" ::: "memory");
}
__device__ __forceinline__ void rms_row_to_bf16(const float* xrow, const float* g, bf16* orow, int lane) {
    asm volatile("" : "+v"(lane));
    f32x4 v[8]; float s = 0.f;
#pragma unroll
    for (int j = 0; j < 8; ++j) { v[j] = ld_f4(xrow + (j * 64 + lane) * 4); s += (v[j][0] * v[j][0] + v[j][1] * v[j][1]) + (v[j][2] * v[j][2] + v[j][3] * v[j][3]); }
    const float rstd = frsq(wave_sum(s) * (1.f / D) + EPS);
#pragma unroll
    for (int j = 0; j < 8; ++j) { const f32x4 gg = ld_f4(g + (j * 64 + lane) * 4);
        u32x2 o; o.x = pk2(v[j][0] * rstd * gg[0], v[j][1] * rstd * gg[1]); o.y = pk2(v[j][2] * rstd * gg[2], v[j][3] * rstd * gg[3]);
        st_u2(orow + (j * 64 + lane) * 4, o); }
}
__device__ __forceinline__ void row_to_fp4(const float* src, unsigned char* dst, size_t slice_stride, unsigned short* scale_out, int lane) {
    f32x4 v[8]; float mx = 0.f;
#pragma unroll
    for (int q = 0; q < 8; ++q) { v[q] = ld_f4(src + lane * 32 + q * 4);
        mx = fmaxf(mx, fmaxf(fmaxf(__builtin_fabsf(v[q][0]), __builtin_fabsf(v[q][1])), fmaxf(__builtin_fabsf(v[q][2]), __builtin_fabsf(v[q][3])))); }
#pragma unroll
    for (int o = 1; o < 64; o <<= 1) mx = fmaxf(mx, __shfl_xor(mx, o));
    const float sc = mx > 0.f ? bf_lo(f2bf(mx * (1.0f / 6.0f)) ) : 1.0f, inv = 1.0f / sc;
    u32x4 o;
#pragma unroll
    for (int d = 0; d < 4; ++d) { const f32x4 a = v[2 * d] * inv, b = v[2 * d + 1] * inv;
        unsigned w = 0u;
        w = __builtin_amdgcn_cvt_scalef32_pk_fp4_f32(w, a[0], a[1], 1.0f, 0); w = __builtin_amdgcn_cvt_scalef32_pk_fp4_f32(w, a[2], a[3], 1.0f, 1);
        w = __builtin_amdgcn_cvt_scalef32_pk_fp4_f32(w, b[0], b[1], 1.0f, 2); w = __builtin_amdgcn_cvt_scalef32_pk_fp4_f32(w, b[2], b[3], 1.0f, 3);
        o[d] = w; }
    st_u4(dst + (size_t)(lane >> 3) * slice_stride + (lane & 7) * 16, o);
    if (lane == 0) *(GAS unsigned short*)scale_out = (unsigned short)f2bf(sc);
}
__device__ __forceinline__ void p0_prologue(const Frame& F) {
    LAS float* scr = (LAS float*)(F.lds + RING_OFF + F.wave * 16384);
    int lane = lane_id(); asm volatile("" : "+v"(lane));
    bf16* Wtok = (bf16*)(F.ws + WS_WTOK); bf16* Wswp = (bf16*)(F.ws + WS_WSWP); bf16* Wout = (bf16*)(F.ws + WS_WOUT); bf16* Wq = (bf16*)(F.ws + WS_WQ);
    constexpr int IN_COLS = 7168;
    constexpr int I_IN = (D / 64) * (IN_COLS / 32), I_SQ = (D / 64) * (D / 32), I_L = I_IN + 2 * I_SQ, NITEMS = DEPTH * I_L;
    for (int it = F.gw; it < NITEMS; it += F.ngw) {
        const int l = it / I_L; int r = it % I_L;
        if (r < I_IN) {
            bf16* wt = Wtok + (size_t)l * TOKC * D; bf16* wsw = Wswp + (size_t)l * SWPR * D;
            transpose_item(F.w_in + (size_t)l * D * IN_COLS, D, IN_COLS, scr, r, lane, [=](int n, int k, u32x4 o) {
                const int seg = n >> 10, nn = n & 1023, dd = n & 127, dp = (n & 896) + 2 * (dd & 63) + (dd >> 6);
                if (seg == 0) st_u4(wt + (size_t)(TK_QA + nn) * D + k, o);
                else if (seg == 1) st_u4(wt + (size_t)(TK_KA + nn) * D + k, o);
                else if (seg == 2) st_u4(wsw + (size_t)(SW_VA + nn) * D + k, o);
                else if (seg == 3) st_u4(wt + (size_t)(TK_QR + dp) * D + k, o);
                else if (seg == 4) st_u4(wt + (size_t)(TK_KR + dp) * D + k, o);
                else if (seg == 5) st_u4(wsw + (size_t)(SW_VR + nn) * D + k, o);
                else st_u4(wt + (size_t)(TK_GR + nn) * D + k, o);
            }, F.norm1_g + l * D);
            continue;
        }
        r -= I_IN;
        if (r < I_SQ) { bf16* wo = Wout + (size_t)l * D * D;
            transpose_item(F.w_out + (size_t)l * D * D, D, D, scr, r, lane, [=](int n, int k, u32x4 o) { st_u4(wo + (size_t)n * D + k, o); }); continue; }
        r -= I_SQ;
        { bf16* wq = Wq + (size_t)l * D * D;
            transpose_item(F.peer_wq + (size_t)l * D * D, D, D, scr, r, lane, [=](int n, int k, u32x4 o) { st_u4(wq + (size_t)n * D + k, o); }, F.norm2_g + l * D); }
    }
    {
        bf16* XR0 = (bf16*)(F.ws + WS_XR); float* RSTD = (float*)(F.ws + WS_RSTD);
        for (int m = F.gw; m < T; m += F.ngw) {
            const float* xrow = F.x + (size_t)m * D;
            f32x4 v[8]; float s = 0.f;
#pragma unroll
            for (int j = 0; j < 8; ++j) { v[j] = ld_f4(xrow + (j * 64 + lane) * 4); s += (v[j][0] * v[j][0] + v[j][1] * v[j][1]) + (v[j][2] * v[j][2] + v[j][3] * v[j][3]); }
            const float rstd = frsq(wave_sum(s) * (1.f / D) + EPS);
#pragma unroll
            for (int j = 0; j < 8; ++j) { u32x2 o; o.x = pk2(v[j][0], v[j][1]); o.y = pk2(v[j][2], v[j][3]); st_u2(XR0 + (size_t)m * D + (j * 64 + lane) * 4, o); }
            if (lane == 0) *(GAS float*)(RSTD + m) = rstd;
        }
    }
    {
        unsigned char* UB = (unsigned char*)(F.ws + WS_UB); unsigned char* VB = (unsigned char*)(F.ws + WS_VB);
        unsigned short* SUV = (unsigned short*)(F.ws + WS_SU);
        const int nrows = DEPTH * NEXP;
        for (int r = F.gw; r < 2 * nrows; r += F.ngw) {
            const bool isv = r >= nrows; const int rr = isv ? r - nrows : r;
            row_to_fp4((isv ? F.peer_v : F.peer_u) + (size_t)rr * D, (isv ? VB : UB) + (size_t)(rr / NEXP) * NEXP * (D / 2) + (size_t)(rr % NEXP) * 128, (size_t)NEXP * 128, SUV + 2 * (size_t)rr + (isv ? 1 : 0), lane);
        }
        const size_t nK = (size_t)DEPTH * 16 * 128 * 128 / 8;
        bf16* KB = (bf16*)(F.ws + WS_KEYS);
        const size_t stride = (size_t)F.ngw * 64, start = (size_t)F.gw * 64 + lane;
        for (size_t i = start; i < nK; i += stride) {
            const f32x4 a = ld_f4(F.peer_keys + i * 8), b = ld_f4(F.peer_keys + i * 8 + 4);
            u32x4 o; o.x = pk2(a[0], a[1]); o.y = pk2(a[2], a[3]); o.z = pk2(b[0], b[1]); o.w = pk2(b[2], b[3]); st_u4(KB + i * 8, o);
        }
    }
    {
        f32x2* ct = (f32x2*)(F.ws + WS_ROPE_TOK);
        for (int e = F.gw * 64 + lane; e < S * 64; e += F.ngw * 64) {
            const int pos = e >> 6, i = e & 63;
            const float invf = exp2f(-(float)i * 0.20762050593046014f);
            const double rev = (double)pos * (double)invf * 0.15915494309189535;
            const float fr = (float)(rev - __builtin_floor(rev));
            const f32x2 v = {__builtin_amdgcn_cosf(fr), __builtin_amdgcn_sinf(fr)};
            ct[(size_t)pos * 64 + i] = v;
        }
    }
}

constexpr int A_KP = 272, A_VP = 144;
constexpr int A_KBUF = 0, A_VBUF = A_KBUF + 2 * 64 * A_KP, A_RK = A_VBUF + 2 * 128 * A_VP, A_BIAS = A_RK + 2 * 64 * 4, A_END = A_BIAS + NH * 257 * 4;
static_assert(A_END <= RING_BYTES, "attention LDS map");
__device__ __forceinline__ void attn_wg_task(const Frame& F, int l, int task) {
    int tid = F.wave * 64 + lane_id(); asm volatile("" : "+v"(tid));
    const int lane = tid & 63, c = lane & 15, rq = lane >> 4, wave = F.wave;
    const int cq = task & 7, h = (task >> 3) & 7, b = task >> 6;
    const bf16* TOK = (const bf16*)(F.ws + WS_TOK); const bf16* SWP = (const bf16*)(F.ws + WS_SWP); const float* SSQ = (const float*)(F.ws + WS_SSQ);
    bf16* MIX = (bf16*)(F.ws + WS_MIX);
    LAS unsigned char* lds = F.lds + RING_OFF;
    const LAS float* bh = (const LAS float*)(lds + A_BIAS) + h * 257;
    const int wch = wave >> 1;
    const int qi0 = (wave & 1) * 32 + c;
    const int tq0 = b * S + (4 * cq + wch) * CH + qi0;
    bf16x8 Qf[2][4];
#pragma unroll
    for (int qb = 0; qb < 2; ++qb) {
        const int tq = tq0 + qb * 16;
        float ssq = 0.f;
#pragma unroll
        for (int w = 0; w < 4; ++w) ssq += *(const GAS float*)(SSQ + (size_t)((0 * 8 + h) * 4 + w) * T + tq);
        const float rs = frsq(ssq * (1.f / HD) + EPS) * (pg8::KSCALE * LOG2E);
#pragma unroll
        for (int ks = 0; ks < 4; ++ks) {
            const float* gp = F.qa_g + l * HD + ks * 32 + rq * 8; const float* kp = F.ka_g + l * HD + ks * 32 + rq * 8;
            const f32x4 a0 = ld_f4(gp), a1 = ld_f4(gp + 4), b0 = ld_f4(kp), b1 = ld_f4(kp + 4);
            const u32x4 raw = ld_u4(TOK + (size_t)tq * TOKP + TK_QA + h * HD + ks * 32 + rq * 8);
            u32x4 o;
            o.x = pk2(bf_lo(raw.x) * rs * (a0[0] * b0[0]), bf_hi(raw.x) * rs * (a0[1] * b0[1])); o.y = pk2(bf_lo(raw.y) * rs * (a0[2] * b0[2]), bf_hi(raw.y) * rs * (a0[3] * b0[3]));
            o.z = pk2(bf_lo(raw.z) * rs * (a1[0] * b1[0]), bf_hi(raw.z) * rs * (a1[1] * b1[1])); o.w = pk2(bf_lo(raw.w) * rs * (a1[2] * b1[2]), bf_hi(raw.w) * rs * (a1[3] * b1[3]));
            Qf[qb][ks] = __builtin_bit_cast(bf16x8, o);
        }
    }
    float m_run[2] = {-1e30f, -1e30f}, l_run[2] = {0.f, 0.f};
    f32x4 O[2][8];
#pragma unroll
    for (int qb = 0; qb < 2; ++qb)
#pragma unroll
        for (int db = 0; db < 8; ++db) O[qb][db] = (f32x4){0.f, 0.f, 0.f, 0.f};
    const int p0 = tid, p1 = tid + 512;
    const int kr0 = p0 >> 4, kr1 = p1 >> 4;
    const int kl0 = (kr0 & 32) + ((kr0 >> 2) & 1) * 16 + ((kr0 >> 3) & 3) * 4 + (kr0 & 3), kl1 = (kr1 & 32) + ((kr1 >> 2) & 1) * 16 + ((kr1 >> 3) & 3) * 4 + (kr1 & 3);
    const bf16* gk0 = TOK + (size_t)(b * S + kr0) * TOKP + TK_KA + h * HD + (p0 & 15) * 8; const bf16* gk1 = TOK + (size_t)(b * S + kr1) * TOKP + TK_KA + h * HD + (p1 & 15) * 8;
    const bf16* gv0 = SWP + (size_t)(SW_VA + h * HD + (p0 >> 3)) * SWPP + b * S + (p0 & 7) * 8; const bf16* gv1 = SWP + (size_t)(SW_VA + h * HD + (p1 >> 3)) * SWPP + b * S + (p1 & 7) * 8;
    const int lk0 = A_KBUF + kl0 * A_KP + (p0 & 15) * 16, lk1 = A_KBUF + kl1 * A_KP + (p1 & 15) * 16;
    const int lv0 = A_VBUF + (p0 >> 3) * A_VP + (p0 & 7) * 16, lv1 = A_VBUF + (p1 >> 3) * A_VP + (p1 & 7) * 16;
    const float* gss = SSQ + (size_t)((8 + h) * 4) * T + b * S + (tid & 63);
    u32x4 r0, r1, r2, r3; float rkv = 0.f;
    const int kc0 = 4 * cq - 8, j0 = kc0 < 0 ? -kc0 : 0;
#define A_GLOAD(j) do { const int ko = (kc0 + (j)) * CH; r0 = ld_u4(gk0 + (size_t)ko * TOKP); r1 = ld_u4(gk1 + (size_t)ko * TOKP); r2 = ld_u4(gv0 + ko); r3 = ld_u4(gv1 + ko); \
        if (tid < 64) { float s_ = 0.f; _Pragma("unroll") for (int w = 0; w < 4; ++w) s_ += *(const GAS float*)(gss + (size_t)w * T + ko); rkv = frsq(s_ * (1.f / HD) + EPS); } } while (0)
#define A_LSTORE(bf) do { *(LAS u32x4*)(lds + lk0 + (bf) * 64 * A_KP) = r0; *(LAS u32x4*)(lds + lk1 + (bf) * 64 * A_KP) = r1; *(LAS u32x4*)(lds + lv0 + (bf) * 128 * A_VP) = r2; *(LAS u32x4*)(lds + lv1 + (bf) * 128 * A_VP) = r3; \
        if (tid < 64) ((LAS float*)(lds + A_RK))[(bf) * 64 + tid] = rkv; } while (0)
    __syncthreads();
    A_GLOAD(j0); A_LSTORE(j0 & 1);
    __syncthreads();
    for (int j = j0; j < 12; ++j) {
        if (j < 11) A_GLOAD(j + 1);
        const int tjr = j - wch;
        if (tjr >= 0 && tjr <= 8) {
            const LAS unsigned char* kb = lds + A_KBUF + (j & 1) * 64 * A_KP + c * A_KP + rq * 16;
            const LAS unsigned char* vb = lds + A_VBUF + (j & 1) * 128 * A_VP + c * A_VP + rq * 16;
            const LAS float* rkb = (const LAS float*)(lds + A_RK) + (j & 1) * 64;
            f32x4 sa[2][2][2];
#pragma unroll
            for (int g = 0; g < 2; ++g)
#pragma unroll
                for (int ab = 0; ab < 2; ++ab) { f32x4 a0 = (f32x4){0.f, 0.f, 0.f, 0.f}, a1 = (f32x4){0.f, 0.f, 0.f, 0.f};
#pragma unroll
                    for (int ks = 0; ks < 4; ++ks) { const bf16x8 kf = *(const LAS bf16x8*)(kb + (32 * g + 16 * ab) * A_KP + ks * 64); a0 = mfma16(kf, Qf[0][ks], a0); a1 = mfma16(kf, Qf[1][ks], a1); }
                    sa[0][g][ab] = a0; sa[1][g][ab] = a1; }
            const int relbase = 64 * (8 - tjr);
            float mx[2] = {-1e30f, -1e30f};
            if (tjr <= 5) {
                const float bc = bh[256];
#pragma unroll
                for (int g = 0; g < 2; ++g)
#pragma unroll
                    for (int ab = 0; ab < 2; ++ab) {
                        const f32x4 rk = *(const LAS f32x4*)(rkb + 32 * g + 8 * rq + 4 * ab);
#pragma unroll
                        for (int qb = 0; qb < 2; ++qb)
#pragma unroll
                            for (int e = 0; e < 4; ++e) { const float sv = sa[qb][g][ab][e] * rk[e] + bc; sa[qb][g][ab][e] = sv; mx[qb] = fmaxf(mx[qb], sv); }
                    }
            } else {
#pragma unroll
                for (int g = 0; g < 2; ++g)
#pragma unroll
                    for (int ab = 0; ab < 2; ++ab) {
                        const int kk0 = 32 * g + 8 * rq + 4 * ab;
                        const f32x4 rk = *(const LAS f32x4*)(rkb + kk0);
#pragma unroll
                        for (int qb = 0; qb < 2; ++qb)
#pragma unroll
                            for (int e = 0; e < 4; ++e) {
                                int rel = qi0 + qb * 16 - (kk0 + e) + relbase; rel = rel > 128 ? 128 : (rel < -128 ? -128 : rel);
                                const float sv = sa[qb][g][ab][e] * rk[e] + bh[rel + 128];
                                sa[qb][g][ab][e] = sv; mx[qb] = fmaxf(mx[qb], sv);
                            }
                    }
            }
            bf16x8 Pf[2][2];
            bool moved = false;
            float alpha[2];
#pragma unroll
            for (int qb = 0; qb < 2; ++qb) {
                const float mxr = rq_max(mx[qb]);
                const float mn = fmaxf(m_run[qb], mxr); alpha[qb] = fexp2(m_run[qb] - mn);
                moved = moved || (mn > m_run[qb]);
                float ps = 0.f;
#pragma unroll
                for (int g = 0; g < 2; ++g) {
#pragma unroll
                    for (int ab = 0; ab < 2; ++ab)
#pragma unroll
                        for (int e = 0; e < 4; ++e) { const float p = fexp2(sa[qb][g][ab][e] - mn); sa[qb][g][ab][e] = p; ps += p; }
                    Pf[qb][g] = pack8(sa[qb][g][0], sa[qb][g][1]);
                }
                l_run[qb] = l_run[qb] * alpha[qb] + ps; m_run[qb] = mn;
            }
            if (__any(moved)) {
#pragma unroll
                for (int qb = 0; qb < 2; ++qb)
#pragma unroll
                    for (int db = 0; db < 8; ++db) O[qb][db] *= alpha[qb];
            }
#pragma unroll
            for (int g = 0; g < 2; ++g)
#pragma unroll
                for (int db = 0; db < 8; ++db) { const bf16x8 vf = *(const LAS bf16x8*)(vb + db * 16 * A_VP + g * 64); O[0][db] = mfma16(vf, Pf[0][g], O[0][db]); O[1][db] = mfma16(vf, Pf[1][g], O[1][db]); }
        }
        if (j < 11) A_LSTORE((j + 1) & 1);
        __syncthreads();
    }
#undef A_GLOAD
#undef A_LSTORE
#pragma unroll
    for (int qb = 0; qb < 2; ++qb) {
        const int tq = tq0 + qb * 16;
        const float inv = 1.0f / rq_sum(l_run[qb]);
        float ss = 0.f;
#pragma unroll
        for (int db = 0; db < 8; ++db) { O[qb][db] *= inv; ss += (O[qb][db][0] * O[qb][db][0] + O[qb][db][1] * O[qb][db][1]) + (O[qb][db][2] * O[qb][db][2] + O[qb][db][3] * O[qb][db][3]); }
        const float rstd = frsq(rq_sum(ss) * (1.f / HD) + EPS);
#pragma unroll
        for (int db = 0; db < 8; ++db) {
            const int d0 = h * HD + db * 16 + rq * 4;
            const f32x4 g4 = ld_f4(F.attn_g + l * 1024 + d0);
            u32x2 o; o.x = pk2(O[qb][db][0] * rstd * g4[0], O[qb][db][1] * rstd * g4[1]); o.y = pk2(O[qb][db][2] * rstd * g4[2], O[qb][db][3] * rstd * g4[3]);
            st_u2(MIX + (size_t)tq * D + d0, o);
        }
    }
}

constexpr int SC_PITCH = 36, SC_WAVE_BYTES = 64 * SC_PITCH, SC_OFF = A_END;
static_assert(SC_OFF % 4 == 0 && SC_OFF + NWAVES * SC_WAVE_BYTES <= RING_BYTES, "scan LDS map");
struct ScanOps { u32x4 kp[2]; bf16x8 va[4][2]; };
__device__ __forceinline__ void scan_load(ScanOps& o, const bf16* kg, const bf16* vrow, int n) {
#pragma unroll
    for (int i = 0; i < 2; ++i) o.kp[i] = ld_u4(kg + (size_t)(n * CH + i * 32) * TOKP);
#pragma unroll
    for (int eb = 0; eb < 4; ++eb)
#pragma unroll
        for (int ks = 0; ks < 2; ++ks) o.va[eb][ks] = ld_b8(vrow + (size_t)eb * 16 * SWPP + n * CH + ks * 32);
}
__device__ __forceinline__ void scan_step(f32x4 (&st)[4], const ScanOps& o, const float (&dec)[16], LAS unsigned char* kw, const LAS unsigned char* kr, bf16* sp, int n, float cd) {
#pragma unroll
    for (int eb = 0; eb < 4; ++eb) { u32x2 w; w.x = pk2(st[eb][0], st[eb][1]); w.y = pk2(st[eb][2], st[eb][3]); st_u2(sp + (size_t)n * HD * HD + eb * 16 * HD, w); }
#pragma unroll
    for (int i = 0; i < 2; ++i)
#pragma unroll
        for (int d = 0; d < 4; ++d) *(LAS unsigned*)(kw + i * 32 * SC_PITCH + d * 4) = o.kp[i][d];
    LDS_WAIT(); asm volatile("" ::: "memory");
    bf16x8 ka[2];
#pragma unroll
    for (int ks = 0; ks < 2; ++ks) { u32x4 w;
#pragma unroll
        for (int j = 0; j < 4; ++j) { const unsigned e0 = *(const LAS unsigned short*)(kr + (ks * 32 + 2 * j) * SC_PITCH), e1 = *(const LAS unsigned short*)(kr + (ks * 32 + 2 * j + 1) * SC_PITCH);
            w[j] = pk2(bf_lo(e0) * dec[ks * 8 + 2 * j], bf_lo(e1) * dec[ks * 8 + 2 * j + 1]); }
        ka[ks] = __builtin_bit_cast(bf16x8, w); }
    LDS_WAIT(); asm volatile("" ::: "memory");
#pragma unroll
    for (int eb = 0; eb < 4; ++eb) { st[eb] *= cd;
#pragma unroll
        for (int ks = 0; ks < 2; ++ks) st[eb] = mfma16(ka[ks], o.va[eb][ks], st[eb]); }
}
__device__ __forceinline__ void scan_task(const Frame& F, int task) {
    int lane = lane_id(); asm volatile("" : "+v"(lane));
    const int c = lane & 15, rq = lane >> 4;
    const int eh = task & 1, db = (task >> 1) & 7, h = (task >> 4) & 7, b = task >> 7, bhh = b * NH + h;
    const bf16* TOK = (const bf16*)(F.ws + WS_TOK); const bf16* SWP = (const bf16*)(F.ws + WS_SWP); bf16* ST = (bf16*)(F.ws + WS_ST);
    const bf16* kg = TOK + (size_t)(b * S + (lane >> 1)) * TOKP + TK_KR + h * HD + db * 16 + (lane & 1) * 8;
    const bf16* vrow = SWP + (size_t)(SW_VR + h * HD + eh * 64 + c) * SWPP + b * S + rq * 8;
    bf16* sp = ST + ((size_t)bhh * NCH * HD + eh * 64 + c) * HD + db * 16 + rq * 4;
    LAS unsigned char* kt = F.lds + RING_OFF + SC_OFF + F.wave * SC_WAVE_BYTES;
    LAS unsigned char* kw = kt + (lane >> 1) * SC_PITCH + (lane & 1) * 16;
    const LAS unsigned char* kr = kt + (rq * 8) * SC_PITCH + c * 2;
    f32x4 st[4];
#pragma unroll
    for (int eb = 0; eb < 4; ++eb) st[eb] = (f32x4){0.f, 0.f, 0.f, 0.f};
    const float lg = pg8::lg2gamma(h), cd = fexp2(64.f * lg);
    float dec[16];
#pragma unroll
    for (int i = 0; i < 16; ++i) dec[i] = fexp2((float)(63 - ((i >> 3) * 32 + rq * 8 + (i & 7))) * lg);
    ScanOps o0, o1, o2;
    scan_load(o0, kg, vrow, 0); scan_load(o1, kg, vrow, 1);
    for (int n = 0; n < NCH - 1; n += 3) {
        if (n + 2 < NCH - 1) scan_load(o2, kg, vrow, n + 2);
        scan_step(st, o0, dec, kw, kr, sp, n, cd);
        if (n + 1 < NCH - 1) { if (n + 3 < NCH - 1) scan_load(o0, kg, vrow, n + 3); scan_step(st, o1, dec, kw, kr, sp, n + 1, cd); }
        if (n + 2 < NCH - 1) { if (n + 4 < NCH - 1) scan_load(o1, kg, vrow, n + 4); scan_step(st, o2, dec, kw, kr, sp, n + 2, cd); }
    }
#pragma unroll
    for (int eb = 0; eb < 4; ++eb) { u32x2 w; w.x = pk2(st[eb][0], st[eb][1]); w.y = pk2(st[eb][2], st[eb][3]); st_u2(sp + (size_t)(NCH - 1) * HD * HD + eb * 16 * HD, w); }
}

__device__ __forceinline__ void ret_task(const Frame& F, int l, int task) {
    int lane = lane_id(); asm volatile("" : "+v"(lane));
    const int c = lane & 15, rq = lane >> 4;
    const int qb2 = task & 1, n = (task >> 1) & 31, h = (task >> 6) & 7, b = task >> 9, bhh = b * NH + h;
    const bf16* TOK = (const bf16*)(F.ws + WS_TOK); const bf16* SWP = (const bf16*)(F.ws + WS_SWP); const bf16* ST = (const bf16*)(F.ws + WS_ST);
    bf16* MIX = (bf16*)(F.ws + WS_MIX);
    const int tc0 = b * S + n * CH, tq0 = tc0 + qb2 * 32;
    const float lg = pg8::lg2gamma(h);
    bf16x8 Qf[2][4];
#pragma unroll
    for (int qb = 0; qb < 2; ++qb)
#pragma unroll
        for (int ks = 0; ks < 4; ++ks) Qf[qb][ks] = ld_b8(TOK + (size_t)(tq0 + qb * 16 + c) * TOKP + TK_QR + h * HD + ks * 32 + rq * 8);
    f32x4 acc[2][8];
#pragma unroll
    for (int qb = 0; qb < 2; ++qb)
#pragma unroll
        for (int eb = 0; eb < 8; ++eb) acc[qb][eb] = (f32x4){0.f, 0.f, 0.f, 0.f};
    const bf16* sp = ST + (((size_t)bhh * NCH + n) * HD + c) * HD + rq * 8;
#pragma unroll
    for (int eb = 0; eb < 8; ++eb)
#pragma unroll
        for (int ks = 0; ks < 4; ++ks) { const bf16x8 sf = ld_b8(sp + eb * 16 * HD + ks * 32);
#pragma unroll
            for (int qb = 0; qb < 2; ++qb) acc[qb][eb] = mfma16(sf, Qf[qb][ks], acc[qb][eb]); }
#pragma unroll
    for (int qb = 0; qb < 2; ++qb) { const float f = fexp2((float)(qb2 * 32 + qb * 16 + c + 1) * lg);
#pragma unroll
        for (int eb = 0; eb < 8; ++eb) acc[qb][eb] *= f; }
    for (int g = 0; g <= qb2; ++g) {
        f32x4 sa[2][2];
#pragma unroll
        for (int qb = 0; qb < 2; ++qb)
#pragma unroll
            for (int ab = 0; ab < 2; ++ab) sa[qb][ab] = (f32x4){0.f, 0.f, 0.f, 0.f};
#pragma unroll
        for (int ab = 0; ab < 2; ++ab) {
            const int key = 32 * g + (c >> 2) * 8 + 4 * ab + (c & 3);
            const bf16* kp = TOK + (size_t)(tc0 + key) * TOKP + TK_KR + h * HD + rq * 8;
#pragma unroll
            for (int ks = 0; ks < 4; ++ks) { const bf16x8 kf = ld_b8(kp + ks * 32);
#pragma unroll
                for (int qb = 0; qb < 2; ++qb) sa[qb][ab] = mfma16(kf, Qf[qb][ks], sa[qb][ab]); }
        }
        bf16x8 Pf[2];
#pragma unroll
        for (int qb = 0; qb < 2; ++qb) {
            const int i = qb2 * 32 + qb * 16 + c;
#pragma unroll
            for (int ab = 0; ab < 2; ++ab)
#pragma unroll
                for (int e = 0; e < 4; ++e) { const int diff = i - (32 * g + 8 * rq + 4 * ab + e);
                    sa[qb][ab][e] = diff >= 0 ? sa[qb][ab][e] * fexp2((float)diff * lg) : 0.f; }
            Pf[qb] = pack8(sa[qb][0], sa[qb][1]);
        }
#pragma unroll
        for (int eb = 0; eb < 8; ++eb) { const bf16x8 vf = ld_b8(SWP + (size_t)(SW_VR + h * HD + eb * 16 + c) * SWPP + tc0 + 32 * g + 8 * rq);
#pragma unroll
            for (int qb = 0; qb < 2; ++qb) acc[qb][eb] = mfma16(vf, Pf[qb], acc[qb][eb]); }
    }
#pragma unroll
    for (int qb = 0; qb < 2; ++qb) {
        const int t = tq0 + qb * 16 + c;
        float ss = 0.f;
#pragma unroll
        for (int eb = 0; eb < 8; ++eb) ss += (acc[qb][eb][0] * acc[qb][eb][0] + acc[qb][eb][1] * acc[qb][eb][1]) + (acc[qb][eb][2] * acc[qb][eb][2] + acc[qb][eb][3] * acc[qb][eb][3]);
        const float rstd = frsq(rq_sum(ss) * (1.f / HD) + EPS);
#pragma unroll
        for (int eb = 0; eb < 8; ++eb) {
            const int e0 = h * HD + eb * 16 + rq * 4;
            const f32x4 g4 = ld_f4(F.ret_g + l * 1024 + e0);
            const u32x2 gw = ld_u2(TOK + (size_t)t * TOKP + TK_GR + e0);
            u32x2 o; o.x = pk2(acc[qb][eb][0] * rstd * g4[0] * bf_lo(gw.x), acc[qb][eb][1] * rstd * g4[1] * bf_hi(gw.x));
            o.y = pk2(acc[qb][eb][2] * rstd * g4[2] * bf_lo(gw.y), acc[qb][eb][3] * rstd * g4[3] * bf_hi(gw.y));
            st_u2(MIX + (size_t)t * D + 1024 + e0, o);
        }
    }
}

__device__ __constant__ unsigned char kCandAB[64] = {0, 1, 2, 3, 4, 5, 6, 7, 8, 9, 10, 11, 12, 13, 14, 15, 16, 17, 18, 19, 20, 21, 22, 23, 32, 33, 34, 35, 36, 48, 49, 50, 51, 64, 65, 66, 80, 81, 96, 97,
                                                   112, 113, 128, 144, 160, 176, 192, 208, 224, 240, 0, 0, 0, 0, 0, 0, 0, 0, 0, 0, 0, 0, 0, 0};
template <unsigned MASK> __device__ __forceinline__ float embed_idx(float x, unsigned idx) {
    const unsigned u = __builtin_bit_cast(unsigned, x); const unsigned low = (u >> 31) ? idx : (MASK - idx);
    return __builtin_bit_cast(float, (u & ~MASK) | low);
}
template <unsigned MASK> __device__ __forceinline__ unsigned decode_idx(float y) {
    const unsigned u = __builtin_bit_cast(unsigned, y); const unsigned low = u & MASK; return (u >> 31) ? low : (MASK - low);
}
template <int N> __device__ __forceinline__ void sortdesc(float (&v)[N]) {
#pragma unroll
    for (int k = 2; k <= N; k <<= 1)
#pragma unroll
        for (int j = k >> 1; j > 0; j >>= 1)
#pragma unroll
            for (int i = 0; i < N; ++i) { const int p = i ^ j;
                if (p > i) { const bool desc = ((i & k) == 0); const float a = v[i], b = v[p], hi = fmaxf(a, b), lo = fminf(a, b); v[i] = desc ? hi : lo; v[p] = desc ? lo : hi; } }
}
__device__ __forceinline__ void merge16(float (&v)[16]) {
#pragma unroll
    for (int j = 8; j > 0; j >>= 1)
#pragma unroll
        for (int i = 0; i < 16; ++i) { const int p = i ^ j; if (p > i) { const float a = v[i], b = v[p]; v[i] = fmaxf(a, b); v[p] = fminf(a, b); } }
}
__device__ __forceinline__ void top16_of_group(float (&a)[16]) {
#pragma unroll
    for (int sh = 16; sh <= 32; sh <<= 1) {
        float cc[16];
#pragma unroll
        for (int i = 0; i < 16; ++i) cc[i] = fmaxf(a[i], __shfl_xor(a[15 - i], sh));
        merge16(cc);
#pragma unroll
        for (int i = 0; i < 16; ++i) a[i] = cc[i];
    }
}
constexpr int TL_STRIDE = 17, TL_WAVE_FLOATS = 2 * 16 * TL_STRIDE;
constexpr int KL_PITCH = 272, KL_BYTES = 2 * 128 * KL_PITCH;
static_assert(KL_BYTES + NWAVES * TL_WAVE_FLOATS * 4 <= RING_BYTES, "top-k LDS map");
__device__ __forceinline__ void topk_task(const Frame& F, int l, int tb, int h, const LAS unsigned char* kl, LAS float* tl) {
    int lane = lane_id(); asm volatile("" : "+v"(lane));
    const int c = lane & 15, rq = lane >> 4;
    const int t0 = tb * 16;
    const bf16* QP = (const bf16*)(F.ws + WS_QP);
    int* EXPI = (int*)(F.ws + WS_EXP); float* GATE = (float*)(F.ws + WS_GATE);
    const float NEG = -__builtin_inff();
#pragma unroll
    for (int p = 0; p < 2; ++p) {
        bf16x8 Qf[4];
#pragma unroll
        for (int ks = 0; ks < 4; ++ks) Qf[ks] = ld_b8(QP + (size_t)(t0 + c) * QPP + h * 256 + p * 128 + ks * 32 + rq * 8);
        float v[32];
        const LAS unsigned char* kbase = kl + (p * 128 + c) * KL_PITCH + rq * 16;
#pragma unroll
        for (int kb = 0; kb < 8; ++kb) {
            f32x4 a = (f32x4){0.f, 0.f, 0.f, 0.f};
#pragma unroll
            for (int ks = 0; ks < 4; ++ks) a = mfma16(*(const LAS bf16x8*)(kbase + kb * 16 * KL_PITCH + ks * 64), Qf[ks], a);
#pragma unroll
            for (int e = 0; e < 4; ++e) v[kb * 4 + e] = embed_idx<127u>(a[e], (unsigned)(kb * 16 + rq * 4 + e));
        }
        sortdesc<32>(v);
        float top[16];
#pragma unroll
        for (int i = 0; i < 16; ++i) top[i] = v[i];
        top16_of_group(top);
        if (rq == 0) {
#pragma unroll
            for (int it = 0; it < 16; ++it) tl[(p * 16 + c) * TL_STRIDE + it] = top[it];
        }
    }
    LDS_WAIT(); asm volatile("" ::: "memory");
    const LAS float* t0l = tl + (0 * 16 + c) * TL_STRIDE; const LAS float* t1l = tl + (16 + c) * TL_STRIDE;
    float res[16];
#pragma unroll
    for (int j = 0; j < 16; ++j) {
        const int cid = j * 4 + rq; const unsigned ab = kCandAB[cid < 50 ? cid : 0];
        const float sum = t0l[ab >> 4] + t1l[ab & 15];
        res[j] = (j < 13 && cid < 50) ? embed_idx<63u>(sum, (unsigned)cid) : NEG;
    }
    sortdesc<16>(res);
    top16_of_group(res);
    float rs2 = 0.f;
    { const float* SS2 = (const float*)(F.ws + WS_SS2) + (t0 + c);
#pragma unroll
        for (int i = 0; i < 8; ++i) rs2 += *(const GAS float*)(SS2 + (size_t)(rq * 8 + i) * T); }
    const float lsc = frsq(rq_sum(rs2) * (1.f / D) + EPS) * LOG2E;
    float den = 0.f;
#pragma unroll
    for (int it = 0; it < 16; ++it) den += fexp2((res[it] - res[0]) * lsc);
    const float rden = 1.0f / den;
#pragma unroll
    for (int it = 0; it < 16; ++it) {
        if ((it >> 2) == rq) {
            const unsigned cid = decode_idx<63u>(res[it]); const unsigned ab = kCandAB[cid];
            const unsigned i1 = decode_idx<127u>(t0l[ab >> 4]), i2 = decode_idx<127u>(t1l[ab & 15]);
            const size_t o = (size_t)(t0 + c) * 128 + h * 16 + it;
            *(GAS int*)(EXPI + o) = (int)(i1 * 128u + i2);
            *(GAS float*)(GATE + o) = fexp2((res[it] - res[0]) * lsc) * rden;
        }
    }
    LDS_WAIT(); asm volatile("" ::: "memory");
}

__device__ __forceinline__ float reduce16(const float (&p)[16], int lane) {
    const bool b5 = lane & 32, b4 = lane & 16, b3 = lane & 8, b2 = lane & 4;
    float q[8], r4[4], s2[2];
#pragma unroll
    for (int k = 0; k < 8; ++k) { const float send = b5 ? p[k] : p[k + 8], keep = b5 ? p[k + 8] : p[k]; q[k] = keep + __shfl_xor(send, 32); }
#pragma unroll
    for (int k = 0; k < 4; ++k) { const float send = b4 ? q[k] : q[k + 4], keep = b4 ? q[k + 4] : q[k]; r4[k] = keep + __shfl_xor(send, 16); }
#pragma unroll
    for (int k = 0; k < 2; ++k) { const float send = b3 ? r4[k] : r4[k + 2], keep = b3 ? r4[k + 2] : r4[k]; s2[k] = keep + __shfl_xor(send, 8); }
    const float send = b2 ? s2[0] : s2[1], keep = b2 ? s2[1] : s2[0];
    float v = keep + __shfl_xor(send, 4);
    v += __shfl_xor(v, 1); v += __shfl_xor(v, 2);
    return v;
}
struct RowBuf { u32x4 r[8]; };
__device__ __forceinline__ void rows_load(RowBuf& B, const unsigned char* tab, int ids, int lane_base, int lane) {
#pragma unroll
    for (int r = 0; r < 8; ++r) {
        const int e = __builtin_amdgcn_readlane(ids, lane_base + r);
        B.r[r] = ld_u4(tab + (size_t)e * (D / 2) + lane * 16);
    }
}
__device__ __forceinline__ float dot8f4(unsigned w, const float* hv) {
    const f32x2 a = __builtin_amdgcn_cvt_scalef32_pk_f32_fp4(w, 1.0f, 0), b = __builtin_amdgcn_cvt_scalef32_pk_f32_fp4(w, 1.0f, 1),
                c = __builtin_amdgcn_cvt_scalef32_pk_f32_fp4(w, 1.0f, 2), d = __builtin_amdgcn_cvt_scalef32_pk_f32_fp4(w, 1.0f, 3);
    return ((a[0] * hv[0] + a[1] * hv[1]) + (b[0] * hv[2] + b[1] * hv[3])) + ((c[0] * hv[4] + c[1] * hv[5]) + (d[0] * hv[6] + d[1] * hv[7]));
}
__device__ __forceinline__ float dot32(const u32x4 w, const float* hv) { return (dot8f4(w.x, hv) + dot8f4(w.y, hv + 8)) + (dot8f4(w.z, hv + 16) + dot8f4(w.w, hv + 24)); }
__device__ __forceinline__ void axpy8f4(unsigned w, float s, float* o) {
    const f32x2 a = __builtin_amdgcn_cvt_scalef32_pk_f32_fp4(w, 1.0f, 0), b = __builtin_amdgcn_cvt_scalef32_pk_f32_fp4(w, 1.0f, 1),
                c = __builtin_amdgcn_cvt_scalef32_pk_f32_fp4(w, 1.0f, 2), d = __builtin_amdgcn_cvt_scalef32_pk_f32_fp4(w, 1.0f, 3);
    o[0] += s * a[0]; o[1] += s * a[1]; o[2] += s * b[0]; o[3] += s * b[1]; o[4] += s * c[0]; o[5] += s * c[1]; o[6] += s * d[0]; o[7] += s * d[1];
}
__device__ __forceinline__ void axpy32(const u32x4 w, float s, float* o) { axpy8f4(w.x, s, o); axpy8f4(w.y, s, o + 8); axpy8f4(w.z, s, o + 16); axpy8f4(w.w, s, o + 24); }
constexpr size_t XSL_BYTES = (size_t)NEXP * 128;
constexpr int XW_S = 0, XW_SQ = 8192, XW_RS = 10240, XW_B = 10304, XW_ID = 10816, XW_BYTES = 13312;
constexpr int XZ_OFF = NWAVES * XW_BYTES, XZ_BYTES = 512;
constexpr int XG_OFF = XZ_OFF + XZ_BYTES;
typedef int i32x8 __attribute__((ext_vector_type(8)));
struct URows { u32x4 r[16]; };
__device__ __forceinline__ f32x4 reduce32to4(const float (&p)[32], int lane) {
    const bool b5 = (lane & 32) != 0, b4 = (lane & 16) != 0, b3 = (lane & 8) != 0;
    float q[16], r8[8]; f32x4 o;
#pragma unroll
    for (int k = 0; k < 16; ++k) { const float send = b5 ? p[k] : p[k + 16], keep = b5 ? p[k + 16] : p[k]; q[k] = keep + __shfl_xor(send, 32); }
#pragma unroll
    for (int k = 0; k < 8; ++k) { const float send = b4 ? q[k] : q[k + 8], keep = b4 ? q[k + 8] : q[k]; r8[k] = keep + __shfl_xor(send, 16); }
#pragma unroll
    for (int k = 0; k < 4; ++k) { const float send = b3 ? r8[k] : r8[k + 4], keep = b3 ? r8[k + 4] : r8[k]; o[k] = keep + __shfl_xor(send, 8); }
    return o;
}
#define XFENCE() asm volatile("" ::: "memory")
__device__ __forceinline__ u32x4 ldo_u4(const void* base, unsigned off) { return *(const GAS u32x4*)((const GAS unsigned char*)base + off); }
__device__ __forceinline__ u32x2 ldo_u2(const void* base, unsigned off) { return *(const GAS u32x2*)((const GAS unsigned char*)base + off); }
__device__ __forceinline__ void sto_u2(void* base, unsigned off, u32x2 v) { *(GAS u32x2*)((GAS unsigned char*)base + off) = v; }
__device__ __forceinline__ void sto_f4(void* base, unsigned off, f32x4 v) { *(GAS f32x4*)((GAS unsigned char*)base + off) = v; }
__device__ __forceinline__ void expert_phase(const Frame& F, int l, int xcc, LAS unsigned char* wl, const LAS unsigned char* zb) {
    int lane = lane_id(); asm volatile("" : "+v"(lane));
    const int c = lane & 15, rq = lane >> 4, rr = lane >> 3, pc = lane & 7;
    LAS float* SA = (LAS float*)(wl + XW_S); LAS float* SQ = (LAS float*)(wl + XW_SQ); LAS float* RS = (LAS float*)(wl + XW_RS); LAS unsigned char* BI = wl + XW_B; LAS unsigned char* IDL = wl + XW_ID;
    const unsigned char* UBl = (const unsigned char*)(F.ws + WS_UB) + (size_t)l * NEXP * (D / 2); const unsigned char* VBl = (const unsigned char*)(F.ws + WS_VB) + (size_t)l * NEXP * (D / 2);
    const unsigned* SUV = (const unsigned*)(F.ws + WS_SU) + (size_t)l * NEXP;
    const bf16* X1 = (const bf16*)(F.ws + WS_H2); bf16* XR = (bf16*)(F.ws + WS_XR);
    const int* EXPI = (const int*)(F.ws + WS_EXP); const float* GATE = (const float*)(F.ws + WS_GATE);
    const LAS float* G2 = (const LAS float*)(zb + XZ_BYTES);
    for (int tb = F.gw; tb < T; tb += 8 * F.ngw) {
        auto tok = [&](int k) { const int t = tb + k * F.ngw; return t < T ? t : tb; };
        auto slice_of = [&](int i) { return ((i >> 3) + xcc) & 7; };
        {
            float zf = 0.f; asm volatile("" : "+v"(zf)); const f32x4 z = (f32x4){zf, zf, zf, zf};
#pragma unroll
            for (int i = 0; i < 8; ++i) *(LAS f32x4*)(SA + (i * 64 + lane) * 4) = z;
#pragma unroll
            for (int i = 0; i < 2; ++i) *(LAS f32x4*)(SQ + (i * 64 + lane) * 4) = z;
#pragma unroll
            for (int k = 0; k < 8; ++k) { const u32x2 e2 = ldo_u2(EXPI + (size_t)tok(k) * 128, 8u * lane); *(LAS unsigned*)(IDL + k * 256 + lane * 4) = e2.x | (e2.y << 16); }
            const float* SS2 = (const float*)(F.ws + WS_SS2);
            float ss[8];
#pragma unroll
            for (int k = 0; k < 8; ++k) ss[k] = *(const GAS float*)(SS2 + (size_t)(lane & 31) * T + tok(k));
#pragma unroll
            for (int k = 0; k < 8; ++k) { const float tot = wave_sum(ss[k]) * 0.5f; if (lane == 0) RS[k] = frsq(tot * (1.f / D) + EPS); }
            LDS_WAIT(); XFENCE();
        }
#ifndef U_REP
#define U_REP 1
#endif
#ifndef V_REP
#define V_REP 1
#endif
        for (int urep = 0; urep < U_REP; ++urep) {
            if (urep) { float zf = 0.f; asm volatile("" : "+v"(zf)); const f32x4 z = (f32x4){zf, zf, zf, zf};
#pragma unroll
                for (int i = 0; i < 8; ++i) *(LAS f32x4*)(SA + (i * 64 + lane) * 4) = z;
                LDS_WAIT(); XFENCE(); }
            const LAS unsigned char* bbase = c < 2 ? BI + c * 128 + rq * 32 : zb;
            LAS unsigned char* bw = BI + (lane >> 5) * 256 + (((lane & 31) >> 2) & 3) * 32 + ((lane & 31) >> 4) * 16 + (lane & 3) * 4;
            auto u_x = [&](int i) { return ldo_u2(X1 + (size_t)tok(i & 7) * D + slice_of(i) * 256, 8u * lane); };
            struct HRows { u32x4 r[8]; };
            auto u_rows_h = [&](int hs, HRows& H) {
                const int i = hs >> 1, mg = hs & 1;
                const unsigned char* Usl = UBl + (size_t)slice_of(i) * XSL_BYTES;
                const u32x2 id = *(const LAS u32x2*)(IDL + (i & 7) * 256 + c * 16 + mg * 8);
#ifdef U_PROBE_MASK
                const unsigned pm = (U_REP > 1 && urep == 0) ? (unsigned)(U_PROBE_MASK) : 0xffffu;
#else
                const unsigned pm = 0xffffu;
#endif
                const unsigned i0 = id.x, i1 = id.y;
#pragma unroll
                for (int mm = 0; mm < 4; ++mm) { const unsigned w = mm < 2 ? i0 : i1; const unsigned e = (mm & 1) ? (w >> 16) : (w & 0xffffu); const unsigned off = (e & pm) * 128u + 16u * rq;
                    H.r[2 * mm] = ldo_u4(Usl, off); H.r[2 * mm + 1] = ldo_u4(Usl + 64, off); }
            };
            i32x8 B0, B1;
            auto u_bbuild = [&](int i, const u32x2& xw) {
                const int k = i & 7;
                const f32x4 gg = *(const LAS f32x4*)(G2 + slice_of(i) * 256 + 4 * lane);
                const float rstd = RS[k];
                const float h0 = bf_lo(xw.x) * rstd * gg[0], h1 = bf_hi(xw.x) * rstd * gg[1], h2 = bf_lo(xw.y) * rstd * gg[2], h3 = bf_hi(xw.y) * rstd * gg[3];
                int w = __builtin_amdgcn_cvt_pk_fp8_f32(h0, h1, 0, false); w = __builtin_amdgcn_cvt_pk_fp8_f32(h2, h3, w, true);
                const f32x2 b0 = __builtin_amdgcn_cvt_pk_f32_fp8(w, false), b1 = __builtin_amdgcn_cvt_pk_f32_fp8(w, true);
                int v = __builtin_amdgcn_cvt_pk_fp8_f32(h0 - b0[0], h1 - b0[1], 0, false); v = __builtin_amdgcn_cvt_pk_fp8_f32(h2 - b1[0], h3 - b1[1], v, true);
                *(LAS int*)(bw) = w; *(LAS int*)(bw + 128) = v;
                LDS_WAIT(); XFENCE();
                const u32x4 b0l = *(const LAS u32x4*)(bbase), b0h = *(const LAS u32x4*)(bbase + 16), b1l = *(const LAS u32x4*)(bbase + 256), b1h = *(const LAS u32x4*)(bbase + 272);
                B0 = (i32x8){(int)b0l.x, (int)b0l.y, (int)b0l.z, (int)b0l.w, (int)b0h.x, (int)b0h.y, (int)b0h.z, (int)b0h.w};
                B1 = (i32x8){(int)b1l.x, (int)b1l.y, (int)b1l.z, (int)b1l.w, (int)b1h.x, (int)b1h.y, (int)b1h.z, (int)b1h.w};
            };
            auto u_comp_h = [&](int hs, HRows& H) {
                const int k = (hs >> 1) & 7, mg = hs & 1;
                LAS f32x4* tp = (LAS f32x4*)(SA + k * 256 + (c & 1) * 16 + 4 * rq) + mg * 32;
                f32x4 acc[4];
#pragma unroll
                for (int mm = 0; mm < 4; ++mm) acc[mm] = (f32x4){0.f, 0.f, 0.f, 0.f};
                if (c < 2) {
#pragma unroll
                    for (int mm = 0; mm < 4; ++mm) acc[mm] = tp[mm * 8];
                }
#pragma unroll
                for (int mm = 0; mm < 4; ++mm) {
                    const i32x8 a0 = {(int)H.r[2 * mm].x, (int)H.r[2 * mm].y, (int)H.r[2 * mm].z, (int)H.r[2 * mm].w, 0, 0, 0, 0};
                    const i32x8 a1 = {(int)H.r[2 * mm + 1].x, (int)H.r[2 * mm + 1].y, (int)H.r[2 * mm + 1].z, (int)H.r[2 * mm + 1].w, 0, 0, 0, 0};
                    acc[mm] = __builtin_amdgcn_mfma_scale_f32_16x16x128_f8f6f4(a0, B0, acc[mm], 4, 0, 0, 0x7F7F7F7F, 0, 0x7F7F7F7F);
                    acc[mm] = __builtin_amdgcn_mfma_scale_f32_16x16x128_f8f6f4(a1, B1, acc[mm], 4, 0, 0, 0x7F7F7F7F, 0, 0x7F7F7F7F);
                }
                if (c < 2) {
#pragma unroll
                    for (int mm = 0; mm < 4; ++mm) tp[mm * 8] = acc[mm];
                }
            };
            HRows H0, H1, H2, H3;
            u32x2 xe, xo;
            xe = u_x(0);
            u_rows_h(0, H0); u_rows_h(1, H1); u_rows_h(2, H2);
            xo = u_x(1);
            XFENCE();
#pragma unroll 1
            for (int hs = 0; hs < 128; hs += 4) {
                const int i = hs >> 1;
                const int h3 = hs + 3, h4 = hs + 4 < 128 ? hs + 4 : 127, h5 = hs + 5 < 128 ? hs + 5 : 127, h6 = hs + 6 < 128 ? hs + 6 : 127;
                u_rows_h(h3, H3);
                XFENCE();
                u_bbuild(i, xe); u_comp_h(hs, H0);
                XFENCE();
                u_rows_h(h4, H0); xe = u_x(i + 2 < 64 ? i + 2 : 63);
                XFENCE();
                u_comp_h(hs + 1, H1);
                XFENCE();
                u_rows_h(h5, H1);
                XFENCE();
                u_bbuild(i + 1, xo); u_comp_h(hs + 2, H2);
                XFENCE();
                u_rows_h(h6, H2); xo = u_x(i + 3 < 64 ? i + 3 : 63);
                XFENCE();
                u_comp_h(hs + 3, H3);
                XFENCE();
            }
        }
        LDS_WAIT(); XFENCE();
        {
            unsigned suvq[8][2]; float gtq[8][2];
#pragma unroll
            for (int k = 0; k < 8; ++k)
#pragma unroll
                for (int hf = 0; hf < 2; ++hf) { const unsigned e = *(const LAS unsigned short*)(IDL + k * 256 + (hf * 64 + lane) * 2);
                    suvq[k][hf] = *(const GAS unsigned*)(SUV + e); gtq[k][hf] = *(const GAS float*)(GATE + (size_t)tok(k) * 128 + hf * 64 + lane); }
#pragma unroll
            for (int k = 0; k < 8; ++k) {
                float wq[2];
#pragma unroll
                for (int hf = 0; hf < 2; ++hf) {
                    const unsigned suv = suvq[k][hf];
                    const int kk = hf * 64 + lane;
                    const float a = (SA[k * 256 + (kk & 7) * 32 + (kk >> 3)] + SA[k * 256 + (kk & 7) * 32 + 16 + (kk >> 3)]) * bf_lo(suv);
                    wq[hf] = gtq[k][hf] * bf_hi(suv) * 0.5f * a * (1.0f + erff(a * 0.7071067811865476f));
                }
                XFENCE();
                float wm = fmaxf(__builtin_fabsf(wq[0]), __builtin_fabsf(wq[1]));
#pragma unroll
                for (int o = 1; o < 64; o <<= 1) wm = fmaxf(wm, __shfl_xor(wm, o));
                const float sc = __builtin_bit_cast(float, __builtin_bit_cast(unsigned, fminf(42.0f / fmaxf(wm, 1e-30f), 1.0e18f)) & 0x7f800000u);
                const unsigned h0 = (unsigned)__builtin_bit_cast(unsigned short, (_Float16)(wq[0] * sc)), h1 = (unsigned)__builtin_bit_cast(unsigned short, (_Float16)(wq[1] * sc));
                ((LAS unsigned*)SA)[k * 256 + lane] = h0 | (h0 << 16); ((LAS unsigned*)SA)[k * 256 + 64 + lane] = h1 | (h1 << 16);
                if (lane == 0) RS[8 + k] = 1.0f / sc;
            }
        }
        LDS_WAIT(); XFENCE();
        for (int vrep = 0; vrep < V_REP; ++vrep) {
            if (vrep) { float zf = 0.f; asm volatile("" : "+v"(zf)); const f32x4 z = (f32x4){zf, zf, zf, zf};
#pragma unroll
                for (int i = 0; i < 2; ++i) *(LAS f32x4*)(SQ + (i * 64 + lane) * 4) = z;
                LDS_WAIT(); XFENCE(); }
            auto v_rows = [&](int i, URows& R) {
                const unsigned char* Vsl = VBl + (size_t)slice_of(i) * XSL_BYTES;
                const u32x4 ia = *(const LAS u32x4*)(IDL + (i & 7) * 256 + rr * 32), ib = *(const LAS u32x4*)(IDL + (i & 7) * 256 + rr * 32 + 16);
#pragma unroll
                for (int j = 0; j < 16; ++j) { const unsigned w = j < 8 ? ia[(j >> 1) & 3] : ib[(j >> 1) & 3]; const unsigned e = (j & 1) ? (w >> 16) : (w & 0xffffu);
                    R.r[j] = ldo_u4(Vsl, e * 128u + 16u * pc); }
            };
            auto v_comp = [&](int i, const URows& R) {
                const int k = i & 7, t = tok(k), sl = slice_of(i);
                const unsigned col = 32u * pc + 4u * rr;
                u32x2 xw;
                typedef _Float16 hf2 __attribute__((ext_vector_type(2)));
                const LAS u32x4* wp = (const LAS u32x4*)(SA + k * 256 + 16 * rr);
                const u32x4 wall[4] = {wp[0], wp[1], wp[2], wp[3]};
                unsigned out[16];
#pragma unroll
                for (int j = 0; j < 16; ++j) out[j] = 0u;
#pragma unroll
                for (int j = 0; j < 16; ++j) {
                    if (j == 8) xw = ldo_u2(X1 + (size_t)t * D + sl * 256, 2u * col);
                    u32x4 rj = R.r[j];
                    asm volatile("" : "+v"(rj.x), "+v"(rj.y), "+v"(rj.z), "+v"(rj.w) :: "memory");
                    const unsigned wj = wall[j >> 2][j & 3]; const hf2 w2 = __builtin_bit_cast(hf2, wj);
#pragma unroll
                    for (int d = 0; d < 4; ++d) {
                        const hf2 a = __builtin_amdgcn_cvt_scalef32_pk_f16_fp4(rj[d], 1.0f, 0), b = __builtin_amdgcn_cvt_scalef32_pk_f16_fp4(rj[d], 1.0f, 1),
                                  cc = __builtin_amdgcn_cvt_scalef32_pk_f16_fp4(rj[d], 1.0f, 2), dd = __builtin_amdgcn_cvt_scalef32_pk_f16_fp4(rj[d], 1.0f, 3);
                        out[4 * d] = __builtin_bit_cast(unsigned, __builtin_elementwise_fma(a, w2, __builtin_bit_cast(hf2, out[4 * d])));
                        out[4 * d + 1] = __builtin_bit_cast(unsigned, __builtin_elementwise_fma(b, w2, __builtin_bit_cast(hf2, out[4 * d + 1])));
                        out[4 * d + 2] = __builtin_bit_cast(unsigned, __builtin_elementwise_fma(cc, w2, __builtin_bit_cast(hf2, out[4 * d + 2])));
                        out[4 * d + 3] = __builtin_bit_cast(unsigned, __builtin_elementwise_fma(dd, w2, __builtin_bit_cast(hf2, out[4 * d + 3])));
                    }
                    if ((j & 3) == 3) asm volatile("" : "+v"(out[0]), "+v"(out[1]), "+v"(out[2]), "+v"(out[3]), "+v"(out[4]), "+v"(out[5]), "+v"(out[6]), "+v"(out[7]), "+v"(out[8]), "+v"(out[9]), "+v"(out[10]), "+v"(out[11]), "+v"(out[12]), "+v"(out[13]), "+v"(out[14]), "+v"(out[15]) :: "memory");
                }
                unsigned o2[2];
                {
                    const bool b5 = (lane & 32) != 0, b4 = (lane & 16) != 0, b3 = (lane & 8) != 0;
                    unsigned q8[8], q4[4];
                    auto hadd = [](unsigned x, unsigned y) { return __builtin_bit_cast(unsigned, __builtin_bit_cast(hf2, x) + __builtin_bit_cast(hf2, y)); };
#pragma unroll
                    for (int n = 0; n < 8; ++n) { const unsigned send = b5 ? out[n] : out[n + 8], keep = b5 ? out[n + 8] : out[n]; q8[n] = hadd(keep, (unsigned)__shfl_xor((int)send, 32)); }
#pragma unroll
                    for (int n = 0; n < 4; ++n) { const unsigned send = b4 ? q8[n] : q8[n + 4], keep = b4 ? q8[n + 4] : q8[n]; q4[n] = hadd(keep, (unsigned)__shfl_xor((int)send, 16)); }
#pragma unroll
                    for (int n = 0; n < 2; ++n) { const unsigned send = b3 ? q4[n] : q4[n + 2], keep = b3 ? q4[n + 2] : q4[n]; o2[n] = hadd(keep, (unsigned)__shfl_xor((int)send, 8)); }
                }
                const float isc = RS[8 + k];
                const hf2 oa = __builtin_bit_cast(hf2, o2[0]), ob = __builtin_bit_cast(hf2, o2[1]);
                const float y0 = bf_lo(xw.x) + (float)oa[0] * isc, y1 = bf_hi(xw.x) + (float)oa[1] * isc, y2 = bf_lo(xw.y) + (float)ob[0] * isc, y3 = bf_hi(xw.y) + (float)ob[1] * isc;
                if (l + 1 < DEPTH) {
                    u32x2 w; w.x = pk2(y0, y1); w.y = pk2(y2, y3);
                    sto_u2(XR + (size_t)t * D + sl * 256, 2u * col, w);
                    const float s = (y0 * y0 + y1 * y1) + (y2 * y2 + y3 * y3);
                    (void)__hip_atomic_fetch_add(SQ + k * 64 + lane, s, __ATOMIC_RELAXED, __HIP_MEMORY_SCOPE_WAVEFRONT);
                } else sto_f4(F.out + (size_t)t * D + sl * 256, 4u * col, (f32x4){y0, y1, y2, y3});
            };
            URows RA, RB;
            v_rows(0, RA);
            XFENCE();
#pragma unroll 1
            for (int i = 0; i < 64; i += 2) {
                const int i2 = i + 2 < 64 ? i + 2 : 63;
                v_rows(i + 1, RB);
                XFENCE();
                v_comp(i, RA);
                XFENCE();
                v_rows(i2, RA);
                XFENCE();
                v_comp(i + 1, RB);
                XFENCE();
            }
        }
        if (l + 1 < DEPTH) {
            float* RSTD = (float*)(F.ws + WS_RSTD);
#pragma unroll
            for (int k = 0; k < 8; ++k) { const float r1 = frsq(wave_sum(SQ[k * 64 + lane]) * (1.f / D) + EPS); if (lane == 0) *(GAS float*)(RSTD + tok(k)) = r1; }
        }
        LDS_WAIT(); XFENCE();
    }
}

#ifndef PG8_SP2
#define PG8_SP2 true
#endif
#ifndef PG8_ALIGN
#define PG8_ALIGN true
#endif
struct Args { const float* in[14]; float* out; unsigned char* ws; int ph_lo, ph_hi, use_bar, pad; };
__global__ void __launch_bounds__(NWAVES * 64, 2) hybrid_fwd(Args args) {
    extern __shared__ __attribute__((aligned(16))) unsigned char lds_raw[];
    Frame F;
    F.lds = (LAS unsigned char*)lds_raw;
    F.wave = __builtin_amdgcn_readfirstlane((int)threadIdx.x >> 6);
    F.G = gridDim.x; F.gw = blockIdx.x * NWAVES + F.wave; F.ngw = F.G * NWAVES;
    F.x = args.in[0]; F.norm1_g = args.in[1]; F.w_in = args.in[2]; F.qa_g = args.in[3]; F.ka_g = args.in[4]; F.rel_bias = args.in[5]; F.attn_g = args.in[6]; F.ret_g = args.in[7];
    F.w_out = args.in[8]; F.norm2_g = args.in[9]; F.peer_wq = args.in[10]; F.peer_keys = args.in[11]; F.peer_u = args.in[12]; F.peer_v = args.in[13];
    F.out = args.out; F.ws = args.ws;
    for (int u = threadIdx.x; u < (LDS_BYTES - LDSCTL_OFF) / 4; u += NWAVES * 64) ((LAS unsigned*)(F.lds + LDSCTL_OFF))[u] = 0u;
    __syncthreads();
    unsigned* barw = (unsigned*)(args.ws + WS_CTL) + CW_BAR;
    XcdBarrier bar; bar.bar = barw; bar.x = 0; bar.st = nullptr;
    if (args.use_bar) bar = xcd_barrier_post(barw, (volatile LAS unsigned*)(F.lds + MISC_OFF) + 8);
    const int lo = args.ph_lo, hi = args.ph_hi;
#define IN(k) (lo <= (k) && (k) < hi)
#define SEAM(k) do { if (IN((k) + 1)) xcd_barrier(bar, F.wave); } while (0)

#ifndef REP_MASK
#define REP_MASK 0
#endif
#ifndef REP_N
#define REP_N 1
#endif
#define REPS(k) (((REP_MASK >> (k)) & 1) ? REP_N : 1)
#ifndef ONLY
#define PH_ON(k) 1
#else
#define PH_ON(k) ((k)==ONLY)
#endif
    if (PH_ON(0) && IN(0)) { for (int rep = 0; rep < REPS(0); ++rep) p0_prologue(F); SEAM(0); }

    for (int l = 0; l < DEPTH; ++l) {
        const int pb = 1 + l * PH_PER_LAYER;
        if (PH_ON(1) && IN(pb + 0)) for (int rep = 0; rep < REPS(1); ++rep) {
            {
                pg8::Gemm g{(const pg8::bf16_t*)(F.ws + WS_XR), (const pg8::bf16_t*)(F.ws + WS_WTOK) + (size_t)l * TOKC * D, T, TOKC, D};
                pg8::StaticOrder So; So.init(T, TOKC, F.G, (int)blockIdx.x);
                pg8::EpiTok E{(pg8::bf16_t*)(F.ws + WS_TOK), (const pg8::f32x2*)(F.ws + WS_ROPE_TOK), (float*)(F.ws + WS_SSQ), (const float*)(F.ws + WS_RSTD)};
                pg8::gemm_phase<pg8::EpiTok, pg8::StaticOrder, PG8_ALIGN, PG8_SP2>(F.lds + RING_OFF, g, So, E, F.wave);
            }
            {
                pg8::Gemm g{(const pg8::bf16_t*)(F.ws + WS_WSWP) + (size_t)l * SWPR * D, (const pg8::bf16_t*)(F.ws + WS_XR), SWPR, T, D};
                pg8::StaticOrder So; So.init(SWPR, T, F.G, (int)blockIdx.x);
                pg8::EpiSwp E{(pg8::bf16_t*)(F.ws + WS_SWP), SWPP, (const float*)(F.ws + WS_RSTD)};
                pg8::gemm_phase<pg8::EpiSwp, pg8::StaticOrder, PG8_ALIGN, PG8_SP2>(F.lds + RING_OFF, g, So, E, F.wave);
            }
            SEAM(pb + 0);
        }
        if (PH_ON(2) && IN(pb + 1)) for (int rep = 0; rep < REPS(2); ++rep) {
            LAS float* biasL = (LAS float*)(F.lds + RING_OFF + A_BIAS);
            int tid2 = F.wave * 64 + lane_id(); asm volatile("" : "+v"(tid2));
            for (int i = tid2; i < NH * 257; i += NWAVES * 64) biasL[i] = *(const GAS float*)(F.rel_bias + (size_t)l * NH * 257 + i) * LOG2E;
#ifndef SCAN_REP
#define SCAN_REP 1
#endif
            for (int srep = 0; srep < SCAN_REP; ++srep)
            for (int task = F.gw; task < NBATCH * NH * 8 * 2; task += F.ngw) scan_task(F, task);
            {
                constexpr int NAT = NBATCH * NH * 8;
                const int g = (int)blockIdx.x;
                if (F.G == 256) {
                    const int n = g < 128 ? 1 : 3, first = g < 128 ? g : 128 + (g - 128) * 3;
                    for (int i = 0; i < n; ++i) attn_wg_task(F, l, first + i);
                } else {
                    for (int task = g; task < NAT; task += F.G) attn_wg_task(F, l, task);
                }
            }
            SEAM(pb + 1);
        }
        if (PH_ON(3) && IN(pb + 2)) for (int rep = 0; rep < REPS(3); ++rep) {
            for (int task = F.gw; task < NBATCH * NH * NCH * 2; task += F.ngw) ret_task(F, l, task);
            SEAM(pb + 2);
        }
        if (PH_ON(4) && IN(pb + 3)) for (int rep = 0; rep < REPS(4); ++rep) {
            pg8::Gemm g{(const pg8::bf16_t*)(F.ws + WS_MIX), (const pg8::bf16_t*)(F.ws + WS_WOUT) + (size_t)l * D * D, T, D, D};
            pg8::StaticOrder So; So.init(T, D, F.G, (int)blockIdx.x);
            pg8::EpiRes E{l == 0 ? F.x : (const float*)nullptr, (const pg8::bf16_t*)(F.ws + WS_XR), (pg8::bf16_t*)(F.ws + WS_H2), (float*)(F.ws + WS_SS2)};
            pg8::gemm_phase<pg8::EpiRes, pg8::StaticOrder, PG8_ALIGN, PG8_SP2>(F.lds + RING_OFF, g, So, E, F.wave);
            SEAM(pb + 3);
        }
        if (PH_ON(6) && IN(pb + 5)) for (int rep = 0; rep < REPS(6); ++rep) {
            pg8::Gemm g{(const pg8::bf16_t*)(F.ws + WS_H2), (const pg8::bf16_t*)(F.ws + WS_WQ) + (size_t)l * D * D, T, D, D};
            pg8::StaticOrder So; So.init(T, D, F.G, (int)blockIdx.x);
            pg8::EpiB16 E{(pg8::bf16_t*)(F.ws + WS_QP), QPP};
            pg8::gemm_phase<pg8::EpiB16, pg8::StaticOrder, PG8_ALIGN, PG8_SP2>(F.lds + RING_OFF, g, So, E, F.wave);
            SEAM(pb + 5);
        }
        if (PH_ON(7) && IN(pb + 6)) for (int rep = 0; rep < REPS(7); ++rep) {
            LAS unsigned char* kl = F.lds + RING_OFF; LAS float* tl = (LAS float*)(F.lds + RING_OFF + KL_BYTES) + F.wave * TL_WAVE_FLOATS;
            int tid3 = F.wave * 64 + lane_id(); asm volatile("" : "+v"(tid3));
            const bf16* KEYS = (const bf16*)(F.ws + WS_KEYS) + (size_t)l * 8 * 256 * 128;
            for (int wt = blockIdx.x; wt < 256; wt += F.G) {
                const int tg = wt >> 1, hg = wt & 1;
                for (int hi = 0; hi < 4; ++hi) {
                    const int h = hg * 4 + hi;
                    __syncthreads();
#pragma unroll
                    for (int i = 0; i < 8; ++i) { const int idx = tid3 + 512 * i, row = idx >> 4, c16 = idx & 15;
                        *(LAS u32x4*)(kl + row * KL_PITCH + c16 * 16) = ld_u4(KEYS + ((size_t)h * 256 + row) * 128 + c16 * 8); }
                    __syncthreads();
                    topk_task(F, l, tg * 8 + F.wave, h, kl, tl);
                }
            }
            SEAM(pb + 6);
        }
        if (PH_ON(8) && IN(pb + 7)) for (int rep = 0; rep < REPS(8); ++rep) {
            LAS unsigned char* wl = F.lds + RING_OFF + F.wave * XW_BYTES; const LAS unsigned char* zb = F.lds + RING_OFF + XZ_OFF;
            { int tid4 = F.wave * 64 + lane_id(); asm volatile("" : "+v"(tid4)); for (int i = tid4; i < XZ_BYTES / 4; i += NWAVES * 64) ((LAS unsigned*)zb)[i] = 0u;
              for (int i = tid4; i < D; i += NWAVES * 64) ((LAS float*)(F.lds + RING_OFF + XG_OFF))[i] = *(const GAS float*)(F.norm2_g + l * D + i); }
            __syncthreads();
            expert_phase(F, l, (int)xb_xcc_id(), wl, zb);
            SEAM(pb + 7);
        }
    }
#undef IN
#undef SEAM
}

extern "C" void kernel_launch(void* const* d_in, const int* in_sizes, int n_in, void* d_out, int out_size, void* d_ws, size_t ws_size, hipStream_t stream) {
    static int grid = 0;
    if (grid == 0) {
        if (n_in != 14 || in_sizes[0] != T * D || out_size != T * D || ws_size < WS_END) {
            fprintf(stderr, "kernel_launch: unexpected problem (n_in %d, in0 %d, out %d, ws %zu; need ws >= %zu); nothing launched\n", n_in, n_in > 0 ? in_sizes[0] : -1, out_size, ws_size, (size_t)WS_END); grid = -1; return; }
        int dev = 0, cus = 0, per_cu = 0;
        if (hipGetDevice(&dev) != hipSuccess || hipDeviceGetAttribute(&cus, hipDeviceAttributeMultiprocessorCount, dev) != hipSuccess) { fprintf(stderr, "kernel_launch: device query failed\n"); grid = -1; return; }
        if (hipFuncSetAttribute((const void*)hybrid_fwd, hipFuncAttributeMaxDynamicSharedMemorySize, LDS_BYTES) != hipSuccess) { fprintf(stderr, "kernel_launch: hipFuncSetAttribute failed\n"); grid = -1; return; }
        if (hipOccupancyMaxActiveBlocksPerMultiprocessor(&per_cu, (const void*)hybrid_fwd, NWAVES * 64, LDS_BYTES) != hipSuccess || per_cu < 1)
            fprintf(stderr, "kernel_launch: note: occupancy query reports %d workgroups per CU\n", per_cu);
        (void)hipGetLastError();
        grid = cus;
    }
    if (grid < 0) return;
    if (hipMemsetAsync((char*)d_ws + WS_CTL, 0, CTL_ZERO_BYTES, stream) != hipSuccess) { fprintf(stderr, "kernel_launch: memset failed\n"); return; }
    Args a{};
    for (int i = 0; i < 14; ++i) a.in[i] = (const float*)d_in[i];
    a.out = (float*)d_out; a.ws = (unsigned char*)d_ws; a.pad = 0;
#if MK_ONE_LAUNCH
    a.ph_lo = 0; a.ph_hi = N_PHASES; a.use_bar = 1;
    hipLaunchKernelGGL(hybrid_fwd, dim3(grid), dim3(NWAVES * 64), LDS_BYTES, stream, a);
    { const hipError_t le = hipPeekAtLastError(); if (le != hipSuccess) fprintf(stderr, "kernel_launch: launch failed: %s\n", hipGetErrorName(le)); }
#else
    for (int p = 0; p < N_PHASES; ++p) {
        a.ph_lo = p; a.ph_hi = p + 1; a.use_bar = 0;
        hipLaunchKernelGGL(hybrid_fwd, dim3(grid), dim3(NWAVES * 64), LDS_BYTES, stream, a);
        const hipError_t le = hipPeekAtLastError(); if (le != hipSuccess) { fprintf(stderr, "kernel_launch: launch %d failed: %s\n", p, hipGetErrorName(le)); break; }
    }
#endif
}
```

```cpp
#include <hip/hip_runtime.h>
#include <cstdio>
#include <cstdint>

#ifndef MK_ONE_LAUNCH
#define MK_ONE_LAUNCH 1
#endif

namespace pg8 {
#define PG8_LAS __attribute__((address_space(3)))
typedef unsigned short bf16_t;
typedef short bf16x8 __attribute__((ext_vector_type(8)));
typedef float f32x4 __attribute__((ext_vector_type(4)));
typedef unsigned u32x4 __attribute__((ext_vector_type(4)));
constexpr int BM = 256, BK = 64, HALF = 128, HTB = HALF * BK * 2  , STAGE_BYTES = 8 * HTB, NXCD = 8, WGM = 8;

__host__ __device__ __forceinline__ int lds_byte(int r, int c) { const int st = (r >> 4) * 2 + (c >> 5), rr = r & 15, cc = c & 31, ob = rr * 64 + cc * 2; return st * 1024 + (ob ^ (((ob >> 9) & 1) << 5)); }
__host__ __device__ __forceinline__ void stage_rc(int b, int& R, int& C) { const int st = b / 1024, sb = b % 1024, swz = sb ^ (((sb >> 9) & 1) << 5); R = (st >> 1) * 16 + swz / 64; C = (st & 1) * 32 + (swz % 64) / 2; }
__host__ __device__ __forceinline__ int perm32(int rho) { const int n = rho >> 4, i = rho & 15; return 8 * (i >> 2) + 4 * n + (i & 3); }

struct Unit { int pm, pn; };
struct Gemm { const bf16_t* A; const bf16_t* Bt; int M, N, K; };

struct StaticOrder {
    int nM, nN, nwg, G, c;
    __host__ __device__ void init(int M, int N, int G_, int c_) { nM = M / BM; nN = N / BM; nwg = nM * nN; G = G_; c = c_; }
    __host__ __device__ bool next(int i, Unit& u) const {
        const long L = (long)i * G + c; if (L >= nwg) return false;
        int wgid = (int)L; { const int q = nwg / NXCD, r = nwg % NXCD, xcd = wgid % NXCD, off = wgid / NXCD; wgid = (xcd < r ? xcd * (q + 1) : r * (q + 1) + (xcd - r) * q) + off; }
        const int nig = WGM * nN, gid = wgid / nig, fm = gid * WGM, gsz = (nM - fm) < WGM ? (nM - fm) : WGM;
        u.pm = fm + ((wgid % nig) % gsz); u.pn = (wgid % nig) / gsz; return true;
    }
    __device__ __forceinline__ void a_ready(const Unit&) const {}
    __device__ __forceinline__ void done(const Unit&) const {}
};
__device__ __forceinline__ unsigned cvt_pk_bf16(float lo, float hi) { unsigned r; asm volatile("v_cvt_pk_bf16_f32 %0, %1, %2" : "=v"(r) : "v"(lo), "v"(hi)); return r; }

typedef float f32x2 __attribute__((ext_vector_type(2)));
constexpr int MT = 16384, MS = 2048;
constexpr int TOKC = 5120;
constexpr int TOKP = 5248, SWPP = 16512, QPP = 2176;
constexpr float KSCALE = 0.08838834764831845f;
__device__ __forceinline__ float lg2gamma(int h) {
    return h == 0 ? -0.04580368961312479f : h == 1 ? -0.02272007650008353f : h == 2 ? -0.011315313227834146f : h == 3 ? -0.005646563141142063f :
           h == 4 ? -0.0028205190623786626f : h == 5 ? -0.0014095702546713536f : h == 6 ? -0.0007046129765893727f : -0.0003522634716290214f;
}

struct EpiTok {
    static constexpr bool PERM = true, AFTER_DRAIN = false;
    bf16_t* O; const f32x2* cs; float* ssq; const float* rstd;
    __device__ __forceinline__ void operator()(const f32x4 (&acc)[2][2][4][2], const Unit& u, int wr, int wc, int fr, int fq) const {
        const int row0 = u.pm * BM + wr * 64 + fr, kind = u.pn >> 2;
#pragma unroll
        for (int ai = 0; ai < 2; ++ai)
#pragma unroll
            for (int m = 0; m < 4; ++m) {
                const int row = row0 + ai * HALF + m * 16, pos = row & (MS - 1);
                const float rs = rstd[row];
#pragma unroll
                for (int bj = 0; bj < 2; ++bj) {
                    const int c0 = u.pn * BM + bj * HALF + wc * 32 + 8 * fq;
                    f32x4 v0 = acc[ai][bj][m][0] * rs, v1 = acc[ai][bj][m][1] * rs;
                    if (kind <= 1) {
                        float s = (v0[0] * v0[0] + v0[1] * v0[1]) + (v0[2] * v0[2] + v0[3] * v0[3]) + (v1[0] * v1[0] + v1[1] * v1[1]) + (v1[2] * v1[2] + v1[3] * v1[3]);
                        s += __shfl_xor(s, 16); s += __shfl_xor(s, 32);
                        const int head = (u.pn & 3) * 2 + bj;
                        if (fq == 0) ssq[(size_t)((kind * 8 + head) * 4 + wc) * MT + row] = s;
                    } else if (kind <= 3) {
                        const int i0 = (c0 & 127) >> 1;
                        const f32x4 csa = *(const f32x4*)(cs + (size_t)pos * 64 + i0), csb = *(const f32x4*)(cs + (size_t)pos * 64 + i0 + 2);
                        const float sc = (kind == 3) ? KSCALE : 1.0f;
                        f32x4 w0, w1;
                        w0[0] = (v0[0] * csa[0] - v0[1] * csa[1]) * sc; w0[1] = (v0[1] * csa[0] + v0[0] * csa[1]) * sc;
                        w0[2] = (v0[2] * csa[2] - v0[3] * csa[3]) * sc; w0[3] = (v0[3] * csa[2] + v0[2] * csa[3]) * sc;
                        w1[0] = (v1[0] * csb[0] - v1[1] * csb[1]) * sc; w1[1] = (v1[1] * csb[0] + v1[0] * csb[1]) * sc;
                        w1[2] = (v1[2] * csb[2] - v1[3] * csb[3]) * sc; w1[3] = (v1[3] * csb[2] + v1[2] * csb[3]) * sc;
                        v0 = w0; v1 = w1;
                    } else {
#pragma unroll
                        for (int j = 0; j < 4; ++j) { v0[j] = v0[j] * __builtin_amdgcn_rcpf(1.0f + __builtin_amdgcn_exp2f(-1.4426950408889634f * v0[j]));
                                                      v1[j] = v1[j] * __builtin_amdgcn_rcpf(1.0f + __builtin_amdgcn_exp2f(-1.4426950408889634f * v1[j])); }
                    }
                    u32x4 w; w.x = cvt_pk_bf16(v0[0], v0[1]); w.y = cvt_pk_bf16(v0[2], v0[3]); w.z = cvt_pk_bf16(v1[0], v1[1]); w.w = cvt_pk_bf16(v1[2], v1[3]);
                    *(u32x4*)(O + (size_t)row * TOKP + c0) = w;
                }
            }
    }
};
struct EpiRes {
    static constexpr bool PERM = false, AFTER_DRAIN = false;
    const float* R32; const bf16_t* R16; bf16_t* XB; float* ss2;
    __device__ __forceinline__ void operator()(const f32x4 (&acc)[2][2][4][2], const Unit& u, int wr, int wc, int fr, int fq) const {
        const int row0 = u.pm * BM + wr * 64 + fr, col0 = u.pn * BM + wc * 32 + 4 * fq;
#pragma unroll
        for (int ai = 0; ai < 2; ++ai)
#pragma unroll
            for (int m = 0; m < 4; ++m) { const int row = row0 + ai * HALF + m * 16; const size_t ro = (size_t)row * 2048 + col0;
                float s = 0.f;
#pragma unroll
                for (int bj = 0; bj < 2; ++bj)
#pragma unroll
                    for (int n = 0; n < 2; ++n) { f32x4 r;
                        if (R32) r = *(const f32x4*)(R32 + ro + bj * HALF + n * 16);
                        else { typedef unsigned u32x2_t __attribute__((ext_vector_type(2))); const u32x2_t rw = *(const u32x2_t*)(R16 + ro + bj * HALF + n * 16); const unsigned r0 = rw.x, r1 = rw.y;
                            r = (f32x4){__builtin_bit_cast(float, r0 << 16), __builtin_bit_cast(float, r0 & 0xffff0000u), __builtin_bit_cast(float, r1 << 16), __builtin_bit_cast(float, r1 & 0xffff0000u)}; }
                        const f32x4 v = acc[ai][bj][m][n] + r;
                        typedef unsigned u32x2_s __attribute__((ext_vector_type(2))); u32x2_s w; w.x = cvt_pk_bf16(v[0], v[1]); w.y = cvt_pk_bf16(v[2], v[3]);
                        *(u32x2_s*)(XB + ro + bj * HALF + n * 16) = w;
                        s += (v[0] * v[0] + v[1] * v[1]) + (v[2] * v[2] + v[3] * v[3]); }
                s += __shfl_xor(s, 16); s += __shfl_xor(s, 32);
                if (fq == 0) ss2[(size_t)(u.pn * 4 + wc) * MT + row] = s; }
    }
};
struct EpiB16 {
    static constexpr bool PERM = true, AFTER_DRAIN = false;
    bf16_t* O; int ldc;
    __device__ __forceinline__ void operator()(const f32x4 (&acc)[2][2][4][2], const Unit& u, int wr, int wc, int fr, int fq) const {
        const int row0 = u.pm * BM + wr * 64 + fr, col0 = u.pn * BM + wc * 32 + 8 * fq;
#pragma unroll
        for (int ai = 0; ai < 2; ++ai)
#pragma unroll
            for (int m = 0; m < 4; ++m) { bf16_t* rowp = O + (size_t)(row0 + ai * HALF + m * 16) * ldc + col0;
#pragma unroll
                for (int bj = 0; bj < 2; ++bj) { const f32x4 v0 = acc[ai][bj][m][0], v1 = acc[ai][bj][m][1];
                    u32x4 w; w.x = cvt_pk_bf16(v0[0], v0[1]); w.y = cvt_pk_bf16(v0[2], v0[3]); w.z = cvt_pk_bf16(v1[0], v1[1]); w.w = cvt_pk_bf16(v1[2], v1[3]);
                    *(u32x4*)(rowp + bj * HALF) = w; } }
    }
};
struct EpiSwp {
    static constexpr bool PERM = true, AFTER_DRAIN = false;
    bf16_t* O; int ldc; const float* rstd;
    __device__ __forceinline__ void operator()(const f32x4 (&acc)[2][2][4][2], const Unit& u, int wr, int wc, int fr, int fq) const {
        const int row0 = u.pm * BM + wr * 64 + fr, col0 = u.pn * BM + wc * 32 + 8 * fq;
        f32x4 ra[2], rb[2];
#pragma unroll
        for (int bj = 0; bj < 2; ++bj) { ra[bj] = *(const f32x4*)(rstd + col0 + bj * HALF); rb[bj] = *(const f32x4*)(rstd + col0 + bj * HALF + 4); }
#pragma unroll
        for (int ai = 0; ai < 2; ++ai)
#pragma unroll
            for (int m = 0; m < 4; ++m) { bf16_t* rowp = O + (size_t)(row0 + ai * HALF + m * 16) * ldc + col0;
#pragma unroll
                for (int bj = 0; bj < 2; ++bj) { const f32x4 v0 = acc[ai][bj][m][0] * ra[bj], v1 = acc[ai][bj][m][1] * rb[bj];
                    u32x4 w; w.x = cvt_pk_bf16(v0[0], v0[1]); w.y = cvt_pk_bf16(v0[2], v0[3]); w.z = cvt_pk_bf16(v1[0], v1[1]); w.w = cvt_pk_bf16(v1[2], v1[3]);
                    *(u32x4*)(rowp + bj * HALF) = w; } }
    }
};
template <class Epi, class Sched, bool ALIGN_EPI = false, bool SP2 = false>
__device__ __forceinline__ void gemm_phase(PG8_LAS unsigned char* lds, const Gemm g, const Sched& S, const Epi& E, int wave_in) {
    int tid_ = wave_in * 64 + (int)__builtin_amdgcn_mbcnt_hi(~0u, __builtin_amdgcn_mbcnt_lo(~0u, 0u)); asm volatile("" : "+v"(tid_));
    const int tid = tid_, wid = __builtin_amdgcn_readfirstlane(tid >> 6), lane = tid & 63, wr = wid >> 2, wc = wid & 3, fr = lane & 15, fq = lane >> 4;
    const int K = g.K, nt = K / BK;
    unsigned voffA[2], voffB[2];
#pragma unroll
    for (int i = 0; i < 2; ++i) { int R, C; stage_rc(tid * 16 + i * 8192, R, C); const int Rb = Epi::PERM ? ((R & ~31) + perm32(R & 31)) : R;
        voffA[i] = (unsigned)(R * K + C) * 2u; voffB[i] = (unsigned)(Rb * K + C) * 2u; }
    const size_t kstep = (size_t)(BK * 2);
    const size_t hstep = (size_t)HALF * K * 2;
    const size_t tstep = 2 * hstep;
    const unsigned ldsw = (unsigned)wid * 1024u;
    const int aoff = lds_byte(wr * 64 + fr, fq * 8), boff = lds_byte(wc * 32 + fr, fq * 8);
#define PG8_SA(b, h) (((b) * 2 + (h)) * HTB)
#define PG8_SB(b, h) ((4 + (b) * 2 + (h)) * HTB)
#define PG8_STAGE(bufoff, gbase, voff) do { _Pragma("unroll") for (int _i = 0; _i < 2; ++_i) \
        __builtin_amdgcn_global_load_lds((const unsigned*)((const char*)(gbase) + (voff)[_i]), (PG8_LAS unsigned*)(lds + (bufoff) + ldsw + _i * 8192), 16, 0, 0); } while (0)
#define PG8_LDA(dst, b, h) do { _Pragma("unroll") for (int m = 0; m < 4; ++m) _Pragma("unroll") for (int k = 0; k < 2; ++k) dst[m][k] = *(const PG8_LAS bf16x8*)(lds + PG8_SA(b, h) + aoff + m * 2048 + k * 1024); } while (0)
#define PG8_LDB(dst, b, h) do { _Pragma("unroll") for (int n = 0; n < 2; ++n) _Pragma("unroll") for (int k = 0; k < 2; ++k) dst[n][k] = *(const PG8_LAS bf16x8*)(lds + PG8_SB(b, h) + boff + n * 2048 + k * 1024); } while (0)
#define PG8_MMA(ai, bj, At, Bt) do { __builtin_amdgcn_s_setprio(1); _Pragma("unroll") for (int m = 0; m < 4; ++m) _Pragma("unroll") for (int n = 0; n < 2; ++n) _Pragma("unroll") for (int k = 0; k < 2; ++k) \
        acc[ai][bj][m][n] = __builtin_amdgcn_mfma_f32_16x16x32_bf16(Bt[n][k], At[m][k], acc[ai][bj][m][n], 0, 0, 0); __builtin_amdgcn_s_setprio(0); } while (0)
#define PG8_WAIT_V(n) asm volatile("s_waitcnt vmcnt(" #n ")" ::: "memory")
#define PG8_WAIT_L(n) asm volatile("s_waitcnt lgkmcnt(" #n ")" ::: "memory")
#define PG8_BAR __builtin_amdgcn_s_barrier()
#define PG8_SCHED __builtin_amdgcn_sched_barrier(0)
    Unit cur, nxt; int ui = 0;
    if (!S.next(0, cur)) return;
    f32x4 acc[2][2][4][2];
#pragma unroll
    for (int a = 0; a < 2; ++a)
#pragma unroll
        for (int b = 0; b < 2; ++b)
#pragma unroll
            for (int m = 0; m < 4; ++m)
#pragma unroll
                for (int n = 0; n < 2; ++n) acc[a][b][m][n] = (f32x4){0.f, 0.f, 0.f, 0.f};
    bf16x8 At[4][2], B0[2][2], B1[2][2];
    const char* cA = (const char*)g.A + (size_t)cur.pm * tstep; const char* cB = (const char*)g.Bt + (size_t)cur.pn * tstep;
    S.a_ready(cur);
    if constexpr (SP2) {
        PG8_STAGE(PG8_SB(0, 0), cB, voffB); PG8_STAGE(PG8_SB(0, 1), cB + hstep, voffB); PG8_STAGE(PG8_SA(0, 0), cA, voffA); PG8_STAGE(PG8_SA(0, 1), cA + hstep, voffA);
        if (wr == 1) PG8_BAR;
        PG8_WAIT_V(2); PG8_BAR;
        PG8_STAGE(PG8_SB(1, 0), cB + kstep, voffB); PG8_STAGE(PG8_SA(1, 0), cA + kstep, voffA); PG8_STAGE(PG8_SB(1, 1), cB + hstep + kstep, voffB);
        PG8_WAIT_V(6); PG8_BAR;
    } else {
        PG8_STAGE(PG8_SB(0, 0), cB, voffB); PG8_STAGE(PG8_SA(0, 0), cA, voffA); PG8_STAGE(PG8_SB(0, 1), cB + hstep, voffB); PG8_STAGE(PG8_SA(0, 1), cA + hstep, voffA);
        if (wr == 1) PG8_BAR;
        PG8_WAIT_V(4); PG8_BAR;
        PG8_STAGE(PG8_SB(1, 0), cB + kstep, voffB); PG8_STAGE(PG8_SA(1, 0), cA + kstep, voffA); PG8_STAGE(PG8_SB(1, 1), cB + hstep + kstep, voffB);
        PG8_WAIT_V(6); PG8_BAR;
    }
    for (;;) {
        const bool has_next = S.next(ui + 1, nxt);
        const char* nA = has_next ? (const char*)g.A + (size_t)nxt.pm * tstep : cA; const char* nB = has_next ? (const char*)g.Bt + (size_t)nxt.pn * tstep : cB;
        for (int t = 0; t < nt; t += 2) {
            const bool last = (t == nt - 2);
            const char* a1 = cA + (size_t)(t + 1) * kstep;
            const char* a2 = last ? nA : cA + (size_t)(t + 2) * kstep; const char* b2 = last ? nB : cB + (size_t)(t + 2) * kstep;
            const char* a3 = a2 + kstep; const char* b3 = b2 + kstep;
            if (last && has_next) S.a_ready(nxt);
            if constexpr (SP2) {
            PG8_LDB(B0, 0, 0); PG8_LDB(B1, 0, 1); PG8_SCHED; PG8_LDA(At, 0, 0); PG8_STAGE(PG8_SA(1, 1), a1 + hstep, voffA);
            PG8_WAIT_V(8); PG8_WAIT_L(0); PG8_BAR; PG8_MMA(0, 0, At, B0); PG8_MMA(0, 1, At, B1); PG8_BAR; PG8_SCHED;
            PG8_LDA(At, 0, 1); PG8_STAGE(PG8_SB(0, 0), b2, voffB); PG8_STAGE(PG8_SB(0, 1), b2 + hstep, voffB); PG8_STAGE(PG8_SA(0, 0), a2, voffA);
            PG8_WAIT_V(8); PG8_WAIT_L(0); PG8_BAR; PG8_MMA(1, 0, At, B0); PG8_MMA(1, 1, At, B1); PG8_BAR; PG8_SCHED;
            PG8_LDB(B0, 1, 0); PG8_LDB(B1, 1, 1); PG8_SCHED; PG8_LDA(At, 1, 0); PG8_STAGE(PG8_SA(0, 1), a2 + hstep, voffA);
            PG8_WAIT_V(8); PG8_WAIT_L(0); PG8_BAR; PG8_MMA(0, 0, At, B0); PG8_MMA(0, 1, At, B1); PG8_BAR; PG8_SCHED;
            PG8_LDA(At, 1, 1); PG8_STAGE(PG8_SB(1, 0), b3, voffB); PG8_STAGE(PG8_SB(1, 1), b3 + hstep, voffB); PG8_STAGE(PG8_SA(1, 0), a3, voffA);
            PG8_WAIT_V(8); PG8_WAIT_L(0); PG8_BAR; PG8_MMA(1, 0, At, B0); PG8_MMA(1, 1, At, B1); PG8_BAR; PG8_SCHED;
            } else {
            PG8_LDB(B0, 0, 0); PG8_SCHED; PG8_LDA(At, 0, 0); PG8_STAGE(PG8_SA(1, 1), a1 + hstep, voffA);
            PG8_WAIT_L(8); PG8_BAR; PG8_WAIT_L(0); PG8_MMA(0, 0, At, B0); PG8_BAR; PG8_SCHED;
            PG8_LDB(B1, 0, 1); PG8_STAGE(PG8_SB(0, 0), b2, voffB);
            PG8_BAR; PG8_WAIT_L(0); PG8_MMA(0, 1, At, B1); PG8_BAR;
            PG8_LDA(At, 0, 1); PG8_STAGE(PG8_SA(0, 0), a2, voffA);
            PG8_BAR; PG8_WAIT_L(0); PG8_MMA(1, 0, At, B0); PG8_BAR; PG8_SCHED;
            PG8_STAGE(PG8_SB(0, 1), b2 + hstep, voffB);
            PG8_WAIT_V(6); PG8_BAR; PG8_MMA(1, 1, At, B1); PG8_BAR;
            PG8_LDB(B0, 1, 0); PG8_SCHED; PG8_LDA(At, 1, 0); PG8_STAGE(PG8_SA(0, 1), a2 + hstep, voffA);
            PG8_WAIT_L(8); PG8_BAR; PG8_WAIT_L(0); PG8_MMA(0, 0, At, B0); PG8_BAR; PG8_SCHED;
            PG8_LDB(B1, 1, 1); PG8_STAGE(PG8_SB(1, 0), b3, voffB);
            PG8_BAR; PG8_WAIT_L(0); PG8_MMA(0, 1, At, B1); PG8_BAR;
            PG8_LDA(At, 1, 1); PG8_STAGE(PG8_SA(1, 0), a3, voffA);
            PG8_BAR; PG8_WAIT_L(0); PG8_MMA(1, 0, At, B0); PG8_BAR; PG8_SCHED;
            PG8_STAGE(PG8_SB(1, 1), b3 + hstep, voffB);
            PG8_WAIT_V(6); PG8_BAR; PG8_MMA(1, 1, At, B1); PG8_BAR;
            }
        }
        if constexpr (ALIGN_EPI) { if (wr == 0) PG8_BAR; }
        if constexpr (!Epi::AFTER_DRAIN) { E(acc, cur, wr, wc, fr, fq); S.done(cur); }
        if (!has_next) break;
#pragma unroll
        for (int a = 0; a < 2; ++a)
#pragma unroll
            for (int b = 0; b < 2; ++b)
#pragma unroll
                for (int m = 0; m < 4; ++m)
#pragma unroll
                    for (int n = 0; n < 2; ++n) acc[a][b][m][n] = (f32x4){0.f, 0.f, 0.f, 0.f};
        cur = nxt; cA = nA; cB = nB; ++ui;
        if constexpr (ALIGN_EPI) { if (wr == 1) PG8_BAR; }
    }
    PG8_WAIT_V(0);
    if constexpr (!ALIGN_EPI) { if (wr == 0) PG8_BAR; }
    PG8_BAR;
    if constexpr (Epi::AFTER_DRAIN) { E.fused(acc, cur, wr, wc, fr, fq, lds, wid, lane); S.done(cur); }
#undef PG8_SA
#undef PG8_SB
#undef PG8_STAGE
#undef PG8_LDA
#undef PG8_LDB
#undef PG8_MMA
#undef PG8_WAIT_V
#undef PG8_WAIT_L
#undef PG8_BAR
#undef PG8_SCHED
}
}

constexpr int NWAVES = 8;
constexpr int T = 16384, D = 2048, S = 2048, NBATCH = 8, CH = 64, NCH = 32, NH = 8, HD = 128, DEPTH = 4, NEXP = 16384;
constexpr int TOKC = pg8::TOKC, SWPR = 2048, TOKP = pg8::TOKP, SWPP = pg8::SWPP, QPP = pg8::QPP;
constexpr int TK_QA = 0, TK_KA = 1024, TK_QR = 2048, TK_KR = 3072, TK_GR = 4096;
constexpr int SW_VA = 0, SW_VR = 1024;
constexpr float EPS = 1e-6f, LOG2E = 1.4426950408889634f;
constexpr int PH_PER_LAYER = 8, N_PHASES = 1 + DEPTH * PH_PER_LAYER;

constexpr size_t MiB = 1u << 20;
constexpr size_t WS_CTL = 0, CTL_ZERO_BYTES = 1 * MiB;
constexpr size_t WS_ROPE_TOK = 1 * MiB, WS_ROPE_TR = 2 * MiB, WS_KEYS = 3 * MiB, WS_SSQ = 5 * MiB, WS_EXP = 9 * MiB, WS_GATE = 17 * MiB, WS_SS2 = 25 * MiB;
constexpr size_t WS_WTOK = 32 * MiB, WS_WSWP = 112 * MiB, WS_WOUT = 160 * MiB, WS_WQ = 192 * MiB;
constexpr size_t WS_HN = 224 * MiB, WS_TOK = 288 * MiB, WS_SWP = 456 * MiB, WS_ST = 556 * MiB, WS_MIX = 620 * MiB, WS_XR = 684 * MiB, WS_QP = 812 * MiB, WS_H2 = 884 * MiB;
constexpr size_t WS_UB = 948 * MiB, WS_VB = 1012 * MiB, WS_SU = 1076 * MiB, WS_SV = 1077 * MiB, WS_END = 1078 * MiB;
static_assert(WS_KEYS + (size_t)DEPTH * 16 * 128 * 128 * 2 <= WS_SSQ && WS_SSQ + (size_t)16 * 4 * T * 4 <= WS_EXP && WS_EXP + (size_t)T * 128 * 4 <= WS_GATE && WS_GATE + (size_t)T * 128 * 4 <= WS_SS2 && WS_SS2 + (size_t)32 * T * 4 <= WS_WTOK, "ws map 1");
static_assert(WS_WTOK + (size_t)DEPTH * TOKC * D * 2 <= WS_WSWP && WS_WSWP + (size_t)DEPTH * SWPR * D * 2 <= WS_WOUT && WS_WOUT + (size_t)DEPTH * D * D * 2 <= WS_WQ && WS_WQ + (size_t)DEPTH * D * D * 2 <= WS_HN, "ws map 2");
static_assert(WS_HN + (size_t)T * D * 2 <= WS_TOK && WS_TOK + (size_t)T * TOKP * 2 <= WS_SWP && WS_SWP + (size_t)SWPR * SWPP * 2 <= WS_ST && WS_ST + (size_t)64 * 32 * 128 * 128 * 2 <= WS_MIX, "ws map 3");
static_assert(WS_MIX + (size_t)T * D * 2 <= WS_XR && WS_XR + (size_t)T * D * 2 <= WS_QP && WS_QP + (size_t)T * QPP * 2 <= WS_H2 && WS_H2 + (size_t)T * D * 2 <= WS_UB, "ws map 4");
static_assert(WS_UB + (size_t)DEPTH * NEXP * D / 2 <= WS_VB && WS_VB + (size_t)DEPTH * NEXP * D / 2 <= WS_SU && WS_SU + (size_t)DEPTH * NEXP * 4 <= WS_SV && WS_SV + (size_t)DEPTH * NEXP * 4 <= WS_END, "ws map 5");
constexpr size_t WS_RSTD = WS_SV;
constexpr int CW_BAR = 4096;

constexpr int RING_OFF = 0, RING_BYTES = 131072;
constexpr int LDSCTL_OFF = RING_BYTES, MISC_OFF = LDSCTL_OFF + 320;
constexpr int LDS_BYTES = 147456;

#define GAS __attribute__((address_space(1)))
#define LAS __attribute__((address_space(3)))
typedef unsigned short bf16;
typedef short bf16x8 __attribute__((ext_vector_type(8)));
typedef float f32x4 __attribute__((ext_vector_type(4)));
typedef float f32x2 __attribute__((ext_vector_type(2)));
typedef unsigned u32x4 __attribute__((ext_vector_type(4)));
typedef unsigned u32x2 __attribute__((ext_vector_type(2)));
#define LDS_WAIT() asm volatile("s_waitcnt lgkmcnt(0)" ::: "memory")
__device__ __forceinline__ unsigned f2bf(float f) { unsigned u = __builtin_bit_cast(unsigned, f); return (u + 0x7fffu + ((u >> 16) & 1u)) >> 16; }
__device__ __forceinline__ unsigned pk2(float lo, float hi) { return f2bf(lo) | (f2bf(hi) << 16); }
__device__ __forceinline__ float bf_lo(unsigned w) { return __builtin_bit_cast(float, w << 16); }
__device__ __forceinline__ float bf_hi(unsigned w) { return __builtin_bit_cast(float, w & 0xffff0000u); }
__device__ __forceinline__ bf16x8 ld_b8(const bf16* p) { return *(const GAS bf16x8*)p; }
__device__ __forceinline__ u32x4 ld_u4(const void* p) { return *(const GAS u32x4*)p; }
__device__ __forceinline__ u32x2 ld_u2(const void* p) { return *(const GAS u32x2*)p; }
__device__ __forceinline__ f32x4 ld_f4(const float* p) { return *(const GAS f32x4*)p; }
__device__ __forceinline__ void st_u2(void* p, u32x2 v) { *(GAS u32x2*)p = v; }
__device__ __forceinline__ void st_u4(void* p, u32x4 v) { *(GAS u32x4*)p = v; }
__device__ __forceinline__ void st_f4(float* p, f32x4 v) { *(GAS f32x4*)p = v; }
__device__ __forceinline__ f32x4 mfma16(bf16x8 a, bf16x8 b, f32x4 c) { return __builtin_amdgcn_mfma_f32_16x16x32_bf16(a, b, c, 0, 0, 0); }
__device__ __forceinline__ bf16x8 pack8(f32x4 a, f32x4 b) {
    u32x4 w; w.x = pk2(a[0], a[1]); w.y = pk2(a[2], a[3]); w.z = pk2(b[0], b[1]); w.w = pk2(b[2], b[3]); return __builtin_bit_cast(bf16x8, w);
}
__device__ __forceinline__ float wave_sum(float v) {
#pragma unroll
    for (int o = 1; o < 64; o <<= 1) v += __shfl_xor(v, o);
    return v;
}
__device__ __forceinline__ float rq_sum(float v) { v += __shfl_xor(v, 16); v += __shfl_xor(v, 32); return v; }
__device__ __forceinline__ float rq_max(float v) { v = fmaxf(v, __shfl_xor(v, 16)); v = fmaxf(v, __shfl_xor(v, 32)); return v; }
__device__ __forceinline__ int lane_id() { return (int)__builtin_amdgcn_mbcnt_hi(~0u, __builtin_amdgcn_mbcnt_lo(~0u, 0u)); }
__device__ __forceinline__ float fexp2(float x) { return __builtin_amdgcn_exp2f(x); }
__device__ __forceinline__ float frsq(float x) { return __builtin_amdgcn_rsqf(x); }

#define XB_TMO      128
#define XB_XCNT(j)  (256  + 64 * (j))
#define XB_XSUB(j)  (1280 + 64 * (j))
#define XB_XGEN(j)  (2304 + 64 * (j))
#define XB_TOP      3328
#define XB_TOPGEN   3392
#define XCD_BAR_WORDS 3456
#define XB_SPIN_CAP (1u << 20)
__device__ __forceinline__ unsigned xb_ld(unsigned* p)              { return __hip_atomic_load(p, __ATOMIC_RELAXED, __HIP_MEMORY_SCOPE_AGENT); }
__device__ __forceinline__ unsigned xb_add(unsigned* p, unsigned v) { return __hip_atomic_fetch_add(p, v, __ATOMIC_RELAXED, __HIP_MEMORY_SCOPE_AGENT); }
__device__ __forceinline__ unsigned xb_xcc_id() { return (unsigned)__builtin_amdgcn_s_getreg((3 << 11) | 20) & 0xFu; }
#define XB_SPIN(cond, bar) do { unsigned _sp = 0; while (cond) { __builtin_amdgcn_s_sleep(1); \
    if ((++_sp & 255u) == 0u) { if (xb_ld(&(bar)[XB_TMO])) break; if (_sp > XB_SPIN_CAP) { atomicAdd(&(bar)[XB_TMO], 1u); break; } } } } while (0)
struct XcdBarrier { unsigned* bar; unsigned x; volatile LAS unsigned* st; };
__device__ __forceinline__ XcdBarrier xcd_barrier_post(unsigned* bar, volatile LAS unsigned* st) {
    XcdBarrier b; b.bar = bar; b.x = xb_xcc_id(); b.st = st;
    if (threadIdx.x == 0) (void)xb_add(&bar[XB_XCNT(b.x)], 1u);
    return b;
}
__device__ __forceinline__ void xcd_barrier_complete(unsigned* bar, unsigned x, unsigned& nloc, unsigned& nx) {
    const unsigned G = gridDim.x * gridDim.y * gridDim.z;
    unsigned sum, cnt, mine, sp = 0u;
    for (;;) {
        sum = 0u; cnt = 0u; mine = 0u;
#pragma unroll
        for (unsigned j = 0; j < 16; ++j) { const unsigned c = xb_ld(&bar[XB_XCNT(j)]); sum += c; cnt += (c > 0u) ? 1u : 0u; mine = (j == x) ? c : mine; }
        if (sum == G) break;
        __builtin_amdgcn_s_sleep(1);
        if ((++sp & 255u) == 0u) { if (xb_ld(&bar[XB_TMO])) break; if (sp > XB_SPIN_CAP) { atomicAdd(&bar[XB_TMO], 1u); break; } }
    }
    nloc = mine > 0u ? mine : 1u; nx = cnt > 0u ? cnt : 1u;
}
__device__ __forceinline__ void xcd_barrier(const XcdBarrier& b, int wave) {
    asm volatile("s_waitcnt vmcnt(0)" ::: "memory");
    __syncthreads();
    if (wave == 0 && lane_id() == 0) {
        unsigned* bar = b.bar;
        __builtin_amdgcn_s_waitcnt(0);
        unsigned nloc = b.st[0], nx = b.st[1];
        if (nloc == 0u) { xcd_barrier_complete(bar, b.x, nloc, nx); b.st[0] = nloc; b.st[1] = nx; }
        const unsigned old = xb_add(&bar[XB_XSUB(b.x)], 1u);
        const unsigned gen = old / nloc;
        if (old + 1u == (gen + 1u) * nloc) {
            __builtin_amdgcn_fence(__ATOMIC_RELEASE, "agent");
            asm volatile("s_waitcnt vmcnt(0)" ::: "memory");
            const unsigned og = xb_add(&bar[XB_TOP], 1u);
            const unsigned tg = og / nx;
            if (og + 1u == (tg + 1u) * nx) xb_add(&bar[XB_TOPGEN], 1u);
            else XB_SPIN(xb_ld(&bar[XB_TOPGEN]) == tg, bar);
            __builtin_amdgcn_fence(__ATOMIC_ACQUIRE, "agent");
            xb_add(&bar[XB_XGEN(b.x)], 1u);
            asm volatile("s_waitcnt vmcnt(0)" ::: "memory");
        } else {
            XB_SPIN(xb_ld(&bar[XB_XGEN(b.x)]) == gen, bar);
            __builtin_amdgcn_fence(__ATOMIC_ACQUIRE, "agent");
            asm volatile("s_waitcnt vmcnt(0)" ::: "memory");
        }
    }
    __syncthreads();
}

struct Frame {
    LAS unsigned char* lds;
    int wave, G, gw, ngw;
    const float *x, *norm1_g, *w_in, *qa_g, *ka_g, *rel_bias, *attn_g, *ret_g, *w_out, *norm2_g, *peer_wq, *peer_keys, *peer_u, *peer_v;
    float* out; unsigned char* ws;
};

template <class DstFn>
__device__ __forceinline__ void transpose_item(const float* W, int K, int N, LAS float* scr, int item, int lane, DstFn dst, const float* kscale = nullptr) {
    const int nblk = N / 32, kb = item / nblk, nb = item % nblk, k0 = 64 * kb, n0 = 32 * nb;
#pragma unroll
    for (int i = 0; i < 32; ++i) { const int kk = 2 * i + (lane >> 5); float wv = *(const GAS float*)(W + (size_t)(k0 + kk) * N + n0 + (lane & 31));
        scr[kk * 33 + (lane & 31)] = wv; }
    LDS_WAIT(); asm volatile("" ::: "memory");
    const int c = lane & 7;
    f32x4 ka = (f32x4){1.f, 1.f, 1.f, 1.f}, kb4 = ka;
    if (kscale) { ka = ld_f4(kscale + k0 + 8 * c); kb4 = ld_f4(kscale + k0 + 8 * c + 4); }
#pragma unroll
    for (int j = 0; j < 4; ++j) { const int n = (lane >> 3) + 8 * j; const LAS float* s = scr + (8 * c) * 33 + n;
        u32x4 o; o.x = pk2(s[0 * 33] * ka[0], s[1 * 33] * ka[1]); o.y = pk2(s[2 * 33] * ka[2], s[3 * 33] * ka[3]); o.z = pk2(s[4 * 33] * kb4[0], s[5 * 33] * kb4[1]); o.w = pk2(s[6 * 33] * kb4[2], s[7 * 33] * kb4[3]);
        dst(n0 + n, k0 + 8 * c, o); }
    LDS_WAIT(); asm volatile("" ::: "memory");
}
__device__ __forceinline__ void rms_row_to_bf16(const float* xrow, const float* g, bf16* orow, int lane) {
    asm volatile("" : "+v"(lane));
    f32x4 v[8]; float s = 0.f;
#pragma unroll
    for (int j = 0; j < 8; ++j) { v[j] = ld_f4(xrow + (j * 64 + lane) * 4); s += (v[j][0] * v[j][0] + v[j][1] * v[j][1]) + (v[j][2] * v[j][2] + v[j][3] * v[j][3]); }
    const float rstd = frsq(wave_sum(s) * (1.f / D) + EPS);
#pragma unroll
    for (int j = 0; j < 8; ++j) { const f32x4 gg = ld_f4(g + (j * 64 + lane) * 4);
        u32x2 o; o.x = pk2(v[j][0] * rstd * gg[0], v[j][1] * rstd * gg[1]); o.y = pk2(v[j][2] * rstd * gg[2], v[j][3] * rstd * gg[3]);
        st_u2(orow + (j * 64 + lane) * 4, o); }
}
__device__ __forceinline__ void row_to_fp4(const float* src, unsigned char* dst, size_t slice_stride, unsigned short* scale_out, int lane) {
    f32x4 v[8]; float mx = 0.f;
#pragma unroll
    for (int q = 0; q < 8; ++q) { v[q] = ld_f4(src + lane * 32 + q * 4);
        mx = fmaxf(mx, fmaxf(fmaxf(__builtin_fabsf(v[q][0]), __builtin_fabsf(v[q][1])), fmaxf(__builtin_fabsf(v[q][2]), __builtin_fabsf(v[q][3])))); }
#pragma unroll
    for (int o = 1; o < 64; o <<= 1) mx = fmaxf(mx, __shfl_xor(mx, o));
    const float sc = mx > 0.f ? bf_lo(f2bf(mx * (1.0f / 6.0f)) ) : 1.0f, inv = 1.0f / sc;
    u32x4 o;
#pragma unroll
    for (int d = 0; d < 4; ++d) { const f32x4 a = v[2 * d] * inv, b = v[2 * d + 1] * inv;
        unsigned w = 0u;
        w = __builtin_amdgcn_cvt_scalef32_pk_fp4_f32(w, a[0], a[1], 1.0f, 0); w = __builtin_amdgcn_cvt_scalef32_pk_fp4_f32(w, a[2], a[3], 1.0f, 1);
        w = __builtin_amdgcn_cvt_scalef32_pk_fp4_f32(w, b[0], b[1], 1.0f, 2); w = __builtin_amdgcn_cvt_scalef32_pk_fp4_f32(w, b[2], b[3], 1.0f, 3);
        o[d] = w; }
    st_u4(dst + (size_t)(lane >> 3) * slice_stride + (lane & 7) * 16, o);
    if (lane == 0) *(GAS unsigned short*)scale_out = (unsigned short)f2bf(sc);
}
__device__ __forceinline__ void p0_prologue(const Frame& F) {
    LAS float* scr = (LAS float*)(F.lds + RING_OFF + F.wave * 16384);
    int lane = lane_id(); asm volatile("" : "+v"(lane));
    bf16* Wtok = (bf16*)(F.ws + WS_WTOK); bf16* Wswp = (bf16*)(F.ws + WS_WSWP); bf16* Wout = (bf16*)(F.ws + WS_WOUT); bf16* Wq = (bf16*)(F.ws + WS_WQ);
    constexpr int IN_COLS = 7168;
    constexpr int I_IN = (D / 64) * (IN_COLS / 32), I_SQ = (D / 64) * (D / 32), I_L = I_IN + 2 * I_SQ, NITEMS = DEPTH * I_L;
    for (int it = F.gw; it < NITEMS; it += F.ngw) {
        const int l = it / I_L; int r = it % I_L;
        if (r < I_IN) {
            bf16* wt = Wtok + (size_t)l * TOKC * D; bf16* wsw = Wswp + (size_t)l * SWPR * D;
            transpose_item(F.w_in + (size_t)l * D * IN_COLS, D, IN_COLS, scr, r, lane, [=](int n, int k, u32x4 o) {
                const int seg = n >> 10, nn = n & 1023, dd = n & 127, dp = (n & 896) + 2 * (dd & 63) + (dd >> 6);
                if (seg == 0) st_u4(wt + (size_t)(TK_QA + nn) * D + k, o);
                else if (seg == 1) st_u4(wt + (size_t)(TK_KA + nn) * D + k, o);
                else if (seg == 2) st_u4(wsw + (size_t)(SW_VA + nn) * D + k, o);
                else if (seg == 3) st_u4(wt + (size_t)(TK_QR + dp) * D + k, o);
                else if (seg == 4) st_u4(wt + (size_t)(TK_KR + dp) * D + k, o);
                else if (seg == 5) st_u4(wsw + (size_t)(SW_VR + nn) * D + k, o);
                else st_u4(wt + (size_t)(TK_GR + nn) * D + k, o);
            }, F.norm1_g + l * D);
            continue;
        }
        r -= I_IN;
        if (r < I_SQ) { bf16* wo = Wout + (size_t)l * D * D;
            transpose_item(F.w_out + (size_t)l * D * D, D, D, scr, r, lane, [=](int n, int k, u32x4 o) { st_u4(wo + (size_t)n * D + k, o); }); continue; }
        r -= I_SQ;
        { bf16* wq = Wq + (size_t)l * D * D;
            transpose_item(F.peer_wq + (size_t)l * D * D, D, D, scr, r, lane, [=](int n, int k, u32x4 o) { st_u4(wq + (size_t)n * D + k, o); }, F.norm2_g + l * D); }
    }
    {
        bf16* XR0 = (bf16*)(F.ws + WS_XR); float* RSTD = (float*)(F.ws + WS_RSTD);
        for (int m = F.gw; m < T; m += F.ngw) {
            const float* xrow = F.x + (size_t)m * D;
            f32x4 v[8]; float s = 0.f;
#pragma unroll
            for (int j = 0; j < 8; ++j) { v[j] = ld_f4(xrow + (j * 64 + lane) * 4); s += (v[j][0] * v[j][0] + v[j][1] * v[j][1]) + (v[j][2] * v[j][2] + v[j][3] * v[j][3]); }
            const float rstd = frsq(wave_sum(s) * (1.f / D) + EPS);
#pragma unroll
            for (int j = 0; j < 8; ++j) { u32x2 o; o.x = pk2(v[j][0], v[j][1]); o.y = pk2(v[j][2], v[j][3]); st_u2(XR0 + (size_t)m * D + (j * 64 + lane) * 4, o); }
            if (lane == 0) *(GAS float*)(RSTD + m) = rstd;
        }
    }
    {
        unsigned char* UB = (unsigned char*)(F.ws + WS_UB); unsigned char* VB = (unsigned char*)(F.ws + WS_VB);
        unsigned short* SUV = (unsigned short*)(F.ws + WS_SU);
        const int nrows = DEPTH * NEXP;
        for (int r = F.gw; r < 2 * nrows; r += F.ngw) {
            const bool isv = r >= nrows; const int rr = isv ? r - nrows : r;
            row_to_fp4((isv ? F.peer_v : F.peer_u) + (size_t)rr * D, (isv ? VB : UB) + (size_t)(rr / NEXP) * NEXP * (D / 2) + (size_t)(rr % NEXP) * 128, (size_t)NEXP * 128, SUV + 2 * (size_t)rr + (isv ? 1 : 0), lane);
        }
        const size_t nK = (size_t)DEPTH * 16 * 128 * 128 / 8;
        bf16* KB = (bf16*)(F.ws + WS_KEYS);
        const size_t stride = (size_t)F.ngw * 64, start = (size_t)F.gw * 64 + lane;
        for (size_t i = start; i < nK; i += stride) {
            const f32x4 a = ld_f4(F.peer_keys + i * 8), b = ld_f4(F.peer_keys + i * 8 + 4);
            u32x4 o; o.x = pk2(a[0], a[1]); o.y = pk2(a[2], a[3]); o.z = pk2(b[0], b[1]); o.w = pk2(b[2], b[3]); st_u4(KB + i * 8, o);
        }
    }
    {
        f32x2* ct = (f32x2*)(F.ws + WS_ROPE_TOK);
        for (int e = F.gw * 64 + lane; e < S * 64; e += F.ngw * 64) {
            const int pos = e >> 6, i = e & 63;
            const float invf = exp2f(-(float)i * 0.20762050593046014f);
            const double rev = (double)pos * (double)invf * 0.15915494309189535;
            const float fr = (float)(rev - __builtin_floor(rev));
            const f32x2 v = {__builtin_amdgcn_cosf(fr), __builtin_amdgcn_sinf(fr)};
            ct[(size_t)pos * 64 + i] = v;
        }
    }
}

constexpr int A_KP = 272, A_VP = 144;
constexpr int A_KBUF = 0, A_VBUF = A_KBUF + 2 * 64 * A_KP, A_RK = A_VBUF + 2 * 128 * A_VP, A_BIAS = A_RK + 2 * 64 * 4, A_END = A_BIAS + NH * 257 * 4;
static_assert(A_END <= RING_BYTES, "attention LDS map");
__device__ __forceinline__ void attn_wg_task(const Frame& F, int l, int task) {
    int tid = F.wave * 64 + lane_id(); asm volatile("" : "+v"(tid));
    const int lane = tid & 63, c = lane & 15, rq = lane >> 4, wave = F.wave;
    const int cq = task & 7, h = (task >> 3) & 7, b = task >> 6;
    const bf16* TOK = (const bf16*)(F.ws + WS_TOK); const bf16* SWP = (const bf16*)(F.ws + WS_SWP); const float* SSQ = (const float*)(F.ws + WS_SSQ);
    bf16* MIX = (bf16*)(F.ws + WS_MIX);
    LAS unsigned char* lds = F.lds + RING_OFF;
    const LAS float* bh = (const LAS float*)(lds + A_BIAS) + h * 257;
    const int wch = wave >> 1;
    const int qi0 = (wave & 1) * 32 + c;
    const int tq0 = b * S + (4 * cq + wch) * CH + qi0;
    bf16x8 Qf[2][4];
#pragma unroll
    for (int qb = 0; qb < 2; ++qb) {
        const int tq = tq0 + qb * 16;
        float ssq = 0.f;
#pragma unroll
        for (int w = 0; w < 4; ++w) ssq += *(const GAS float*)(SSQ + (size_t)((0 * 8 + h) * 4 + w) * T + tq);
        const float rs = frsq(ssq * (1.f / HD) + EPS) * (pg8::KSCALE * LOG2E);
#pragma unroll
        for (int ks = 0; ks < 4; ++ks) {
            const float* gp = F.qa_g + l * HD + ks * 32 + rq * 8; const float* kp = F.ka_g + l * HD + ks * 32 + rq * 8;
            const f32x4 a0 = ld_f4(gp), a1 = ld_f4(gp + 4), b0 = ld_f4(kp), b1 = ld_f4(kp + 4);
            const u32x4 raw = ld_u4(TOK + (size_t)tq * TOKP + TK_QA + h * HD + ks * 32 + rq * 8);
            u32x4 o;
            o.x = pk2(bf_lo(raw.x) * rs * (a0[0] * b0[0]), bf_hi(raw.x) * rs * (a0[1] * b0[1])); o.y = pk2(bf_lo(raw.y) * rs * (a0[2] * b0[2]), bf_hi(raw.y) * rs * (a0[3] * b0[3]));
            o.z = pk2(bf_lo(raw.z) * rs * (a1[0] * b1[0]), bf_hi(raw.z) * rs * (a1[1] * b1[1])); o.w = pk2(bf_lo(raw.w) * rs * (a1[2] * b1[2]), bf_hi(raw.w) * rs * (a1[3] * b1[3]));
            Qf[qb][ks] = __builtin_bit_cast(bf16x8, o);
        }
    }
    float m_run[2] = {-1e30f, -1e30f}, l_run[2] = {0.f, 0.f};
    f32x4 O[2][8];
#pragma unroll
    for (int qb = 0; qb < 2; ++qb)
#pragma unroll
        for (int db = 0; db < 8; ++db) O[qb][db] = (f32x4){0.f, 0.f, 0.f, 0.f};
    const int p0 = tid, p1 = tid + 512;
    const int kr0 = p0 >> 4, kr1 = p1 >> 4;
    const int kl0 = (kr0 & 32) + ((kr0 >> 2) & 1) * 16 + ((kr0 >> 3) & 3) * 4 + (kr0 & 3), kl1 = (kr1 & 32) + ((kr1 >> 2) & 1) * 16 + ((kr1 >> 3) & 3) * 4 + (kr1 & 3);
    const bf16* gk0 = TOK + (size_t)(b * S + kr0) * TOKP + TK_KA + h * HD + (p0 & 15) * 8; const bf16* gk1 = TOK + (size_t)(b * S + kr1) * TOKP + TK_KA + h * HD + (p1 & 15) * 8;
    const bf16* gv0 = SWP + (size_t)(SW_VA + h * HD + (p0 >> 3)) * SWPP + b * S + (p0 & 7) * 8; const bf16* gv1 = SWP + (size_t)(SW_VA + h * HD + (p1 >> 3)) * SWPP + b * S + (p1 & 7) * 8;
    const int lk0 = A_KBUF + kl0 * A_KP + (p0 & 15) * 16, lk1 = A_KBUF + kl1 * A_KP + (p1 & 15) * 16;
    const int lv0 = A_VBUF + (p0 >> 3) * A_VP + (p0 & 7) * 16, lv1 = A_VBUF + (p1 >> 3) * A_VP + (p1 & 7) * 16;
    const float* gss = SSQ + (size_t)((8 + h) * 4) * T + b * S + (tid & 63);
    u32x4 r0, r1, r2, r3; float rkv = 0.f;
    const int kc0 = 4 * cq - 8, j0 = kc0 < 0 ? -kc0 : 0;
#define A_GLOAD(j) do { const int ko = (kc0 + (j)) * CH; r0 = ld_u4(gk0 + (size_t)ko * TOKP); r1 = ld_u4(gk1 + (size_t)ko * TOKP); r2 = ld_u4(gv0 + ko); r3 = ld_u4(gv1 + ko); \
        if (tid < 64) { float s_ = 0.f; _Pragma("unroll") for (int w = 0; w < 4; ++w) s_ += *(const GAS float*)(gss + (size_t)w * T + ko); rkv = frsq(s_ * (1.f / HD) + EPS); } } while (0)
#define A_LSTORE(bf) do { *(LAS u32x4*)(lds + lk0 + (bf) * 64 * A_KP) = r0; *(LAS u32x4*)(lds + lk1 + (bf) * 64 * A_KP) = r1; *(LAS u32x4*)(lds + lv0 + (bf) * 128 * A_VP) = r2; *(LAS u32x4*)(lds + lv1 + (bf) * 128 * A_VP) = r3; \
        if (tid < 64) ((LAS float*)(lds + A_RK))[(bf) * 64 + tid] = rkv; } while (0)
    __syncthreads();
    A_GLOAD(j0); A_LSTORE(j0 & 1);
    __syncthreads();
    for (int j = j0; j < 12; ++j) {
        if (j < 11) A_GLOAD(j + 1);
        const int tjr = j - wch;
        if (tjr >= 0 && tjr <= 8) {
            const LAS unsigned char* kb = lds + A_KBUF + (j & 1) * 64 * A_KP + c * A_KP + rq * 16;
            const LAS unsigned char* vb = lds + A_VBUF + (j & 1) * 128 * A_VP + c * A_VP + rq * 16;
            const LAS float* rkb = (const LAS float*)(lds + A_RK) + (j & 1) * 64;
            f32x4 sa[2][2][2];
#pragma unroll
            for (int g = 0; g < 2; ++g)
#pragma unroll
                for (int ab = 0; ab < 2; ++ab) { f32x4 a0 = (f32x4){0.f, 0.f, 0.f, 0.f}, a1 = (f32x4){0.f, 0.f, 0.f, 0.f};
#pragma unroll
                    for (int ks = 0; ks < 4; ++ks) { const bf16x8 kf = *(const LAS bf16x8*)(kb + (32 * g + 16 * ab) * A_KP + ks * 64); a0 = mfma16(kf, Qf[0][ks], a0); a1 = mfma16(kf, Qf[1][ks], a1); }
                    sa[0][g][ab] = a0; sa[1][g][ab] = a1; }
            const int relbase = 64 * (8 - tjr);
            float mx[2] = {-1e30f, -1e30f};
            if (tjr <= 5) {
                const float bc = bh[256];
#pragma unroll
                for (int g = 0; g < 2; ++g)
#pragma unroll
                    for (int ab = 0; ab < 2; ++ab) {
                        const f32x4 rk = *(const LAS f32x4*)(rkb + 32 * g + 8 * rq + 4 * ab);
#pragma unroll
                        for (int qb = 0; qb < 2; ++qb)
#pragma unroll
                            for (int e = 0; e < 4; ++e) { const float sv = sa[qb][g][ab][e] * rk[e] + bc; sa[qb][g][ab][e] = sv; mx[qb] = fmaxf(mx[qb], sv); }
                    }
            } else {
#pragma unroll
                for (int g = 0; g < 2; ++g)
#pragma unroll
                    for (int ab = 0; ab < 2; ++ab) {
                        const int kk0 = 32 * g + 8 * rq + 4 * ab;
                        const f32x4 rk = *(const LAS f32x4*)(rkb + kk0);
#pragma unroll
                        for (int qb = 0; qb < 2; ++qb)
#pragma unroll
                            for (int e = 0; e < 4; ++e) {
                                int rel = qi0 + qb * 16 - (kk0 + e) + relbase; rel = rel > 128 ? 128 : (rel < -128 ? -128 : rel);
                                const float sv = sa[qb][g][ab][e] * rk[e] + bh[rel + 128];
                                sa[qb][g][ab][e] = sv; mx[qb] = fmaxf(mx[qb], sv);
                            }
                    }
            }
            bf16x8 Pf[2][2];
            bool moved = false;
            float alpha[2];
#pragma unroll
            for (int qb = 0; qb < 2; ++qb) {
                const float mxr = rq_max(mx[qb]);
                const float mn = fmaxf(m_run[qb], mxr); alpha[qb] = fexp2(m_run[qb] - mn);
                moved = moved || (mn > m_run[qb]);
                float ps = 0.f;
#pragma unroll
                for (int g = 0; g < 2; ++g) {
#pragma unroll
                    for (int ab = 0; ab < 2; ++ab)
#pragma unroll
                        for (int e = 0; e < 4; ++e) { const float p = fexp2(sa[qb][g][ab][e] - mn); sa[qb][g][ab][e] = p; ps += p; }
                    Pf[qb][g] = pack8(sa[qb][g][0], sa[qb][g][1]);
                }
                l_run[qb] = l_run[qb] * alpha[qb] + ps; m_run[qb] = mn;
            }
            if (__any(moved)) {
#pragma unroll
                for (int qb = 0; qb < 2; ++qb)
#pragma unroll
                    for (int db = 0; db < 8; ++db) O[qb][db] *= alpha[qb];
            }
#pragma unroll
            for (int g = 0; g < 2; ++g)
#pragma unroll
                for (int db = 0; db < 8; ++db) { const bf16x8 vf = *(const LAS bf16x8*)(vb + db * 16 * A_VP + g * 64); O[0][db] = mfma16(vf, Pf[0][g], O[0][db]); O[1][db] = mfma16(vf, Pf[1][g], O[1][db]); }
        }
        if (j < 11) A_LSTORE((j + 1) & 1);
        __syncthreads();
    }
#undef A_GLOAD
#undef A_LSTORE
#pragma unroll
    for (int qb = 0; qb < 2; ++qb) {
        const int tq = tq0 + qb * 16;
        const float inv = 1.0f / rq_sum(l_run[qb]);
        float ss = 0.f;
#pragma unroll
        for (int db = 0; db < 8; ++db) { O[qb][db] *= inv; ss += (O[qb][db][0] * O[qb][db][0] + O[qb][db][1] * O[qb][db][1]) + (O[qb][db][2] * O[qb][db][2] + O[qb][db][3] * O[qb][db][3]); }
        const float rstd = frsq(rq_sum(ss) * (1.f / HD) + EPS);
#pragma unroll
        for (int db = 0; db < 8; ++db) {
            const int d0 = h * HD + db * 16 + rq * 4;
            const f32x4 g4 = ld_f4(F.attn_g + l * 1024 + d0);
            u32x2 o; o.x = pk2(O[qb][db][0] * rstd * g4[0], O[qb][db][1] * rstd * g4[1]); o.y = pk2(O[qb][db][2] * rstd * g4[2], O[qb][db][3] * rstd * g4[3]);
            st_u2(MIX + (size_t)tq * D + d0, o);
        }
    }
}

constexpr int SC_PITCH = 36, SC_WAVE_BYTES = 64 * SC_PITCH, SC_OFF = A_END;
static_assert(SC_OFF % 4 == 0 && SC_OFF + NWAVES * SC_WAVE_BYTES <= RING_BYTES, "scan LDS map");
struct ScanOps { u32x4 kp[2]; bf16x8 va[4][2]; };
__device__ __forceinline__ void scan_load(ScanOps& o, const bf16* kg, const bf16* vrow, int n) {
#pragma unroll
    for (int i = 0; i < 2; ++i) o.kp[i] = ld_u4(kg + (size_t)(n * CH + i * 32) * TOKP);
#pragma unroll
    for (int eb = 0; eb < 4; ++eb)
#pragma unroll
        for (int ks = 0; ks < 2; ++ks) o.va[eb][ks] = ld_b8(vrow + (size_t)eb * 16 * SWPP + n * CH + ks * 32);
}
__device__ __forceinline__ void scan_step(f32x4 (&st)[4], const ScanOps& o, const float (&dec)[16], LAS unsigned char* kw, const LAS unsigned char* kr, bf16* sp, int n, float cd) {
#pragma unroll
    for (int eb = 0; eb < 4; ++eb) { u32x2 w; w.x = pk2(st[eb][0], st[eb][1]); w.y = pk2(st[eb][2], st[eb][3]); st_u2(sp + (size_t)n * HD * HD + eb * 16 * HD, w); }
#pragma unroll
    for (int i = 0; i < 2; ++i)
#pragma unroll
        for (int d = 0; d < 4; ++d) *(LAS unsigned*)(kw + i * 32 * SC_PITCH + d * 4) = o.kp[i][d];
    LDS_WAIT(); asm volatile("" ::: "memory");
    bf16x8 ka[2];
#pragma unroll
    for (int ks = 0; ks < 2; ++ks) { u32x4 w;
#pragma unroll
        for (int j = 0; j < 4; ++j) { const unsigned e0 = *(const LAS unsigned short*)(kr + (ks * 32 + 2 * j) * SC_PITCH), e1 = *(const LAS unsigned short*)(kr + (ks * 32 + 2 * j + 1) * SC_PITCH);
            w[j] = pk2(bf_lo(e0) * dec[ks * 8 + 2 * j], bf_lo(e1) * dec[ks * 8 + 2 * j + 1]); }
        ka[ks] = __builtin_bit_cast(bf16x8, w); }
    LDS_WAIT(); asm volatile("" ::: "memory");
#pragma unroll
    for (int eb = 0; eb < 4; ++eb) { st[eb] *= cd;
#pragma unroll
        for (int ks = 0; ks < 2; ++ks) st[eb] = mfma16(ka[ks], o.va[eb][ks], st[eb]); }
}
__device__ __forceinline__ void scan_task(const Frame& F, int task) {
    int lane = lane_id(); asm volatile("" : "+v"(lane));
    const int c = lane & 15, rq = lane >> 4;
    const int eh = task & 1, db = (task >> 1) & 7, h = (task >> 4) & 7, b = task >> 7, bhh = b * NH + h;
    const bf16* TOK = (const bf16*)(F.ws + WS_TOK); const bf16* SWP = (const bf16*)(F.ws + WS_SWP); bf16* ST = (bf16*)(F.ws + WS_ST);
    const bf16* kg = TOK + (size_t)(b * S + (lane >> 1)) * TOKP + TK_KR + h * HD + db * 16 + (lane & 1) * 8;
    const bf16* vrow = SWP + (size_t)(SW_VR + h * HD + eh * 64 + c) * SWPP + b * S + rq * 8;
    bf16* sp = ST + ((size_t)bhh * NCH * HD + eh * 64 + c) * HD + db * 16 + rq * 4;
    LAS unsigned char* kt = F.lds + RING_OFF + SC_OFF + F.wave * SC_WAVE_BYTES;
    LAS unsigned char* kw = kt + (lane >> 1) * SC_PITCH + (lane & 1) * 16;
    const LAS unsigned char* kr = kt + (rq * 8) * SC_PITCH + c * 2;
    f32x4 st[4];
#pragma unroll
    for (int eb = 0; eb < 4; ++eb) st[eb] = (f32x4){0.f, 0.f, 0.f, 0.f};
    const float lg = pg8::lg2gamma(h), cd = fexp2(64.f * lg);
    float dec[16];
#pragma unroll
    for (int i = 0; i < 16; ++i) dec[i] = fexp2((float)(63 - ((i >> 3) * 32 + rq * 8 + (i & 7))) * lg);
    ScanOps o0, o1, o2;
    scan_load(o0, kg, vrow, 0); scan_load(o1, kg, vrow, 1);
    for (int n = 0; n < NCH - 1; n += 3) {
        if (n + 2 < NCH - 1) scan_load(o2, kg, vrow, n + 2);
        scan_step(st, o0, dec, kw, kr, sp, n, cd);
        if (n + 1 < NCH - 1) { if (n + 3 < NCH - 1) scan_load(o0, kg, vrow, n + 3); scan_step(st, o1, dec, kw, kr, sp, n + 1, cd); }
        if (n + 2 < NCH - 1) { if (n + 4 < NCH - 1) scan_load(o1, kg, vrow, n + 4); scan_step(st, o2, dec, kw, kr, sp, n + 2, cd); }
    }
#pragma unroll
    for (int eb = 0; eb < 4; ++eb) { u32x2 w; w.x = pk2(st[eb][0], st[eb][1]); w.y = pk2(st[eb][2], st[eb][3]); st_u2(sp + (size_t)(NCH - 1) * HD * HD + eb * 16 * HD, w); }
}

__device__ __forceinline__ void ret_task(const Frame& F, int l, int task) {
    int lane = lane_id(); asm volatile("" : "+v"(lane));
    const int c = lane & 15, rq = lane >> 4;
    const int qb2 = task & 1, n = (task >> 1) & 31, h = (task >> 6) & 7, b = task >> 9, bhh = b * NH + h;
    const bf16* TOK = (const bf16*)(F.ws + WS_TOK); const bf16* SWP = (const bf16*)(F.ws + WS_SWP); const bf16* ST = (const bf16*)(F.ws + WS_ST);
    bf16* MIX = (bf16*)(F.ws + WS_MIX);
    const int tc0 = b * S + n * CH, tq0 = tc0 + qb2 * 32;
    const float lg = pg8::lg2gamma(h);
    bf16x8 Qf[2][4];
#pragma unroll
    for (int qb = 0; qb < 2; ++qb)
#pragma unroll
        for (int ks = 0; ks < 4; ++ks) Qf[qb][ks] = ld_b8(TOK + (size_t)(tq0 + qb * 16 + c) * TOKP + TK_QR + h * HD + ks * 32 + rq * 8);
    f32x4 acc[2][8];
#pragma unroll
    for (int qb = 0; qb < 2; ++qb)
#pragma unroll
        for (int eb = 0; eb < 8; ++eb) acc[qb][eb] = (f32x4){0.f, 0.f, 0.f, 0.f};
    const bf16* sp = ST + (((size_t)bhh * NCH + n) * HD + c) * HD + rq * 8;
#pragma unroll
    for (int eb = 0; eb < 8; ++eb)
#pragma unroll
        for (int ks = 0; ks < 4; ++ks) { const bf16x8 sf = ld_b8(sp + eb * 16 * HD + ks * 32);
#pragma unroll
            for (int qb = 0; qb < 2; ++qb) acc[qb][eb] = mfma16(sf, Qf[qb][ks], acc[qb][eb]); }
#pragma unroll
    for (int qb = 0; qb < 2; ++qb) { const float f = fexp2((float)(qb2 * 32 + qb * 16 + c + 1) * lg);
#pragma unroll
        for (int eb = 0; eb < 8; ++eb) acc[qb][eb] *= f; }
    for (int g = 0; g <= qb2; ++g) {
        f32x4 sa[2][2];
#pragma unroll
        for (int qb = 0; qb < 2; ++qb)
#pragma unroll
            for (int ab = 0; ab < 2; ++ab) sa[qb][ab] = (f32x4){0.f, 0.f, 0.f, 0.f};
#pragma unroll
        for (int ab = 0; ab < 2; ++ab) {
            const int key = 32 * g + (c >> 2) * 8 + 4 * ab + (c & 3);
            const bf16* kp = TOK + (size_t)(tc0 + key) * TOKP + TK_KR + h * HD + rq * 8;
#pragma unroll
            for (int ks = 0; ks < 4; ++ks) { const bf16x8 kf = ld_b8(kp + ks * 32);
#pragma unroll
                for (int qb = 0; qb < 2; ++qb) sa[qb][ab] = mfma16(kf, Qf[qb][ks], sa[qb][ab]); }
        }
        bf16x8 Pf[2];
#pragma unroll
        for (int qb = 0; qb < 2; ++qb) {
            const int i = qb2 * 32 + qb * 16 + c;
#pragma unroll
            for (int ab = 0; ab < 2; ++ab)
#pragma unroll
                for (int e = 0; e < 4; ++e) { const int diff = i - (32 * g + 8 * rq + 4 * ab + e);
                    sa[qb][ab][e] = diff >= 0 ? sa[qb][ab][e] * fexp2((float)diff * lg) : 0.f; }
            Pf[qb] = pack8(sa[qb][0], sa[qb][1]);
        }
#pragma unroll
        for (int eb = 0; eb < 8; ++eb) { const bf16x8 vf = ld_b8(SWP + (size_t)(SW_VR + h * HD + eb * 16 + c) * SWPP + tc0 + 32 * g + 8 * rq);
#pragma unroll
            for (int qb = 0; qb < 2; ++qb) acc[qb][eb] = mfma16(vf, Pf[qb], acc[qb][eb]); }
    }
#pragma unroll
    for (int qb = 0; qb < 2; ++qb) {
        const int t = tq0 + qb * 16 + c;
        float ss = 0.f;
#pragma unroll
        for (int eb = 0; eb < 8; ++eb) ss += (acc[qb][eb][0] * acc[qb][eb][0] + acc[qb][eb][1] * acc[qb][eb][1]) + (acc[qb][eb][2] * acc[qb][eb][2] + acc[qb][eb][3] * acc[qb][eb][3]);
        const float rstd = frsq(rq_sum(ss) * (1.f / HD) + EPS);
#pragma unroll
        for (int eb = 0; eb < 8; ++eb) {
            const int e0 = h * HD + eb * 16 + rq * 4;
            const f32x4 g4 = ld_f4(F.ret_g + l * 1024 + e0);
            const u32x2 gw = ld_u2(TOK + (size_t)t * TOKP + TK_GR + e0);
            u32x2 o; o.x = pk2(acc[qb][eb][0] * rstd * g4[0] * bf_lo(gw.x), acc[qb][eb][1] * rstd * g4[1] * bf_hi(gw.x));
            o.y = pk2(acc[qb][eb][2] * rstd * g4[2] * bf_lo(gw.y), acc[qb][eb][3] * rstd * g4[3] * bf_hi(gw.y));
            st_u2(MIX + (size_t)t * D + 1024 + e0, o);
        }
    }
}

__device__ __constant__ unsigned char kCandAB[64] = {0, 1, 2, 3, 4, 5, 6, 7, 8, 9, 10, 11, 12, 13, 14, 15, 16, 17, 18, 19, 20, 21, 22, 23, 32, 33, 34, 35, 36, 48, 49, 50, 51, 64, 65, 66, 80, 81, 96, 97,
                                                   112, 113, 128, 144, 160, 176, 192, 208, 224, 240, 0, 0, 0, 0, 0, 0, 0, 0, 0, 0, 0, 0, 0, 0};
template <unsigned MASK> __device__ __forceinline__ float embed_idx(float x, unsigned idx) {
    const unsigned u = __builtin_bit_cast(unsigned, x); const unsigned low = (u >> 31) ? idx : (MASK - idx);
    return __builtin_bit_cast(float, (u & ~MASK) | low);
}
template <unsigned MASK> __device__ __forceinline__ unsigned decode_idx(float y) {
    const unsigned u = __builtin_bit_cast(unsigned, y); const unsigned low = u & MASK; return (u >> 31) ? low : (MASK - low);
}
template <int N> __device__ __forceinline__ void sortdesc(float (&v)[N]) {
#pragma unroll
    for (int k = 2; k <= N; k <<= 1)
#pragma unroll
        for (int j = k >> 1; j > 0; j >>= 1)
#pragma unroll
            for (int i = 0; i < N; ++i) { const int p = i ^ j;
                if (p > i) { const bool desc = ((i & k) == 0); const float a = v[i], b = v[p], hi = fmaxf(a, b), lo = fminf(a, b); v[i] = desc ? hi : lo; v[p] = desc ? lo : hi; } }
}
__device__ __forceinline__ void merge16(float (&v)[16]) {
#pragma unroll
    for (int j = 8; j > 0; j >>= 1)
#pragma unroll
        for (int i = 0; i < 16; ++i) { const int p = i ^ j; if (p > i) { const float a = v[i], b = v[p]; v[i] = fmaxf(a, b); v[p] = fminf(a, b); } }
}
__device__ __forceinline__ void top16_of_group(float (&a)[16]) {
#pragma unroll
    for (int sh = 16; sh <= 32; sh <<= 1) {
        float cc[16];
#pragma unroll
        for (int i = 0; i < 16; ++i) cc[i] = fmaxf(a[i], __shfl_xor(a[15 - i], sh));
        merge16(cc);
#pragma unroll
        for (int i = 0; i < 16; ++i) a[i] = cc[i];
    }
}
constexpr int TL_STRIDE = 17, TL_WAVE_FLOATS = 2 * 16 * TL_STRIDE;
constexpr int KL_PITCH = 272, KL_BYTES = 2 * 128 * KL_PITCH;
static_assert(KL_BYTES + NWAVES * TL_WAVE_FLOATS * 4 <= RING_BYTES, "top-k LDS map");
__device__ __forceinline__ void topk_task(const Frame& F, int l, int tb, int h, const LAS unsigned char* kl, LAS float* tl, const LAS unsigned char* cab) {
    int lane = lane_id(); asm volatile("" : "+v"(lane));
    const int c = lane & 15, rq = lane >> 4;
    const int t0 = tb * 16;
    const bf16* QP = (const bf16*)(F.ws + WS_QP);
    int* EXPI = (int*)(F.ws + WS_EXP); float* GATE = (float*)(F.ws + WS_GATE);
    const float NEG = -__builtin_inff();
    bf16x8 Qall[2][4];
#pragma unroll
    for (int p = 0; p < 2; ++p)
#pragma unroll
        for (int ks = 0; ks < 4; ++ks) Qall[p][ks] = ld_b8(QP + (size_t)(t0 + c) * QPP + h * 256 + p * 128 + ks * 32 + rq * 8);
    float rsp[8];
    { const float* SS2 = (const float*)(F.ws + WS_SS2) + (t0 + c);
#pragma unroll
        for (int i = 0; i < 8; ++i) rsp[i] = *(const GAS float*)(SS2 + (size_t)(rq * 8 + i) * T); }
#pragma unroll
    for (int p = 0; p < 2; ++p) {
        bf16x8 Qf[4];
#pragma unroll
        for (int ks = 0; ks < 4; ++ks) Qf[ks] = Qall[p][ks];
        float v[32];
        const LAS unsigned char* kbase = kl + (p * 128 + c) * KL_PITCH + rq * 16;
#pragma unroll
        for (int kb = 0; kb < 8; ++kb) {
            f32x4 a = (f32x4){0.f, 0.f, 0.f, 0.f};
#pragma unroll
            for (int ks = 0; ks < 4; ++ks) a = mfma16(*(const LAS bf16x8*)(kbase + kb * 16 * KL_PITCH + ks * 64), Qf[ks], a);
#pragma unroll
            for (int e = 0; e < 4; ++e) v[kb * 4 + e] = embed_idx<127u>(a[e], (unsigned)(kb * 16 + rq * 4 + e));
        }
        sortdesc<32>(v);
        float top[16];
#pragma unroll
        for (int i = 0; i < 16; ++i) top[i] = v[i];
        top16_of_group(top);
        if (rq == 0) {
#pragma unroll
            for (int it = 0; it < 16; ++it) tl[(p * 16 + c) * TL_STRIDE + it] = top[it];
        }
    }
    LDS_WAIT(); asm volatile("" ::: "memory");
    const LAS float* t0l = tl + (0 * 16 + c) * TL_STRIDE; const LAS float* t1l = tl + (16 + c) * TL_STRIDE;
    float res[16];
#pragma unroll
    for (int j = 0; j < 16; ++j) {
        const int cid = j * 4 + rq; const unsigned ab = cab[cid < 50 ? cid : 0];
        const float sum = t0l[ab >> 4] + t1l[ab & 15];
        res[j] = (j < 13 && cid < 50) ? embed_idx<63u>(sum, (unsigned)cid) : NEG;
    }
    sortdesc<16>(res);
    top16_of_group(res);
    float rs2 = 0.f;
#pragma unroll
    for (int i = 0; i < 8; ++i) rs2 += rsp[i];
    const float lsc = frsq(rq_sum(rs2) * (1.f / D) + EPS) * LOG2E;
    float den = 0.f;
#pragma unroll
    for (int it = 0; it < 16; ++it) den += fexp2((res[it] - res[0]) * lsc);
    const float rden = 1.0f / den;
#pragma unroll
    for (int it = 0; it < 16; ++it) {
        if ((it >> 2) == rq) {
            const unsigned cid = decode_idx<63u>(res[it]); const unsigned ab = cab[cid];
            const unsigned i1 = decode_idx<127u>(t0l[ab >> 4]), i2 = decode_idx<127u>(t1l[ab & 15]);
            const size_t o = (size_t)(t0 + c) * 128 + h * 16 + it;
            *(GAS int*)(EXPI + o) = (int)(i1 * 128u + i2);
            *(GAS float*)(GATE + o) = fexp2((res[it] - res[0]) * lsc) * rden;
        }
    }
    LDS_WAIT(); asm volatile("" ::: "memory");
}

__device__ __forceinline__ float reduce16(const float (&p)[16], int lane) {
    const bool b5 = lane & 32, b4 = lane & 16, b3 = lane & 8, b2 = lane & 4;
    float q[8], r4[4], s2[2];
#pragma unroll
    for (int k = 0; k < 8; ++k) { const float send = b5 ? p[k] : p[k + 8], keep = b5 ? p[k + 8] : p[k]; q[k] = keep + __shfl_xor(send, 32); }
#pragma unroll
    for (int k = 0; k < 4; ++k) { const float send = b4 ? q[k] : q[k + 4], keep = b4 ? q[k + 4] : q[k]; r4[k] = keep + __shfl_xor(send, 16); }
#pragma unroll
    for (int k = 0; k < 2; ++k) { const float send = b3 ? r4[k] : r4[k + 2], keep = b3 ? r4[k + 2] : r4[k]; s2[k] = keep + __shfl_xor(send, 8); }
    const float send = b2 ? s2[0] : s2[1], keep = b2 ? s2[1] : s2[0];
    float v = keep + __shfl_xor(send, 4);
    v += __shfl_xor(v, 1); v += __shfl_xor(v, 2);
    return v;
}
struct RowBuf { u32x4 r[8]; };
__device__ __forceinline__ void rows_load(RowBuf& B, const unsigned char* tab, int ids, int lane_base, int lane) {
#pragma unroll
    for (int r = 0; r < 8; ++r) {
        const int e = __builtin_amdgcn_readlane(ids, lane_base + r);
        B.r[r] = ld_u4(tab + (size_t)e * (D / 2) + lane * 16);
    }
}
__device__ __forceinline__ float dot8f4(unsigned w, const float* hv) {
    const f32x2 a = __builtin_amdgcn_cvt_scalef32_pk_f32_fp4(w, 1.0f, 0), b = __builtin_amdgcn_cvt_scalef32_pk_f32_fp4(w, 1.0f, 1),
                c = __builtin_amdgcn_cvt_scalef32_pk_f32_fp4(w, 1.0f, 2), d = __builtin_amdgcn_cvt_scalef32_pk_f32_fp4(w, 1.0f, 3);
    return ((a[0] * hv[0] + a[1] * hv[1]) + (b[0] * hv[2] + b[1] * hv[3])) + ((c[0] * hv[4] + c[1] * hv[5]) + (d[0] * hv[6] + d[1] * hv[7]));
}
__device__ __forceinline__ float dot32(const u32x4 w, const float* hv) { return (dot8f4(w.x, hv) + dot8f4(w.y, hv + 8)) + (dot8f4(w.z, hv + 16) + dot8f4(w.w, hv + 24)); }
__device__ __forceinline__ void axpy8f4(unsigned w, float s, float* o) {
    const f32x2 a = __builtin_amdgcn_cvt_scalef32_pk_f32_fp4(w, 1.0f, 0), b = __builtin_amdgcn_cvt_scalef32_pk_f32_fp4(w, 1.0f, 1),
                c = __builtin_amdgcn_cvt_scalef32_pk_f32_fp4(w, 1.0f, 2), d = __builtin_amdgcn_cvt_scalef32_pk_f32_fp4(w, 1.0f, 3);
    o[0] += s * a[0]; o[1] += s * a[1]; o[2] += s * b[0]; o[3] += s * b[1]; o[4] += s * c[0]; o[5] += s * c[1]; o[6] += s * d[0]; o[7] += s * d[1];
}
__device__ __forceinline__ void axpy32(const u32x4 w, float s, float* o) { axpy8f4(w.x, s, o); axpy8f4(w.y, s, o + 8); axpy8f4(w.z, s, o + 16); axpy8f4(w.w, s, o + 24); }
constexpr size_t XSL_BYTES = (size_t)NEXP * 128;
constexpr int XW_S = 0, XW_SQ = 8192, XW_RS = 10240, XW_B = 10304, XW_ID = 10816, XW_BYTES = 13312;
constexpr int XZ_OFF = NWAVES * XW_BYTES, XZ_BYTES = 512;
constexpr int XG_OFF = XZ_OFF + XZ_BYTES;
typedef int i32x8 __attribute__((ext_vector_type(8)));
struct URows { u32x4 r[16]; };
__device__ __forceinline__ f32x4 reduce32to4(const float (&p)[32], int lane) {
    const bool b5 = (lane & 32) != 0, b4 = (lane & 16) != 0, b3 = (lane & 8) != 0;
    float q[16], r8[8]; f32x4 o;
#pragma unroll
    for (int k = 0; k < 16; ++k) { const float send = b5 ? p[k] : p[k + 16], keep = b5 ? p[k + 16] : p[k]; q[k] = keep + __shfl_xor(send, 32); }
#pragma unroll
    for (int k = 0; k < 8; ++k) { const float send = b4 ? q[k] : q[k + 8], keep = b4 ? q[k + 8] : q[k]; r8[k] = keep + __shfl_xor(send, 16); }
#pragma unroll
    for (int k = 0; k < 4; ++k) { const float send = b3 ? r8[k] : r8[k + 4], keep = b3 ? r8[k + 4] : r8[k]; o[k] = keep + __shfl_xor(send, 8); }
    return o;
}
#define XFENCE() asm volatile("" ::: "memory")
__device__ __forceinline__ u32x4 ldo_u4(const void* base, unsigned off) { return *(const GAS u32x4*)((const GAS unsigned char*)base + off); }
__device__ __forceinline__ u32x2 ldo_u2(const void* base, unsigned off) { return *(const GAS u32x2*)((const GAS unsigned char*)base + off); }
__device__ __forceinline__ void sto_u2(void* base, unsigned off, u32x2 v) { *(GAS u32x2*)((GAS unsigned char*)base + off) = v; }
__device__ __forceinline__ void sto_f4(void* base, unsigned off, f32x4 v) { *(GAS f32x4*)((GAS unsigned char*)base + off) = v; }
__device__ __forceinline__ void expert_phase(const Frame& F, int l, int xcc, LAS unsigned char* wl, const LAS unsigned char* zb) {
    int lane = lane_id(); asm volatile("" : "+v"(lane));
    const int c = lane & 15, rq = lane >> 4, rr = lane >> 3, pc = lane & 7;
    LAS float* SA = (LAS float*)(wl + XW_S); LAS float* SQ = (LAS float*)(wl + XW_SQ); LAS float* RS = (LAS float*)(wl + XW_RS); LAS unsigned char* BI = wl + XW_B; LAS unsigned char* IDL = wl + XW_ID;
    const unsigned char* UBl = (const unsigned char*)(F.ws + WS_UB) + (size_t)l * NEXP * (D / 2); const unsigned char* VBl = (const unsigned char*)(F.ws + WS_VB) + (size_t)l * NEXP * (D / 2);
    const unsigned* SUV = (const unsigned*)(F.ws + WS_SU) + (size_t)l * NEXP;
    const bf16* X1 = (const bf16*)(F.ws + WS_H2); bf16* XR = (bf16*)(F.ws + WS_XR);
    const int* EXPI = (const int*)(F.ws + WS_EXP); const float* GATE = (const float*)(F.ws + WS_GATE);
    const LAS float* G2 = (const LAS float*)(zb + XZ_BYTES);
    for (int tb = F.gw; tb < T; tb += 8 * F.ngw) {
        auto tok = [&](int k) { const int t = tb + k * F.ngw; return t < T ? t : tb; };
        auto slice_of = [&](int i) { return ((i >> 3) + xcc) & 7; };
        {
            float zf = 0.f; asm volatile("" : "+v"(zf)); const f32x4 z = (f32x4){zf, zf, zf, zf};
#pragma unroll
            for (int i = 0; i < 8; ++i) *(LAS f32x4*)(SA + (i * 64 + lane) * 4) = z;
#pragma unroll
            for (int i = 0; i < 2; ++i) *(LAS f32x4*)(SQ + (i * 64 + lane) * 4) = z;
#pragma unroll
            for (int k = 0; k < 8; ++k) { const u32x2 e2 = ldo_u2(EXPI + (size_t)tok(k) * 128, 8u * lane); *(LAS unsigned*)(IDL + k * 256 + lane * 4) = e2.x | (e2.y << 16); }
            const float* SS2 = (const float*)(F.ws + WS_SS2);
            float ss[8];
#pragma unroll
            for (int k = 0; k < 8; ++k) ss[k] = *(const GAS float*)(SS2 + (size_t)(lane & 31) * T + tok(k));
#pragma unroll
            for (int k = 0; k < 8; ++k) { const float tot = wave_sum(ss[k]) * 0.5f; if (lane == 0) RS[k] = frsq(tot * (1.f / D) + EPS); }
            LDS_WAIT(); XFENCE();
        }
#ifndef U_REP
#define U_REP 1
#endif
#ifndef V_REP
#define V_REP 1
#endif
        for (int urep = 0; urep < U_REP; ++urep) {
            if (urep) { float zf = 0.f; asm volatile("" : "+v"(zf)); const f32x4 z = (f32x4){zf, zf, zf, zf};
#pragma unroll
                for (int i = 0; i < 8; ++i) *(LAS f32x4*)(SA + (i * 64 + lane) * 4) = z;
                LDS_WAIT(); XFENCE(); }
            const LAS unsigned char* bbase = c < 2 ? BI + c * 128 + rq * 32 : zb;
            LAS unsigned char* bw = BI + (lane >> 5) * 256 + (((lane & 31) >> 2) & 3) * 32 + ((lane & 31) >> 4) * 16 + (lane & 3) * 4;
            auto u_x = [&](int i) { return ldo_u2(X1 + (size_t)tok(i & 7) * D + slice_of(i) * 256, 8u * lane); };
            struct HRows { u32x4 r[8]; };
            auto u_rows_h = [&](int hs, HRows& H) {
                const int i = hs >> 1, mg = hs & 1;
                const unsigned char* Usl = UBl + (size_t)slice_of(i) * XSL_BYTES;
                const u32x2 id = *(const LAS u32x2*)(IDL + (i & 7) * 256 + c * 16 + mg * 8);
#ifdef U_PROBE_MASK
                const unsigned pm = (U_REP > 1 && urep == 0) ? (unsigned)(U_PROBE_MASK) : 0xffffu;
#else
                const unsigned pm = 0xffffu;
#endif
                const unsigned i0 = id.x, i1 = id.y;
#pragma unroll
                for (int mm = 0; mm < 4; ++mm) { const unsigned w = mm < 2 ? i0 : i1; const unsigned e = (mm & 1) ? (w >> 16) : (w & 0xffffu); const unsigned off = (e & pm) * 128u + 16u * rq;
                    H.r[2 * mm] = ldo_u4(Usl, off); H.r[2 * mm + 1] = ldo_u4(Usl + 64, off); }
            };
            i32x8 B0, B1;
            auto u_bbuild = [&](int i, const u32x2& xw) {
                const int k = i & 7;
                const f32x4 gg = *(const LAS f32x4*)(G2 + slice_of(i) * 256 + 4 * lane);
                const float rstd = RS[k];
                const float h0 = bf_lo(xw.x) * rstd * gg[0], h1 = bf_hi(xw.x) * rstd * gg[1], h2 = bf_lo(xw.y) * rstd * gg[2], h3 = bf_hi(xw.y) * rstd * gg[3];
                int w = __builtin_amdgcn_cvt_pk_fp8_f32(h0, h1, 0, false); w = __builtin_amdgcn_cvt_pk_fp8_f32(h2, h3, w, true);
                const f32x2 b0 = __builtin_amdgcn_cvt_pk_f32_fp8(w, false), b1 = __builtin_amdgcn_cvt_pk_f32_fp8(w, true);
                int v = __builtin_amdgcn_cvt_pk_fp8_f32(h0 - b0[0], h1 - b0[1], 0, false); v = __builtin_amdgcn_cvt_pk_fp8_f32(h2 - b1[0], h3 - b1[1], v, true);
                *(LAS int*)(bw) = w; *(LAS int*)(bw + 128) = v;
                LDS_WAIT(); XFENCE();
                const u32x4 b0l = *(const LAS u32x4*)(bbase), b0h = *(const LAS u32x4*)(bbase + 16), b1l = *(const LAS u32x4*)(bbase + 256), b1h = *(const LAS u32x4*)(bbase + 272);
                B0 = (i32x8){(int)b0l.x, (int)b0l.y, (int)b0l.z, (int)b0l.w, (int)b0h.x, (int)b0h.y, (int)b0h.z, (int)b0h.w};
                B1 = (i32x8){(int)b1l.x, (int)b1l.y, (int)b1l.z, (int)b1l.w, (int)b1h.x, (int)b1h.y, (int)b1h.z, (int)b1h.w};
            };
            auto u_comp_h = [&](int hs, HRows& H) {
                const int k = (hs >> 1) & 7, mg = hs & 1;
                LAS f32x4* tp = (LAS f32x4*)(SA + k * 256 + (c & 1) * 16 + 4 * rq) + mg * 32;
                f32x4 acc[4];
#pragma unroll
                for (int mm = 0; mm < 4; ++mm) acc[mm] = (f32x4){0.f, 0.f, 0.f, 0.f};
                if (c < 2) {
#pragma unroll
                    for (int mm = 0; mm < 4; ++mm) acc[mm] = tp[mm * 8];
                }
#pragma unroll
                for (int mm = 0; mm < 4; ++mm) {
                    const i32x8 a0 = {(int)H.r[2 * mm].x, (int)H.r[2 * mm].y, (int)H.r[2 * mm].z, (int)H.r[2 * mm].w, 0, 0, 0, 0};
                    const i32x8 a1 = {(int)H.r[2 * mm + 1].x, (int)H.r[2 * mm + 1].y, (int)H.r[2 * mm + 1].z, (int)H.r[2 * mm + 1].w, 0, 0, 0, 0};
                    acc[mm] = __builtin_amdgcn_mfma_scale_f32_16x16x128_f8f6f4(a0, B0, acc[mm], 4, 0, 0, 0x7F7F7F7F, 0, 0x7F7F7F7F);
                    acc[mm] = __builtin_amdgcn_mfma_scale_f32_16x16x128_f8f6f4(a1, B1, acc[mm], 4, 0, 0, 0x7F7F7F7F, 0, 0x7F7F7F7F);
                }
                if (c < 2) {
#pragma unroll
                    for (int mm = 0; mm < 4; ++mm) tp[mm * 8] = acc[mm];
                }
            };
            HRows H0, H1, H2, H3;
            u32x2 xe, xo;
            xe = u_x(0);
            u_rows_h(0, H0); u_rows_h(1, H1); u_rows_h(2, H2);
            xo = u_x(1);
            XFENCE();
#pragma unroll 1
            for (int hs = 0; hs < 128; hs += 4) {
                const int i = hs >> 1;
                const int h3 = hs + 3, h4 = hs + 4 < 128 ? hs + 4 : 127, h5 = hs + 5 < 128 ? hs + 5 : 127, h6 = hs + 6 < 128 ? hs + 6 : 127;
                u_rows_h(h3, H3);
                XFENCE();
                u_bbuild(i, xe); u_comp_h(hs, H0);
                XFENCE();
                u_rows_h(h4, H0); xe = u_x(i + 2 < 64 ? i + 2 : 63);
                XFENCE();
                u_comp_h(hs + 1, H1);
                XFENCE();
                u_rows_h(h5, H1);
                XFENCE();
                u_bbuild(i + 1, xo); u_comp_h(hs + 2, H2);
                XFENCE();
                u_rows_h(h6, H2); xo = u_x(i + 3 < 64 ? i + 3 : 63);
                XFENCE();
                u_comp_h(hs + 3, H3);
                XFENCE();
            }
        }
        LDS_WAIT(); XFENCE();
        {
            unsigned suvq[8][2]; float gtq[8][2];
#pragma unroll
            for (int k = 0; k < 8; ++k)
#pragma unroll
                for (int hf = 0; hf < 2; ++hf) { const unsigned e = *(const LAS unsigned short*)(IDL + k * 256 + (hf * 64 + lane) * 2);
                    suvq[k][hf] = *(const GAS unsigned*)(SUV + e); gtq[k][hf] = *(const GAS float*)(GATE + (size_t)tok(k) * 128 + hf * 64 + lane); }
#pragma unroll
            for (int k = 0; k < 8; ++k) {
                float wq[2];
#pragma unroll
                for (int hf = 0; hf < 2; ++hf) {
                    const unsigned suv = suvq[k][hf];
                    const int kk = hf * 64 + lane;
                    const float a = (SA[k * 256 + (kk & 7) * 32 + (kk >> 3)] + SA[k * 256 + (kk & 7) * 32 + 16 + (kk >> 3)]) * bf_lo(suv);
                    wq[hf] = gtq[k][hf] * bf_hi(suv) * 0.5f * a * (1.0f + erff(a * 0.7071067811865476f));
                }
                XFENCE();
                float wm = fmaxf(__builtin_fabsf(wq[0]), __builtin_fabsf(wq[1]));
#pragma unroll
                for (int o = 1; o < 64; o <<= 1) wm = fmaxf(wm, __shfl_xor(wm, o));
                const float sc = __builtin_bit_cast(float, __builtin_bit_cast(unsigned, fminf(42.0f / fmaxf(wm, 1e-30f), 1.0e18f)) & 0x7f800000u);
                const unsigned h0 = (unsigned)__builtin_bit_cast(unsigned short, (_Float16)(wq[0] * sc)), h1 = (unsigned)__builtin_bit_cast(unsigned short, (_Float16)(wq[1] * sc));
                ((LAS unsigned*)SA)[k * 256 + lane] = h0 | (h0 << 16); ((LAS unsigned*)SA)[k * 256 + 64 + lane] = h1 | (h1 << 16);
                if (lane == 0) RS[8 + k] = 1.0f / sc;
            }
        }
        LDS_WAIT(); XFENCE();
        for (int vrep = 0; vrep < V_REP; ++vrep) {
            if (vrep) { float zf = 0.f; asm volatile("" : "+v"(zf)); const f32x4 z = (f32x4){zf, zf, zf, zf};
#pragma unroll
                for (int i = 0; i < 2; ++i) *(LAS f32x4*)(SQ + (i * 64 + lane) * 4) = z;
                LDS_WAIT(); XFENCE(); }
            auto v_rows = [&](int i, URows& R) {
                const unsigned char* Vsl = VBl + (size_t)slice_of(i) * XSL_BYTES;
                const u32x4 ia = *(const LAS u32x4*)(IDL + (i & 7) * 256 + rr * 32), ib = *(const LAS u32x4*)(IDL + (i & 7) * 256 + rr * 32 + 16);
#pragma unroll
                for (int j = 0; j < 16; ++j) { const unsigned w = j < 8 ? ia[(j >> 1) & 3] : ib[(j >> 1) & 3]; const unsigned e = (j & 1) ? (w >> 16) : (w & 0xffffu);
                    R.r[j] = ldo_u4(Vsl, e * 128u + 16u * pc); }
            };
            auto v_comp = [&](int i, const URows& R) {
                const int k = i & 7, t = tok(k), sl = slice_of(i);
                const unsigned col = 32u * pc + 4u * rr;
                u32x2 xw;
                typedef _Float16 hf2 __attribute__((ext_vector_type(2)));
                const LAS u32x4* wp = (const LAS u32x4*)(SA + k * 256 + 16 * rr);
                const u32x4 wall[4] = {wp[0], wp[1], wp[2], wp[3]};
                unsigned out[16];
#pragma unroll
                for (int j = 0; j < 16; ++j) out[j] = 0u;
#pragma unroll
                for (int j = 0; j < 16; ++j) {
                    if (j == 8) xw = ldo_u2(X1 + (size_t)t * D + sl * 256, 2u * col);
                    u32x4 rj = R.r[j];
                    asm volatile("" : "+v"(rj.x), "+v"(rj.y), "+v"(rj.z), "+v"(rj.w) :: "memory");
                    const unsigned wj = wall[j >> 2][j & 3]; const hf2 w2 = __builtin_bit_cast(hf2, wj);
#pragma unroll
                    for (int d = 0; d < 4; ++d) {
                        const hf2 a = __builtin_amdgcn_cvt_scalef32_pk_f16_fp4(rj[d], 1.0f, 0), b = __builtin_amdgcn_cvt_scalef32_pk_f16_fp4(rj[d], 1.0f, 1),
                                  cc = __builtin_amdgcn_cvt_scalef32_pk_f16_fp4(rj[d], 1.0f, 2), dd = __builtin_amdgcn_cvt_scalef32_pk_f16_fp4(rj[d], 1.0f, 3);
                        out[4 * d] = __builtin_bit_cast(unsigned, __builtin_elementwise_fma(a, w2, __builtin_bit_cast(hf2, out[4 * d])));
                        out[4 * d + 1] = __builtin_bit_cast(unsigned, __builtin_elementwise_fma(b, w2, __builtin_bit_cast(hf2, out[4 * d + 1])));
                        out[4 * d + 2] = __builtin_bit_cast(unsigned, __builtin_elementwise_fma(cc, w2, __builtin_bit_cast(hf2, out[4 * d + 2])));
                        out[4 * d + 3] = __builtin_bit_cast(unsigned, __builtin_elementwise_fma(dd, w2, __builtin_bit_cast(hf2, out[4 * d + 3])));
                    }
                    if ((j & 3) == 3) asm volatile("" : "+v"(out[0]), "+v"(out[1]), "+v"(out[2]), "+v"(out[3]), "+v"(out[4]), "+v"(out[5]), "+v"(out[6]), "+v"(out[7]), "+v"(out[8]), "+v"(out[9]), "+v"(out[10]), "+v"(out[11]), "+v"(out[12]), "+v"(out[13]), "+v"(out[14]), "+v"(out[15]) :: "memory");
                }
                unsigned o2[2];
                {
                    const bool b5 = (lane & 32) != 0, b4 = (lane & 16) != 0, b3 = (lane & 8) != 0;
                    unsigned q8[8], q4[4];
                    auto hadd = [](unsigned x, unsigned y) { return __builtin_bit_cast(unsigned, __builtin_bit_cast(hf2, x) + __builtin_bit_cast(hf2, y)); };
#pragma unroll
                    for (int n = 0; n < 8; ++n) { const unsigned send = b5 ? out[n] : out[n + 8], keep = b5 ? out[n + 8] : out[n]; q8[n] = hadd(keep, (unsigned)__shfl_xor((int)send, 32)); }
#pragma unroll
                    for (int n = 0; n < 4; ++n) { const unsigned send = b4 ? q8[n] : q8[n + 4], keep = b4 ? q8[n + 4] : q8[n]; q4[n] = hadd(keep, (unsigned)__shfl_xor((int)send, 16)); }
#pragma unroll
                    for (int n = 0; n < 2; ++n) { const unsigned send = b3 ? q4[n] : q4[n + 2], keep = b3 ? q4[n + 2] : q4[n]; o2[n] = hadd(keep, (unsigned)__shfl_xor((int)send, 8)); }
                }
                const float isc = RS[8 + k];
                const hf2 oa = __builtin_bit_cast(hf2, o2[0]), ob = __builtin_bit_cast(hf2, o2[1]);
                const float y0 = bf_lo(xw.x) + (float)oa[0] * isc, y1 = bf_hi(xw.x) + (float)oa[1] * isc, y2 = bf_lo(xw.y) + (float)ob[0] * isc, y3 = bf_hi(xw.y) + (float)ob[1] * isc;
                if (l + 1 < DEPTH) {
                    u32x2 w; w.x = pk2(y0, y1); w.y = pk2(y2, y3);
                    sto_u2(XR + (size_t)t * D + sl * 256, 2u * col, w);
                    const float s = (y0 * y0 + y1 * y1) + (y2 * y2 + y3 * y3);
                    (void)__hip_atomic_fetch_add(SQ + k * 64 + lane, s, __ATOMIC_RELAXED, __HIP_MEMORY_SCOPE_WAVEFRONT);
                } else sto_f4(F.out + (size_t)t * D + sl * 256, 4u * col, (f32x4){y0, y1, y2, y3});
            };
            URows RA, RB;
            v_rows(0, RA);
            XFENCE();
#pragma unroll 1
            for (int i = 0; i < 64; i += 2) {
                const int i2 = i + 2 < 64 ? i + 2 : 63;
                v_rows(i + 1, RB);
                XFENCE();
                v_comp(i, RA);
                XFENCE();
                v_rows(i2, RA);
                XFENCE();
                v_comp(i + 1, RB);
                XFENCE();
            }
        }
        if (l + 1 < DEPTH) {
            float* RSTD = (float*)(F.ws + WS_RSTD);
#pragma unroll
            for (int k = 0; k < 8; ++k) { const float r1 = frsq(wave_sum(SQ[k * 64 + lane]) * (1.f / D) + EPS); if (lane == 0) *(GAS float*)(RSTD + tok(k)) = r1; }
        }
        LDS_WAIT(); XFENCE();
    }
}

#ifndef PG8_SP2
#define PG8_SP2 true
#endif
#ifndef PG8_ALIGN
#define PG8_ALIGN true
#endif
struct Args { const float* in[14]; float* out; unsigned char* ws; int ph_lo, ph_hi, use_bar, pad; };
__global__ void __launch_bounds__(NWAVES * 64, 2) hybrid_fwd(Args args) {
    extern __shared__ __attribute__((aligned(16))) unsigned char lds_raw[];
    Frame F;
    F.lds = (LAS unsigned char*)lds_raw;
    F.wave = __builtin_amdgcn_readfirstlane((int)threadIdx.x >> 6);
    F.G = gridDim.x; F.gw = blockIdx.x * NWAVES + F.wave; F.ngw = F.G * NWAVES;
    F.x = args.in[0]; F.norm1_g = args.in[1]; F.w_in = args.in[2]; F.qa_g = args.in[3]; F.ka_g = args.in[4]; F.rel_bias = args.in[5]; F.attn_g = args.in[6]; F.ret_g = args.in[7];
    F.w_out = args.in[8]; F.norm2_g = args.in[9]; F.peer_wq = args.in[10]; F.peer_keys = args.in[11]; F.peer_u = args.in[12]; F.peer_v = args.in[13];
    F.out = args.out; F.ws = args.ws;
    for (int u = threadIdx.x; u < (LDS_BYTES - LDSCTL_OFF) / 4; u += NWAVES * 64) ((LAS unsigned*)(F.lds + LDSCTL_OFF))[u] = 0u;
    __syncthreads();
    unsigned* barw = (unsigned*)(args.ws + WS_CTL) + CW_BAR;
    XcdBarrier bar; bar.bar = barw; bar.x = 0; bar.st = nullptr;
    if (args.use_bar) bar = xcd_barrier_post(barw, (volatile LAS unsigned*)(F.lds + MISC_OFF) + 8);
    const int lo = args.ph_lo, hi = args.ph_hi;
#define IN(k) (lo <= (k) && (k) < hi)
#define SEAM(k) do { if (IN((k) + 1)) xcd_barrier(bar, F.wave); } while (0)

#ifndef REP_MASK
#define REP_MASK 0
#endif
#ifndef REP_N
#define REP_N 1
#endif
#define REPS(k) (((REP_MASK >> (k)) & 1) ? REP_N : 1)
#ifndef ONLY
#define PH_ON(k) 1
#else
#define PH_ON(k) ((k)==ONLY)
#endif
    if (PH_ON(0) && IN(0)) { for (int rep = 0; rep < REPS(0); ++rep) p0_prologue(F); SEAM(0); }

    for (int l = 0; l < DEPTH; ++l) {
        const int pb = 1 + l * PH_PER_LAYER;
        if (PH_ON(1) && IN(pb + 0)) for (int rep = 0; rep < REPS(1); ++rep) {
            {
                pg8::Gemm g{(const pg8::bf16_t*)(F.ws + WS_XR), (const pg8::bf16_t*)(F.ws + WS_WTOK) + (size_t)l * TOKC * D, T, TOKC, D};
                pg8::StaticOrder So; So.init(T, TOKC, F.G, (int)blockIdx.x);
                pg8::EpiTok E{(pg8::bf16_t*)(F.ws + WS_TOK), (const pg8::f32x2*)(F.ws + WS_ROPE_TOK), (float*)(F.ws + WS_SSQ), (const float*)(F.ws + WS_RSTD)};
                pg8::gemm_phase<pg8::EpiTok, pg8::StaticOrder, PG8_ALIGN, PG8_SP2>(F.lds + RING_OFF, g, So, E, F.wave);
            }
            {
                pg8::Gemm g{(const pg8::bf16_t*)(F.ws + WS_WSWP) + (size_t)l * SWPR * D, (const pg8::bf16_t*)(F.ws + WS_XR), SWPR, T, D};
                pg8::StaticOrder So; So.init(SWPR, T, F.G, (int)blockIdx.x);
                pg8::EpiSwp E{(pg8::bf16_t*)(F.ws + WS_SWP), SWPP, (const float*)(F.ws + WS_RSTD)};
                pg8::gemm_phase<pg8::EpiSwp, pg8::StaticOrder, PG8_ALIGN, PG8_SP2>(F.lds + RING_OFF, g, So, E, F.wave);
            }
            SEAM(pb + 0);
        }
        if (PH_ON(2) && IN(pb + 1)) for (int rep = 0; rep < REPS(2); ++rep) {
            LAS float* biasL = (LAS float*)(F.lds + RING_OFF + A_BIAS);
            int tid2 = F.wave * 64 + lane_id(); asm volatile("" : "+v"(tid2));
            for (int i = tid2; i < NH * 257; i += NWAVES * 64) biasL[i] = *(const GAS float*)(F.rel_bias + (size_t)l * NH * 257 + i) * LOG2E;
#ifndef SCAN_REP
#define SCAN_REP 1
#endif
            for (int srep = 0; srep < SCAN_REP; ++srep)
            for (int task = F.gw; task < NBATCH * NH * 8 * 2; task += F.ngw) scan_task(F, task);
            {
                constexpr int NAT = NBATCH * NH * 8;
                const int g = (int)blockIdx.x;
                if (F.G == 256) {
                    const int n = g < 128 ? 1 : 3, first = g < 128 ? g : 128 + (g - 128) * 3;
                    for (int i = 0; i < n; ++i) attn_wg_task(F, l, first + i);
                } else {
                    for (int task = g; task < NAT; task += F.G) attn_wg_task(F, l, task);
                }
            }
            SEAM(pb + 1);
        }
        if (PH_ON(3) && IN(pb + 2)) for (int rep = 0; rep < REPS(3); ++rep) {
            for (int task = F.gw; task < NBATCH * NH * NCH * 2; task += F.ngw) ret_task(F, l, task);
            SEAM(pb + 2);
        }
        if (PH_ON(4) && IN(pb + 3)) for (int rep = 0; rep < REPS(4); ++rep) {
            pg8::Gemm g{(const pg8::bf16_t*)(F.ws + WS_MIX), (const pg8::bf16_t*)(F.ws + WS_WOUT) + (size_t)l * D * D, T, D, D};
            pg8::StaticOrder So; So.init(T, D, F.G, (int)blockIdx.x);
            pg8::EpiRes E{l == 0 ? F.x : (const float*)nullptr, (const pg8::bf16_t*)(F.ws + WS_XR), (pg8::bf16_t*)(F.ws + WS_H2), (float*)(F.ws + WS_SS2)};
            pg8::gemm_phase<pg8::EpiRes, pg8::StaticOrder, PG8_ALIGN, PG8_SP2>(F.lds + RING_OFF, g, So, E, F.wave);
            SEAM(pb + 3);
        }
        if (PH_ON(6) && IN(pb + 5)) for (int rep = 0; rep < REPS(6); ++rep) {
            pg8::Gemm g{(const pg8::bf16_t*)(F.ws + WS_H2), (const pg8::bf16_t*)(F.ws + WS_WQ) + (size_t)l * D * D, T, D, D};
            pg8::StaticOrder So; So.init(T, D, F.G, (int)blockIdx.x);
            pg8::EpiB16 E{(pg8::bf16_t*)(F.ws + WS_QP), QPP};
            pg8::gemm_phase<pg8::EpiB16, pg8::StaticOrder, PG8_ALIGN, PG8_SP2>(F.lds + RING_OFF, g, So, E, F.wave);
            SEAM(pb + 5);
        }
        if (PH_ON(7) && IN(pb + 6)) for (int rep = 0; rep < REPS(7); ++rep) {
            LAS unsigned char* kl = F.lds + RING_OFF; LAS float* tl = (LAS float*)(F.lds + RING_OFF + KL_BYTES) + F.wave * TL_WAVE_FLOATS;
            int tid3 = F.wave * 64 + lane_id(); asm volatile("" : "+v"(tid3));
            LAS unsigned char* cab = F.lds + RING_OFF + KL_BYTES + NWAVES * TL_WAVE_FLOATS * 4;
            if (tid3 < 64) cab[tid3] = kCandAB[tid3];
            const bf16* KEYS = (const bf16*)(F.ws + WS_KEYS) + (size_t)l * 8 * 256 * 128;
            for (int wt = blockIdx.x; wt < 256; wt += F.G) {
                const int tg = wt >> 1, hg = wt & 1;
                for (int hi = 0; hi < 4; ++hi) {
                    const int h = hg * 4 + hi;
                    __syncthreads();
#pragma unroll
                    for (int i = 0; i < 8; ++i) { const int idx = tid3 + 512 * i, row = idx >> 4, c16 = idx & 15;
                        *(LAS u32x4*)(kl + row * KL_PITCH + c16 * 16) = ld_u4(KEYS + ((size_t)h * 256 + row) * 128 + c16 * 8); }
                    __syncthreads();
                    topk_task(F, l, tg * 8 + F.wave, h, kl, tl, cab);
                }
            }
            SEAM(pb + 6);
        }
        if (PH_ON(8) && IN(pb + 7)) for (int rep = 0; rep < REPS(8); ++rep) {
            LAS unsigned char* wl = F.lds + RING_OFF + F.wave * XW_BYTES; const LAS unsigned char* zb = F.lds + RING_OFF + XZ_OFF;
            { int tid4 = F.wave * 64 + lane_id(); asm volatile("" : "+v"(tid4)); for (int i = tid4; i < XZ_BYTES / 4; i += NWAVES * 64) ((LAS unsigned*)zb)[i] = 0u;
              for (int i = tid4; i < D; i += NWAVES * 64) ((LAS float*)(F.lds + RING_OFF + XG_OFF))[i] = *(const GAS float*)(F.norm2_g + l * D + i); }
            __syncthreads();
            expert_phase(F, l, (int)xb_xcc_id(), wl, zb);
            SEAM(pb + 7);
        }
    }
#undef IN
#undef SEAM
}

extern "C" void kernel_launch(void* const* d_in, const int* in_sizes, int n_in, void* d_out, int out_size, void* d_ws, size_t ws_size, hipStream_t stream) {
    static int grid = 0;
    if (grid == 0) {
        if (n_in != 14 || in_sizes[0] != T * D || out_size != T * D || ws_size < WS_END) {
            fprintf(stderr, "kernel_launch: unexpected problem (n_in %d, in0 %d, out %d, ws %zu; need ws >= %zu); nothing launched\n", n_in, n_in > 0 ? in_sizes[0] : -1, out_size, ws_size, (size_t)WS_END); grid = -1; return; }
        int dev = 0, cus = 0, per_cu = 0;
        if (hipGetDevice(&dev) != hipSuccess || hipDeviceGetAttribute(&cus, hipDeviceAttributeMultiprocessorCount, dev) != hipSuccess) { fprintf(stderr, "kernel_launch: device query failed\n"); grid = -1; return; }
        if (hipFuncSetAttribute((const void*)hybrid_fwd, hipFuncAttributeMaxDynamicSharedMemorySize, LDS_BYTES) != hipSuccess) { fprintf(stderr, "kernel_launch: hipFuncSetAttribute failed\n"); grid = -1; return; }
        if (hipOccupancyMaxActiveBlocksPerMultiprocessor(&per_cu, (const void*)hybrid_fwd, NWAVES * 64, LDS_BYTES) != hipSuccess || per_cu < 1)
            fprintf(stderr, "kernel_launch: note: occupancy query reports %d workgroups per CU\n", per_cu);
        (void)hipGetLastError();
        grid = cus;
    }
    if (grid < 0) return;
    if (hipMemsetAsync((char*)d_ws + WS_CTL, 0, CTL_ZERO_BYTES, stream) != hipSuccess) { fprintf(stderr, "kernel_launch: memset failed\n"); return; }
    Args a{};
    for (int i = 0; i < 14; ++i) a.in[i] = (const float*)d_in[i];
    a.out = (float*)d_out; a.ws = (unsigned char*)d_ws; a.pad = 0;
#if MK_ONE_LAUNCH
    a.ph_lo = 0; a.ph_hi = N_PHASES; a.use_bar = 1;
    hipLaunchKernelGGL(hybrid_fwd, dim3(grid), dim3(NWAVES * 64), LDS_BYTES, stream, a);
    { const hipError_t le = hipPeekAtLastError(); if (le != hipSuccess) fprintf(stderr, "kernel_launch: launch failed: %s\n", hipGetErrorName(le)); }
#else
    for (int p = 0; p < N_PHASES; ++p) {
        a.ph_lo = p; a.ph_hi = p + 1; a.use_bar = 0;
        hipLaunchKernelGGL(hybrid_fwd, dim3(grid), dim3(NWAVES * 64), LDS_BYTES, stream, a);
        const hipError_t le = hipPeekAtLastError(); if (le != hipSuccess) { fprintf(stderr, "kernel_launch: launch %d failed: %s\n", p, hipGetErrorName(le)); break; }
    }
#endif
}
```

```cpp
#include <hip/hip_runtime.h>
#include <cstdio>
#include <cstdint>

#ifndef MK_ONE_LAUNCH
#define MK_ONE_LAUNCH 1
#endif

namespace pg8 {
#define PG8_LAS __attribute__((address_space(3)))
typedef unsigned short bf16_t;
typedef short bf16x8 __attribute__((ext_vector_type(8)));
typedef float f32x4 __attribute__((ext_vector_type(4)));
typedef unsigned u32x4 __attribute__((ext_vector_type(4)));
constexpr int BM = 256, BK = 64, HALF = 128, HTB = HALF * BK * 2  , STAGE_BYTES = 8 * HTB, NXCD = 8, WGM = 8;

__host__ __device__ __forceinline__ int lds_byte(int r, int c) { const int st = (r >> 4) * 2 + (c >> 5), rr = r & 15, cc = c & 31, ob = rr * 64 + cc * 2; return st * 1024 + (ob ^ (((ob >> 9) & 1) << 5)); }
__host__ __device__ __forceinline__ void stage_rc(int b, int& R, int& C) { const int st = b / 1024, sb = b % 1024, swz = sb ^ (((sb >> 9) & 1) << 5); R = (st >> 1) * 16 + swz / 64; C = (st & 1) * 32 + (swz % 64) / 2; }
__host__ __device__ __forceinline__ int perm32(int rho) { const int n = rho >> 4, i = rho & 15; return 8 * (i >> 2) + 4 * n + (i & 3); }

struct Unit { int pm, pn; };
struct Gemm { const bf16_t* A; const bf16_t* Bt; int M, N, K; };

struct StaticOrder {
    int nM, nN, nwg, G, c;
    __host__ __device__ void init(int M, int N, int G_, int c_) { nM = M / BM; nN = N / BM; nwg = nM * nN; G = G_; c = c_; }
    __host__ __device__ bool next(int i, Unit& u) const {
        const long L = (long)i * G + c; if (L >= nwg) return false;
        int wgid = (int)L; { const int q = nwg / NXCD, r = nwg % NXCD, xcd = wgid % NXCD, off = wgid / NXCD; wgid = (xcd < r ? xcd * (q + 1) : r * (q + 1) + (xcd - r) * q) + off; }
        const int nig = WGM * nN, gid = wgid / nig, fm = gid * WGM, gsz = (nM - fm) < WGM ? (nM - fm) : WGM;
        u.pm = fm + ((wgid % nig) % gsz); u.pn = (wgid % nig) / gsz; return true;
    }
    __device__ __forceinline__ void a_ready(const Unit&) const {}
    __device__ __forceinline__ void done(const Unit&) const {}
};
__device__ __forceinline__ unsigned cvt_pk_bf16(float lo, float hi) { unsigned r; asm volatile("v_cvt_pk_bf16_f32 %0, %1, %2" : "=v"(r) : "v"(lo), "v"(hi)); return r; }

typedef float f32x2 __attribute__((ext_vector_type(2)));
constexpr int MT = 16384, MS = 2048;
constexpr int TOKC = 5120;
constexpr int TOKP = 5248, SWPP = 16512, QPP = 2176;
constexpr float KSCALE = 0.08838834764831845f;
__device__ __forceinline__ float lg2gamma(int h) {
    return h == 0 ? -0.04580368961312479f : h == 1 ? -0.02272007650008353f : h == 2 ? -0.011315313227834146f : h == 3 ? -0.005646563141142063f :
           h == 4 ? -0.0028205190623786626f : h == 5 ? -0.0014095702546713536f : h == 6 ? -0.0007046129765893727f : -0.0003522634716290214f;
}

struct EpiTok {
    static constexpr bool PERM = true, AFTER_DRAIN = false;
    bf16_t* O; const f32x2* cs; float* ssq; const float* rstd;
    __device__ __forceinline__ void operator()(const f32x4 (&acc)[2][2][4][2], const Unit& u, int wr, int wc, int fr, int fq) const {
        const int row0 = u.pm * BM + wr * 64 + fr, kind = u.pn >> 2;
#pragma unroll
        for (int ai = 0; ai < 2; ++ai)
#pragma unroll
            for (int m = 0; m < 4; ++m) {
                const int row = row0 + ai * HALF + m * 16, pos = row & (MS - 1);
                const float rs = rstd[row];
#pragma unroll
                for (int bj = 0; bj < 2; ++bj) {
                    const int c0 = u.pn * BM + bj * HALF + wc * 32 + 8 * fq;
                    f32x4 v0 = acc[ai][bj][m][0] * rs, v1 = acc[ai][bj][m][1] * rs;
                    if (kind <= 1) {
                        float s = (v0[0] * v0[0] + v0[1] * v0[1]) + (v0[2] * v0[2] + v0[3] * v0[3]) + (v1[0] * v1[0] + v1[1] * v1[1]) + (v1[2] * v1[2] + v1[3] * v1[3]);
                        s += __shfl_xor(s, 16); s += __shfl_xor(s, 32);
                        const int head = (u.pn & 3) * 2 + bj;
                        if (fq == 0) ssq[(size_t)((kind * 8 + head) * 4 + wc) * MT + row] = s;
                    } else if (kind <= 3) {
                        const int i0 = (c0 & 127) >> 1;
                        const f32x4 csa = *(const f32x4*)(cs + (size_t)pos * 64 + i0), csb = *(const f32x4*)(cs + (size_t)pos * 64 + i0 + 2);
                        const float sc = (kind == 3) ? KSCALE : 1.0f;
                        f32x4 w0, w1;
                        w0[0] = (v0[0] * csa[0] - v0[1] * csa[1]) * sc; w0[1] = (v0[1] * csa[0] + v0[0] * csa[1]) * sc;
                        w0[2] = (v0[2] * csa[2] - v0[3] * csa[3]) * sc; w0[3] = (v0[3] * csa[2] + v0[2] * csa[3]) * sc;
                        w1[0] = (v1[0] * csb[0] - v1[1] * csb[1]) * sc; w1[1] = (v1[1] * csb[0] + v1[0] * csb[1]) * sc;
                        w1[2] = (v1[2] * csb[2] - v1[3] * csb[3]) * sc; w1[3] = (v1[3] * csb[2] + v1[2] * csb[3]) * sc;
                        v0 = w0; v1 = w1;
                    } else {
#pragma unroll
                        for (int j = 0; j < 4; ++j) { v0[j] = v0[j] * __builtin_amdgcn_rcpf(1.0f + __builtin_amdgcn_exp2f(-1.4426950408889634f * v0[j]));
                                                      v1[j] = v1[j] * __builtin_amdgcn_rcpf(1.0f + __builtin_amdgcn_exp2f(-1.4426950408889634f * v1[j])); }
                    }
                    u32x4 w; w.x = cvt_pk_bf16(v0[0], v0[1]); w.y = cvt_pk_bf16(v0[2], v0[3]); w.z = cvt_pk_bf16(v1[0], v1[1]); w.w = cvt_pk_bf16(v1[2], v1[3]);
                    *(u32x4*)(O + (size_t)row * TOKP + c0) = w;
                }
            }
    }
};
struct EpiRes {
    static constexpr bool PERM = false, AFTER_DRAIN = false;
    const float* R32; const bf16_t* R16; bf16_t* XB; float* ss2;
    __device__ __forceinline__ void operator()(const f32x4 (&acc)[2][2][4][2], const Unit& u, int wr, int wc, int fr, int fq) const {
        const int row0 = u.pm * BM + wr * 64 + fr, col0 = u.pn * BM + wc * 32 + 4 * fq;
#pragma unroll
        for (int ai = 0; ai < 2; ++ai)
#pragma unroll
            for (int m = 0; m < 4; ++m) { const int row = row0 + ai * HALF + m * 16; const size_t ro = (size_t)row * 2048 + col0;
                float s = 0.f;
#pragma unroll
                for (int bj = 0; bj < 2; ++bj)
#pragma unroll
                    for (int n = 0; n < 2; ++n) { f32x4 r;
                        if (R32) r = *(const f32x4*)(R32 + ro + bj * HALF + n * 16);
                        else { typedef unsigned u32x2_t __attribute__((ext_vector_type(2))); const u32x2_t rw = *(const u32x2_t*)(R16 + ro + bj * HALF + n * 16); const unsigned r0 = rw.x, r1 = rw.y;
                            r = (f32x4){__builtin_bit_cast(float, r0 << 16), __builtin_bit_cast(float, r0 & 0xffff0000u), __builtin_bit_cast(float, r1 << 16), __builtin_bit_cast(float, r1 & 0xffff0000u)}; }
                        const f32x4 v = acc[ai][bj][m][n] + r;
                        typedef unsigned u32x2_s __attribute__((ext_vector_type(2))); u32x2_s w; w.x = cvt_pk_bf16(v[0], v[1]); w.y = cvt_pk_bf16(v[2], v[3]);
                        *(u32x2_s*)(XB + ro + bj * HALF + n * 16) = w;
                        s += (v[0] * v[0] + v[1] * v[1]) + (v[2] * v[2] + v[3] * v[3]); }
                s += __shfl_xor(s, 16); s += __shfl_xor(s, 32);
                if (fq == 0) ss2[(size_t)(u.pn * 4 + wc) * MT + row] = s; }
    }
};
struct EpiB16 {
    static constexpr bool PERM = true, AFTER_DRAIN = false;
    bf16_t* O; int ldc;
    __device__ __forceinline__ void operator()(const f32x4 (&acc)[2][2][4][2], const Unit& u, int wr, int wc, int fr, int fq) const {
        const int row0 = u.pm * BM + wr * 64 + fr, col0 = u.pn * BM + wc * 32 + 8 * fq;
#pragma unroll
        for (int ai = 0; ai < 2; ++ai)
#pragma unroll
            for (int m = 0; m < 4; ++m) { bf16_t* rowp = O + (size_t)(row0 + ai * HALF + m * 16) * ldc + col0;
#pragma unroll
                for (int bj = 0; bj < 2; ++bj) { const f32x4 v0 = acc[ai][bj][m][0], v1 = acc[ai][bj][m][1];
                    u32x4 w; w.x = cvt_pk_bf16(v0[0], v0[1]); w.y = cvt_pk_bf16(v0[2], v0[3]); w.z = cvt_pk_bf16(v1[0], v1[1]); w.w = cvt_pk_bf16(v1[2], v1[3]);
                    *(u32x4*)(rowp + bj * HALF) = w; } }
    }
};
struct EpiSwp {
    static constexpr bool PERM = true, AFTER_DRAIN = false;
    bf16_t* O; int ldc; const float* rstd;
    __device__ __forceinline__ void operator()(const f32x4 (&acc)[2][2][4][2], const Unit& u, int wr, int wc, int fr, int fq) const {
        const int row0 = u.pm * BM + wr * 64 + fr, col0 = u.pn * BM + wc * 32 + 8 * fq;
        f32x4 ra[2], rb[2];
#pragma unroll
        for (int bj = 0; bj < 2; ++bj) { ra[bj] = *(const f32x4*)(rstd + col0 + bj * HALF); rb[bj] = *(const f32x4*)(rstd + col0 + bj * HALF + 4); }
#pragma unroll
        for (int ai = 0; ai < 2; ++ai)
#pragma unroll
            for (int m = 0; m < 4; ++m) { bf16_t* rowp = O + (size_t)(row0 + ai * HALF + m * 16) * ldc + col0;
#pragma unroll
                for (int bj = 0; bj < 2; ++bj) { const f32x4 v0 = acc[ai][bj][m][0] * ra[bj], v1 = acc[ai][bj][m][1] * rb[bj];
                    u32x4 w; w.x = cvt_pk_bf16(v0[0], v0[1]); w.y = cvt_pk_bf16(v0[2], v0[3]); w.z = cvt_pk_bf16(v1[0], v1[1]); w.w = cvt_pk_bf16(v1[2], v1[3]);
                    *(u32x4*)(rowp + bj * HALF) = w; } }
    }
};
template <class Epi, class Sched, bool ALIGN_EPI = false, bool SP2 = false>
__device__ __forceinline__ void gemm_phase(PG8_LAS unsigned char* lds, const Gemm g, const Sched& S, const Epi& E, int wave_in) {
    int tid_ = wave_in * 64 + (int)__builtin_amdgcn_mbcnt_hi(~0u, __builtin_amdgcn_mbcnt_lo(~0u, 0u)); asm volatile("" : "+v"(tid_));
    const int tid = tid_, wid = __builtin_amdgcn_readfirstlane(tid >> 6), lane = tid & 63, wr = wid >> 2, wc = wid & 3, fr = lane & 15, fq = lane >> 4;
    const int K = g.K, nt = K / BK;
    unsigned voffA[2], voffB[2];
#pragma unroll
    for (int i = 0; i < 2; ++i) { int R, C; stage_rc(tid * 16 + i * 8192, R, C); const int Rb = Epi::PERM ? ((R & ~31) + perm32(R & 31)) : R;
        voffA[i] = (unsigned)(R * K + C) * 2u; voffB[i] = (unsigned)(Rb * K + C) * 2u; }
    const size_t kstep = (size_t)(BK * 2);
    const size_t hstep = (size_t)HALF * K * 2;
    const size_t tstep = 2 * hstep;
    const unsigned ldsw = (unsigned)wid * 1024u;
    const int aoff = lds_byte(wr * 64 + fr, fq * 8), boff = lds_byte(wc * 32 + fr, fq * 8);
#define PG8_SA(b, h) (((b) * 2 + (h)) * HTB)
#define PG8_SB(b, h) ((4 + (b) * 2 + (h)) * HTB)
#define PG8_STAGE(bufoff, gbase, voff) do { _Pragma("unroll") for (int _i = 0; _i < 2; ++_i) \
        __builtin_amdgcn_global_load_lds((const unsigned*)((const char*)(gbase) + (voff)[_i]), (PG8_LAS unsigned*)(lds + (bufoff) + ldsw + _i * 8192), 16, 0, 0); } while (0)
#define PG8_LDA(dst, b, h) do { _Pragma("unroll") for (int m = 0; m < 4; ++m) _Pragma("unroll") for (int k = 0; k < 2; ++k) dst[m][k] = *(const PG8_LAS bf16x8*)(lds + PG8_SA(b, h) + aoff + m * 2048 + k * 1024); } while (0)
#define PG8_LDB(dst, b, h) do { _Pragma("unroll") for (int n = 0; n < 2; ++n) _Pragma("unroll") for (int k = 0; k < 2; ++k) dst[n][k] = *(const PG8_LAS bf16x8*)(lds + PG8_SB(b, h) + boff + n * 2048 + k * 1024); } while (0)
#define PG8_MMA(ai, bj, At, Bt) do { __builtin_amdgcn_s_setprio(1); _Pragma("unroll") for (int m = 0; m < 4; ++m) _Pragma("unroll") for (int n = 0; n < 2; ++n) _Pragma("unroll") for (int k = 0; k < 2; ++k) \
        acc[ai][bj][m][n] = __builtin_amdgcn_mfma_f32_16x16x32_bf16(Bt[n][k], At[m][k], acc[ai][bj][m][n], 0, 0, 0); __builtin_amdgcn_s_setprio(0); } while (0)
#define PG8_WAIT_V(n) asm volatile("s_waitcnt vmcnt(" #n ")" ::: "memory")
#define PG8_WAIT_L(n) asm volatile("s_waitcnt lgkmcnt(" #n ")" ::: "memory")
#define PG8_BAR __builtin_amdgcn_s_barrier()
#define PG8_SCHED __builtin_amdgcn_sched_barrier(0)
    Unit cur, nxt; int ui = 0;
    if (!S.next(0, cur)) return;
    f32x4 acc[2][2][4][2];
#pragma unroll
    for (int a = 0; a < 2; ++a)
#pragma unroll
        for (int b = 0; b < 2; ++b)
#pragma unroll
            for (int m = 0; m < 4; ++m)
#pragma unroll
                for (int n = 0; n < 2; ++n) acc[a][b][m][n] = (f32x4){0.f, 0.f, 0.f, 0.f};
    bf16x8 At[4][2], B0[2][2], B1[2][2];
    const char* cA = (const char*)g.A + (size_t)cur.pm * tstep; const char* cB = (const char*)g.Bt + (size_t)cur.pn * tstep;
    S.a_ready(cur);
    if constexpr (SP2) {
        PG8_STAGE(PG8_SB(0, 0), cB, voffB); PG8_STAGE(PG8_SB(0, 1), cB + hstep, voffB); PG8_STAGE(PG8_SA(0, 0), cA, voffA); PG8_STAGE(PG8_SA(0, 1), cA + hstep, voffA);
        if (wr == 1) PG8_BAR;
        PG8_WAIT_V(2); PG8_BAR;
        PG8_STAGE(PG8_SB(1, 0), cB + kstep, voffB); PG8_STAGE(PG8_SA(1, 0), cA + kstep, voffA); PG8_STAGE(PG8_SB(1, 1), cB + hstep + kstep, voffB);
        PG8_WAIT_V(6); PG8_BAR;
    } else {
        PG8_STAGE(PG8_SB(0, 0), cB, voffB); PG8_STAGE(PG8_SA(0, 0), cA, voffA); PG8_STAGE(PG8_SB(0, 1), cB + hstep, voffB); PG8_STAGE(PG8_SA(0, 1), cA + hstep, voffA);
        if (wr == 1) PG8_BAR;
        PG8_WAIT_V(4); PG8_BAR;
        PG8_STAGE(PG8_SB(1, 0), cB + kstep, voffB); PG8_STAGE(PG8_SA(1, 0), cA + kstep, voffA); PG8_STAGE(PG8_SB(1, 1), cB + hstep + kstep, voffB);
        PG8_WAIT_V(6); PG8_BAR;
    }
    for (;;) {
        const bool has_next = S.next(ui + 1, nxt);
        const char* nA = has_next ? (const char*)g.A + (size_t)nxt.pm * tstep : cA; const char* nB = has_next ? (const char*)g.Bt + (size_t)nxt.pn * tstep : cB;
        for (int t = 0; t < nt; t += 2) {
            const bool last = (t == nt - 2);
            const char* a1 = cA + (size_t)(t + 1) * kstep;
            const char* a2 = last ? nA : cA + (size_t)(t + 2) * kstep; const char* b2 = last ? nB : cB + (size_t)(t + 2) * kstep;
            const char* a3 = a2 + kstep; const char* b3 = b2 + kstep;
            if (last && has_next) S.a_ready(nxt);
            if constexpr (SP2) {
            PG8_LDB(B0, 0, 0); PG8_LDB(B1, 0, 1); PG8_SCHED; PG8_LDA(At, 0, 0); PG8_STAGE(PG8_SA(1, 1), a1 + hstep, voffA);
            PG8_WAIT_V(8); PG8_WAIT_L(0); PG8_BAR; PG8_MMA(0, 0, At, B0); PG8_MMA(0, 1, At, B1); PG8_BAR; PG8_SCHED;
            PG8_LDA(At, 0, 1); PG8_STAGE(PG8_SB(0, 0), b2, voffB); PG8_STAGE(PG8_SB(0, 1), b2 + hstep, voffB); PG8_STAGE(PG8_SA(0, 0), a2, voffA);
            PG8_WAIT_V(8); PG8_WAIT_L(0); PG8_BAR; PG8_MMA(1, 0, At, B0); PG8_MMA(1, 1, At, B1); PG8_BAR; PG8_SCHED;
            PG8_LDB(B0, 1, 0); PG8_LDB(B1, 1, 1); PG8_SCHED; PG8_LDA(At, 1, 0); PG8_STAGE(PG8_SA(0, 1), a2 + hstep, voffA);
            PG8_WAIT_V(8); PG8_WAIT_L(0); PG8_BAR; PG8_MMA(0, 0, At, B0); PG8_MMA(0, 1, At, B1); PG8_BAR; PG8_SCHED;
            PG8_LDA(At, 1, 1); PG8_STAGE(PG8_SB(1, 0), b3, voffB); PG8_STAGE(PG8_SB(1, 1), b3 + hstep, voffB); PG8_STAGE(PG8_SA(1, 0), a3, voffA);
            PG8_WAIT_V(8); PG8_WAIT_L(0); PG8_BAR; PG8_MMA(1, 0, At, B0); PG8_MMA(1, 1, At, B1); PG8_BAR; PG8_SCHED;
            } else {
            PG8_LDB(B0, 0, 0); PG8_SCHED; PG8_LDA(At, 0, 0); PG8_STAGE(PG8_SA(1, 1), a1 + hstep, voffA);
            PG8_WAIT_L(8); PG8_BAR; PG8_WAIT_L(0); PG8_MMA(0, 0, At, B0); PG8_BAR; PG8_SCHED;
            PG8_LDB(B1, 0, 1); PG8_STAGE(PG8_SB(0, 0), b2, voffB);
            PG8_BAR; PG8_WAIT_L(0); PG8_MMA(0, 1, At, B1); PG8_BAR;
            PG8_LDA(At, 0, 1); PG8_STAGE(PG8_SA(0, 0), a2, voffA);
            PG8_BAR; PG8_WAIT_L(0); PG8_MMA(1, 0, At, B0); PG8_BAR; PG8_SCHED;
            PG8_STAGE(PG8_SB(0, 1), b2 + hstep, voffB);
            PG8_WAIT_V(6); PG8_BAR; PG8_MMA(1, 1, At, B1); PG8_BAR;
            PG8_LDB(B0, 1, 0); PG8_SCHED; PG8_LDA(At, 1, 0); PG8_STAGE(PG8_SA(0, 1), a2 + hstep, voffA);
            PG8_WAIT_L(8); PG8_BAR; PG8_WAIT_L(0); PG8_MMA(0, 0, At, B0); PG8_BAR; PG8_SCHED;
            PG8_LDB(B1, 1, 1); PG8_STAGE(PG8_SB(1, 0), b3, voffB);
            PG8_BAR; PG8_WAIT_L(0); PG8_MMA(0, 1, At, B1); PG8_BAR;
            PG8_LDA(At, 1, 1); PG8_STAGE(PG8_SA(1, 0), a3, voffA);
            PG8_BAR; PG8_WAIT_L(0); PG8_MMA(1, 0, At, B0); PG8_BAR; PG8_SCHED;
            PG8_STAGE(PG8_SB(1, 1), b3 + hstep, voffB);
            PG8_WAIT_V(6); PG8_BAR; PG8_MMA(1, 1, At, B1); PG8_BAR;
            }
        }
        if constexpr (ALIGN_EPI) { if (wr == 0) PG8_BAR; }
        if constexpr (!Epi::AFTER_DRAIN) { E(acc, cur, wr, wc, fr, fq); S.done(cur); }
        if (!has_next) break;
#pragma unroll
        for (int a = 0; a < 2; ++a)
#pragma unroll
            for (int b = 0; b < 2; ++b)
#pragma unroll
                for (int m = 0; m < 4; ++m)
#pragma unroll
                    for (int n = 0; n < 2; ++n) acc[a][b][m][n] = (f32x4){0.f, 0.f, 0.f, 0.f};
        cur = nxt; cA = nA; cB = nB; ++ui;
        if constexpr (ALIGN_EPI) { if (wr == 1) PG8_BAR; }
    }
    PG8_WAIT_V(0);
    if constexpr (!ALIGN_EPI) { if (wr == 0) PG8_BAR; }
    PG8_BAR;
    if constexpr (Epi::AFTER_DRAIN) { E.fused(acc, cur, wr, wc, fr, fq, lds, wid, lane); S.done(cur); }
#undef PG8_SA
#undef PG8_SB
#undef PG8_STAGE
#undef PG8_LDA
#undef PG8_LDB
#undef PG8_MMA
#undef PG8_WAIT_V
#undef PG8_WAIT_L
#undef PG8_BAR
#undef PG8_SCHED
}
}

constexpr int NWAVES = 8;
constexpr int T = 16384, D = 2048, S = 2048, NBATCH = 8, CH = 64, NCH = 32, NH = 8, HD = 128, DEPTH = 4, NEXP = 16384;
constexpr int TOKC = pg8::TOKC, SWPR = 2048, TOKP = pg8::TOKP, SWPP = pg8::SWPP, QPP = pg8::QPP;
constexpr int TK_QA = 0, TK_KA = 1024, TK_QR = 2048, TK_KR = 3072, TK_GR = 4096;
constexpr int SW_VA = 0, SW_VR = 1024;
constexpr float EPS = 1e-6f, LOG2E = 1.4426950408889634f;
constexpr int PH_PER_LAYER = 8, N_PHASES = 1 + DEPTH * PH_PER_LAYER;

constexpr size_t MiB = 1u << 20;
constexpr size_t WS_CTL = 0, CTL_ZERO_BYTES = 1 * MiB;
constexpr size_t WS_ROPE_TOK = 1 * MiB, WS_ROPE_TR = 2 * MiB, WS_KEYS = 3 * MiB, WS_SSQ = 5 * MiB, WS_EXP = 9 * MiB, WS_GATE = 17 * MiB, WS_SS2 = 25 * MiB;
constexpr size_t WS_WTOK = 32 * MiB, WS_WSWP = 112 * MiB, WS_WOUT = 160 * MiB, WS_WQ = 192 * MiB;
constexpr size_t WS_HN = 224 * MiB, WS_TOK = 288 * MiB, WS_SWP = 456 * MiB, WS_ST = 556 * MiB, WS_MIX = 620 * MiB, WS_XR = 684 * MiB, WS_QP = 812 * MiB, WS_H2 = 884 * MiB;
constexpr size_t WS_UB = 948 * MiB, WS_VB = 1012 * MiB, WS_SU = 1076 * MiB, WS_SV = 1077 * MiB, WS_END = 1078 * MiB;
static_assert(WS_KEYS + (size_t)DEPTH * 16 * 128 * 128 * 2 <= WS_SSQ && WS_SSQ + (size_t)16 * 4 * T * 4 <= WS_EXP && WS_EXP + (size_t)T * 128 * 4 <= WS_GATE && WS_GATE + (size_t)T * 128 * 4 <= WS_SS2 && WS_SS2 + (size_t)32 * T * 4 <= WS_WTOK, "ws map 1");
static_assert(WS_WTOK + (size_t)DEPTH * TOKC * D * 2 <= WS_WSWP && WS_WSWP + (size_t)DEPTH * SWPR * D * 2 <= WS_WOUT && WS_WOUT + (size_t)DEPTH * D * D * 2 <= WS_WQ && WS_WQ + (size_t)DEPTH * D * D * 2 <= WS_HN, "ws map 2");
static_assert(WS_HN + (size_t)T * D * 2 <= WS_TOK && WS_TOK + (size_t)T * TOKP * 2 <= WS_SWP && WS_SWP + (size_t)SWPR * SWPP * 2 <= WS_ST && WS_ST + (size_t)64 * 32 * 128 * 128 * 2 <= WS_MIX, "ws map 3");
static_assert(WS_MIX + (size_t)T * D * 2 <= WS_XR && WS_XR + (size_t)T * D * 2 <= WS_QP && WS_QP + (size_t)T * QPP * 2 <= WS_H2 && WS_H2 + (size_t)T * D * 2 <= WS_UB, "ws map 4");
static_assert(WS_UB + (size_t)DEPTH * NEXP * D / 2 <= WS_VB && WS_VB + (size_t)DEPTH * NEXP * D / 2 <= WS_SU && WS_SU + (size_t)DEPTH * NEXP * 4 <= WS_SV && WS_SV + (size_t)DEPTH * NEXP * 4 <= WS_END, "ws map 5");
constexpr size_t WS_RSTD = WS_SV;
constexpr int CW_BAR = 4096;

constexpr int RING_OFF = 0, RING_BYTES = 131072;
constexpr int LDSCTL_OFF = RING_BYTES, MISC_OFF = LDSCTL_OFF + 320;
constexpr int LDS_BYTES = 147456;

#define GAS __attribute__((address_space(1)))
#define LAS __attribute__((address_space(3)))
typedef unsigned short bf16;
typedef short bf16x8 __attribute__((ext_vector_type(8)));
typedef float f32x4 __attribute__((ext_vector_type(4)));
typedef float f32x2 __attribute__((ext_vector_type(2)));
typedef unsigned u32x4 __attribute__((ext_vector_type(4)));
typedef unsigned u32x2 __attribute__((ext_vector_type(2)));
#define LDS_WAIT() asm volatile("s_waitcnt lgkmcnt(0)" ::: "memory")
__device__ __forceinline__ unsigned f2bf(float f) { unsigned u = __builtin_bit_cast(unsigned, f); return (u + 0x7fffu + ((u >> 16) & 1u)) >> 16; }
__device__ __forceinline__ unsigned pk2(float lo, float hi) { return f2bf(lo) | (f2bf(hi) << 16); }
__device__ __forceinline__ float bf_lo(unsigned w) { return __builtin_bit_cast(float, w << 16); }
__device__ __forceinline__ float bf_hi(unsigned w) { return __builtin_bit_cast(float, w & 0xffff0000u); }
__device__ __forceinline__ bf16x8 ld_b8(const bf16* p) { return *(const GAS bf16x8*)p; }
__device__ __forceinline__ u32x4 ld_u4(const void* p) { return *(const GAS u32x4*)p; }
__device__ __forceinline__ u32x2 ld_u2(const void* p) { return *(const GAS u32x2*)p; }
__device__ __forceinline__ f32x4 ld_f4(const float* p) { return *(const GAS f32x4*)p; }
__device__ __forceinline__ void st_u2(void* p, u32x2 v) { *(GAS u32x2*)p = v; }
__device__ __forceinline__ void st_u4(void* p, u32x4 v) { *(GAS u32x4*)p = v; }
__device__ __forceinline__ void st_f4(float* p, f32x4 v) { *(GAS f32x4*)p = v; }
__device__ __forceinline__ f32x4 mfma16(bf16x8 a, bf16x8 b, f32x4 c) { return __builtin_amdgcn_mfma_f32_16x16x32_bf16(a, b, c, 0, 0, 0); }
__device__ __forceinline__ bf16x8 pack8(f32x4 a, f32x4 b) {
    u32x4 w; w.x = pk2(a[0], a[1]); w.y = pk2(a[2], a[3]); w.z = pk2(b[0], b[1]); w.w = pk2(b[2], b[3]); return __builtin_bit_cast(bf16x8, w);
}
__device__ __forceinline__ float wave_sum(float v) {
#pragma unroll
    for (int o = 1; o < 64; o <<= 1) v += __shfl_xor(v, o);
    return v;
}
__device__ __forceinline__ float rq_sum(float v) { v += __shfl_xor(v, 16); v += __shfl_xor(v, 32); return v; }
__device__ __forceinline__ float rq_max(float v) { v = fmaxf(v, __shfl_xor(v, 16)); v = fmaxf(v, __shfl_xor(v, 32)); return v; }
__device__ __forceinline__ int lane_id() { return (int)__builtin_amdgcn_mbcnt_hi(~0u, __builtin_amdgcn_mbcnt_lo(~0u, 0u)); }
__device__ __forceinline__ float fexp2(float x) { return __builtin_amdgcn_exp2f(x); }
__device__ __forceinline__ float frsq(float x) { return __builtin_amdgcn_rsqf(x); }

#define XB_TMO      128
#define XB_XCNT(j)  (256  + 64 * (j))
#define XB_XSUB(j)  (1280 + 64 * (j))
#define XB_XGEN(j)  (2304 + 64 * (j))
#define XB_TOP      3328
#define XB_TOPGEN   3392
#define XCD_BAR_WORDS 3456
#define XB_SPIN_CAP (1u << 20)
__device__ __forceinline__ unsigned xb_ld(unsigned* p)              { return __hip_atomic_load(p, __ATOMIC_RELAXED, __HIP_MEMORY_SCOPE_AGENT); }
__device__ __forceinline__ unsigned xb_add(unsigned* p, unsigned v) { return __hip_atomic_fetch_add(p, v, __ATOMIC_RELAXED, __HIP_MEMORY_SCOPE_AGENT); }
__device__ __forceinline__ unsigned xb_xcc_id() { return (unsigned)__builtin_amdgcn_s_getreg((3 << 11) | 20) & 0xFu; }
#define XB_SPIN(cond, bar) do { unsigned _sp = 0; while (cond) { __builtin_amdgcn_s_sleep(1); \
    if ((++_sp & 255u) == 0u) { if (xb_ld(&(bar)[XB_TMO])) break; if (_sp > XB_SPIN_CAP) { atomicAdd(&(bar)[XB_TMO], 1u); break; } } } } while (0)
struct XcdBarrier { unsigned* bar; unsigned x; volatile LAS unsigned* st; };
__device__ __forceinline__ XcdBarrier xcd_barrier_post(unsigned* bar, volatile LAS unsigned* st) {
    XcdBarrier b; b.bar = bar; b.x = xb_xcc_id(); b.st = st;
    if (threadIdx.x == 0) (void)xb_add(&bar[XB_XCNT(b.x)], 1u);
    return b;
}
__device__ __forceinline__ void xcd_barrier_complete(unsigned* bar, unsigned x, unsigned& nloc, unsigned& nx) {
    const unsigned G = gridDim.x * gridDim.y * gridDim.z;
    unsigned sum, cnt, mine, sp = 0u;
    for (;;) {
        sum = 0u; cnt = 0u; mine = 0u;
#pragma unroll
        for (unsigned j = 0; j < 16; ++j) { const unsigned c = xb_ld(&bar[XB_XCNT(j)]); sum += c; cnt += (c > 0u) ? 1u : 0u; mine = (j == x) ? c : mine; }
        if (sum == G) break;
        __builtin_amdgcn_s_sleep(1);
        if ((++sp & 255u) == 0u) { if (xb_ld(&bar[XB_TMO])) break; if (sp > XB_SPIN_CAP) { atomicAdd(&bar[XB_TMO], 1u); break; } }
    }
    nloc = mine > 0u ? mine : 1u; nx = cnt > 0u ? cnt : 1u;
}
__device__ __forceinline__ void xcd_barrier(const XcdBarrier& b, int wave) {
    asm volatile("s_waitcnt vmcnt(0)" ::: "memory");
    __syncthreads();
    if (wave == 0 && lane_id() == 0) {
        unsigned* bar = b.bar;
        __builtin_amdgcn_s_waitcnt(0);
        unsigned nloc = b.st[0], nx = b.st[1];
        if (nloc == 0u) { xcd_barrier_complete(bar, b.x, nloc, nx); b.st[0] = nloc; b.st[1] = nx; }
        const unsigned old = xb_add(&bar[XB_XSUB(b.x)], 1u);
        const unsigned gen = old / nloc;
        if (old + 1u == (gen + 1u) * nloc) {
            __builtin_amdgcn_fence(__ATOMIC_RELEASE, "agent");
            asm volatile("s_waitcnt vmcnt(0)" ::: "memory");
            const unsigned og = xb_add(&bar[XB_TOP], 1u);
            const unsigned tg = og / nx;
            if (og + 1u == (tg + 1u) * nx) xb_add(&bar[XB_TOPGEN], 1u);
            else XB_SPIN(xb_ld(&bar[XB_TOPGEN]) == tg, bar);
            __builtin_amdgcn_fence(__ATOMIC_ACQUIRE, "agent");
            xb_add(&bar[XB_XGEN(b.x)], 1u);
            asm volatile("s_waitcnt vmcnt(0)" ::: "memory");
        } else {
            XB_SPIN(xb_ld(&bar[XB_XGEN(b.x)]) == gen, bar);
            __builtin_amdgcn_fence(__ATOMIC_ACQUIRE, "agent");
            asm volatile("s_waitcnt vmcnt(0)" ::: "memory");
        }
    }
    __syncthreads();
}

struct Frame {
    LAS unsigned char* lds;
    int wave, G, gw, ngw;
    const float *x, *norm1_g, *w_in, *qa_g, *ka_g, *rel_bias, *attn_g, *ret_g, *w_out, *norm2_g, *peer_wq, *peer_keys, *peer_u, *peer_v;
    float* out; unsigned char* ws;
};

template <class DstFn>
__device__ __forceinline__ void transpose_item(const float* W, int K, int N, LAS float* scr, int item, int lane, DstFn dst, const float* kscale = nullptr) {
    const int nblk = N / 32, kb = item / nblk, nb = item % nblk, k0 = 64 * kb, n0 = 32 * nb;
#pragma unroll
    for (int i = 0; i < 32; ++i) { const int kk = 2 * i + (lane >> 5); float wv = *(const GAS float*)(W + (size_t)(k0 + kk) * N + n0 + (lane & 31));
        scr[kk * 33 + (lane & 31)] = wv; }
    LDS_WAIT(); asm volatile("" ::: "memory");
    const int c = lane & 7;
    f32x4 ka = (f32x4){1.f, 1.f, 1.f, 1.f}, kb4 = ka;
    if (kscale) { ka = ld_f4(kscale + k0 + 8 * c); kb4 = ld_f4(kscale + k0 + 8 * c + 4); }
#pragma unroll
    for (int j = 0; j < 4; ++j) { const int n = (lane >> 3) + 8 * j; const LAS float* s = scr + (8 * c) * 33 + n;
        u32x4 o; o.x = pk2(s[0 * 33] * ka[0], s[1 * 33] * ka[1]); o.y = pk2(s[2 * 33] * ka[2], s[3 * 33] * ka[3]); o.z = pk2(s[4 * 33] * kb4[0], s[5 * 33] * kb4[1]); o.w = pk2(s[6 * 33] * kb4[2], s[7 * 33] * kb4[3]);
        dst(n0 + n, k0 + 8 * c, o); }
    LDS_WAIT(); asm volatile("" ::: "memory");
}
__device__ __forceinline__ void rms_row_to_bf16(const float* xrow, const float* g, bf16* orow, int lane) {
    asm volatile("" : "+v"(lane));
    f32x4 v[8]; float s = 0.f;
#pragma unroll
    for (int j = 0; j < 8; ++j) { v[j] = ld_f4(xrow + (j * 64 + lane) * 4); s += (v[j][0] * v[j][0] + v[j][1] * v[j][1]) + (v[j][2] * v[j][2] + v[j][3] * v[j][3]); }
    const float rstd = frsq(wave_sum(s) * (1.f / D) + EPS);
#pragma unroll
    for (int j = 0; j < 8; ++j) { const f32x4 gg = ld_f4(g + (j * 64 + lane) * 4);
        u32x2 o; o.x = pk2(v[j][0] * rstd * gg[0], v[j][1] * rstd * gg[1]); o.y = pk2(v[j][2] * rstd * gg[2], v[j][3] * rstd * gg[3]);
        st_u2(orow + (j * 64 + lane) * 4, o); }
}
__device__ __forceinline__ void row_to_fp4(const float* src, unsigned char* dst, size_t slice_stride, unsigned short* scale_out, int lane) {
    f32x4 v[8]; float mx = 0.f;
#pragma unroll
    for (int q = 0; q < 8; ++q) { v[q] = ld_f4(src + lane * 32 + q * 4);
        mx = fmaxf(mx, fmaxf(fmaxf(__builtin_fabsf(v[q][0]), __builtin_fabsf(v[q][1])), fmaxf(__builtin_fabsf(v[q][2]), __builtin_fabsf(v[q][3])))); }
#pragma unroll
    for (int o = 1; o < 64; o <<= 1) mx = fmaxf(mx, __shfl_xor(mx, o));
    const float sc = mx > 0.f ? bf_lo(f2bf(mx * (1.0f / 6.0f)) ) : 1.0f, inv = 1.0f / sc;
    u32x4 o;
#pragma unroll
    for (int d = 0; d < 4; ++d) { const f32x4 a = v[2 * d] * inv, b = v[2 * d + 1] * inv;
        unsigned w = 0u;
        w = __builtin_amdgcn_cvt_scalef32_pk_fp4_f32(w, a[0], a[1], 1.0f, 0); w = __builtin_amdgcn_cvt_scalef32_pk_fp4_f32(w, a[2], a[3], 1.0f, 1);
        w = __builtin_amdgcn_cvt_scalef32_pk_fp4_f32(w, b[0], b[1], 1.0f, 2); w = __builtin_amdgcn_cvt_scalef32_pk_fp4_f32(w, b[2], b[3], 1.0f, 3);
        o[d] = w; }
    st_u4(dst + (size_t)(lane >> 3) * slice_stride + (lane & 7) * 16, o);
    if (lane == 0) *(GAS unsigned short*)scale_out = (unsigned short)f2bf(sc);
}
__device__ __forceinline__ void p0_prologue(const Frame& F) {
    LAS float* scr = (LAS float*)(F.lds + RING_OFF + F.wave * 16384);
    int lane = lane_id(); asm volatile("" : "+v"(lane));
    bf16* Wtok = (bf16*)(F.ws + WS_WTOK); bf16* Wswp = (bf16*)(F.ws + WS_WSWP); bf16* Wout = (bf16*)(F.ws + WS_WOUT); bf16* Wq = (bf16*)(F.ws + WS_WQ);
    constexpr int IN_COLS = 7168;
    constexpr int I_IN = (D / 64) * (IN_COLS / 32), I_SQ = (D / 64) * (D / 32), I_L = I_IN + 2 * I_SQ, NITEMS = DEPTH * I_L;
    for (int it = F.gw; it < NITEMS; it += F.ngw) {
        const int l = it / I_L; int r = it % I_L;
        if (r < I_IN) {
            bf16* wt = Wtok + (size_t)l * TOKC * D; bf16* wsw = Wswp + (size_t)l * SWPR * D;
            transpose_item(F.w_in + (size_t)l * D * IN_COLS, D, IN_COLS, scr, r, lane, [=](int n, int k, u32x4 o) {
                const int seg = n >> 10, nn = n & 1023, dd = n & 127, dp = (n & 896) + 2 * (dd & 63) + (dd >> 6);
                if (seg == 0) st_u4(wt + (size_t)(TK_QA + nn) * D + k, o);
                else if (seg == 1) st_u4(wt + (size_t)(TK_KA + nn) * D + k, o);
                else if (seg == 2) st_u4(wsw + (size_t)(SW_VA + nn) * D + k, o);
                else if (seg == 3) st_u4(wt + (size_t)(TK_QR + dp) * D + k, o);
                else if (seg == 4) st_u4(wt + (size_t)(TK_KR + dp) * D + k, o);
                else if (seg == 5) st_u4(wsw + (size_t)(SW_VR + nn) * D + k, o);
                else st_u4(wt + (size_t)(TK_GR + nn) * D + k, o);
            }, F.norm1_g + l * D);
            continue;
        }
        r -= I_IN;
        if (r < I_SQ) { bf16* wo = Wout + (size_t)l * D * D;
            transpose_item(F.w_out + (size_t)l * D * D, D, D, scr, r, lane, [=](int n, int k, u32x4 o) { st_u4(wo + (size_t)n * D + k, o); }); continue; }
        r -= I_SQ;
        { bf16* wq = Wq + (size_t)l * D * D;
            transpose_item(F.peer_wq + (size_t)l * D * D, D, D, scr, r, lane, [=](int n, int k, u32x4 o) { st_u4(wq + (size_t)n * D + k, o); }, F.norm2_g + l * D); }
    }
    {
        bf16* XR0 = (bf16*)(F.ws + WS_XR); float* RSTD = (float*)(F.ws + WS_RSTD);
        for (int m = F.gw; m < T; m += F.ngw) {
            const float* xrow = F.x + (size_t)m * D;
            f32x4 v[8]; float s = 0.f;
#pragma unroll
            for (int j = 0; j < 8; ++j) { v[j] = ld_f4(xrow + (j * 64 + lane) * 4); s += (v[j][0] * v[j][0] + v[j][1] * v[j][1]) + (v[j][2] * v[j][2] + v[j][3] * v[j][3]); }
            const float rstd = frsq(wave_sum(s) * (1.f / D) + EPS);
#pragma unroll
            for (int j = 0; j < 8; ++j) { u32x2 o; o.x = pk2(v[j][0], v[j][1]); o.y = pk2(v[j][2], v[j][3]); st_u2(XR0 + (size_t)m * D + (j * 64 + lane) * 4, o); }
            if (lane == 0) *(GAS float*)(RSTD + m) = rstd;
        }
    }
    {
        unsigned char* UB = (unsigned char*)(F.ws + WS_UB); unsigned char* VB = (unsigned char*)(F.ws + WS_VB);
        unsigned short* SUV = (unsigned short*)(F.ws + WS_SU);
        const int nrows = DEPTH * NEXP;
        for (int r = F.gw; r < 2 * nrows; r += F.ngw) {
            const bool isv = r >= nrows; const int rr = isv ? r - nrows : r;
            row_to_fp4((isv ? F.peer_v : F.peer_u) + (size_t)rr * D, (isv ? VB : UB) + (size_t)(rr / NEXP) * NEXP * (D / 2) + (size_t)(rr % NEXP) * 128, (size_t)NEXP * 128, SUV + 2 * (size_t)rr + (isv ? 1 : 0), lane);
        }
        const size_t nK = (size_t)DEPTH * 16 * 128 * 128 / 8;
        bf16* KB = (bf16*)(F.ws + WS_KEYS);
        const size_t stride = (size_t)F.ngw * 64, start = (size_t)F.gw * 64 + lane;
        for (size_t i = start; i < nK; i += stride) {
            const f32x4 a = ld_f4(F.peer_keys + i * 8), b = ld_f4(F.peer_keys + i * 8 + 4);
            u32x4 o; o.x = pk2(a[0], a[1]); o.y = pk2(a[2], a[3]); o.z = pk2(b[0], b[1]); o.w = pk2(b[2], b[3]); st_u4(KB + i * 8, o);
        }
    }
    {
        f32x2* ct = (f32x2*)(F.ws + WS_ROPE_TOK);
        for (int e = F.gw * 64 + lane; e < S * 64; e += F.ngw * 64) {
            const int pos = e >> 6, i = e & 63;
            const float invf = exp2f(-(float)i * 0.20762050593046014f);
            const double rev = (double)pos * (double)invf * 0.15915494309189535;
            const float fr = (float)(rev - __builtin_floor(rev));
            const f32x2 v = {__builtin_amdgcn_cosf(fr), __builtin_amdgcn_sinf(fr)};
            ct[(size_t)pos * 64 + i] = v;
        }
    }
}

constexpr int A_KP = 272, A_VP = 144;
constexpr int A_KBUF = 0, A_VBUF = A_KBUF + 2 * 64 * A_KP, A_RK = A_VBUF + 2 * 128 * A_VP, A_BIAS = A_RK + 2 * 64 * 4, A_END = A_BIAS + NH * 257 * 4;
static_assert(A_END <= RING_BYTES, "attention LDS map");
__device__ __forceinline__ void attn_wg_task(const Frame& F, int l, int task) {
    int tid = F.wave * 64 + lane_id(); asm volatile("" : "+v"(tid));
    const int lane = tid & 63, c = lane & 15, rq = lane >> 4, wave = F.wave;
    const int cq = task & 7, h = (task >> 3) & 7, b = task >> 6;
    const bf16* TOK = (const bf16*)(F.ws + WS_TOK); const bf16* SWP = (const bf16*)(F.ws + WS_SWP); const float* SSQ = (const float*)(F.ws + WS_SSQ);
    bf16* MIX = (bf16*)(F.ws + WS_MIX);
    LAS unsigned char* lds = F.lds + RING_OFF;
    const LAS float* bh = (const LAS float*)(lds + A_BIAS) + h * 257;
    const int wch = wave >> 1;
    const int qi0 = (wave & 1) * 32 + c;
    const int tq0 = b * S + (4 * cq + wch) * CH + qi0;
    bf16x8 Qf[2][4];
#pragma unroll
    for (int qb = 0; qb < 2; ++qb) {
        const int tq = tq0 + qb * 16;
        float ssq = 0.f;
#pragma unroll
        for (int w = 0; w < 4; ++w) ssq += *(const GAS float*)(SSQ + (size_t)((0 * 8 + h) * 4 + w) * T + tq);
        const float rs = frsq(ssq * (1.f / HD) + EPS) * (pg8::KSCALE * LOG2E);
#pragma unroll
        for (int ks = 0; ks < 4; ++ks) {
            const float* gp = F.qa_g + l * HD + ks * 32 + rq * 8; const float* kp = F.ka_g + l * HD + ks * 32 + rq * 8;
            const f32x4 a0 = ld_f4(gp), a1 = ld_f4(gp + 4), b0 = ld_f4(kp), b1 = ld_f4(kp + 4);
            const u32x4 raw = ld_u4(TOK + (size_t)tq * TOKP + TK_QA + h * HD + ks * 32 + rq * 8);
            u32x4 o;
            o.x = pk2(bf_lo(raw.x) * rs * (a0[0] * b0[0]), bf_hi(raw.x) * rs * (a0[1] * b0[1])); o.y = pk2(bf_lo(raw.y) * rs * (a0[2] * b0[2]), bf_hi(raw.y) * rs * (a0[3] * b0[3]));
            o.z = pk2(bf_lo(raw.z) * rs * (a1[0] * b1[0]), bf_hi(raw.z) * rs * (a1[1] * b1[1])); o.w = pk2(bf_lo(raw.w) * rs * (a1[2] * b1[2]), bf_hi(raw.w) * rs * (a1[3] * b1[3]));
            Qf[qb][ks] = __builtin_bit_cast(bf16x8, o);
        }
    }
    float m_run[2] = {-1e30f, -1e30f}, l_run[2] = {0.f, 0.f};
    f32x4 O[2][8];
#pragma unroll
    for (int qb = 0; qb < 2; ++qb)
#pragma unroll
        for (int db = 0; db < 8; ++db) O[qb][db] = (f32x4){0.f, 0.f, 0.f, 0.f};
    const int p0 = tid, p1 = tid + 512;
    const int kr0 = p0 >> 4, kr1 = p1 >> 4;
    const int kl0 = (kr0 & 32) + ((kr0 >> 2) & 1) * 16 + ((kr0 >> 3) & 3) * 4 + (kr0 & 3), kl1 = (kr1 & 32) + ((kr1 >> 2) & 1) * 16 + ((kr1 >> 3) & 3) * 4 + (kr1 & 3);
    const bf16* gk0 = TOK + (size_t)(b * S + kr0) * TOKP + TK_KA + h * HD + (p0 & 15) * 8; const bf16* gk1 = TOK + (size_t)(b * S + kr1) * TOKP + TK_KA + h * HD + (p1 & 15) * 8;
    const bf16* gv0 = SWP + (size_t)(SW_VA + h * HD + (p0 >> 3)) * SWPP + b * S + (p0 & 7) * 8; const bf16* gv1 = SWP + (size_t)(SW_VA + h * HD + (p1 >> 3)) * SWPP + b * S + (p1 & 7) * 8;
    const int lk0 = A_KBUF + kl0 * A_KP + (p0 & 15) * 16, lk1 = A_KBUF + kl1 * A_KP + (p1 & 15) * 16;
    const int lv0 = A_VBUF + (p0 >> 3) * A_VP + (p0 & 7) * 16, lv1 = A_VBUF + (p1 >> 3) * A_VP + (p1 & 7) * 16;
    const float* gss = SSQ + (size_t)((8 + h) * 4) * T + b * S + (tid & 63);
    u32x4 r0, r1, r2, r3; float rkv = 0.f;
    const int kc0 = 4 * cq - 8, j0 = kc0 < 0 ? -kc0 : 0;
#define A_GLOAD(j) do { const int ko = (kc0 + (j)) * CH; r0 = ld_u4(gk0 + (size_t)ko * TOKP); r1 = ld_u4(gk1 + (size_t)ko * TOKP); r2 = ld_u4(gv0 + ko); r3 = ld_u4(gv1 + ko); \
        if (tid < 64) { float s_ = 0.f; _Pragma("unroll") for (int w = 0; w < 4; ++w) s_ += *(const GAS float*)(gss + (size_t)w * T + ko); rkv = frsq(s_ * (1.f / HD) + EPS); } } while (0)
#define A_LSTORE(bf) do { *(LAS u32x4*)(lds + lk0 + (bf) * 64 * A_KP) = r0; *(LAS u32x4*)(lds + lk1 + (bf) * 64 * A_KP) = r1; *(LAS u32x4*)(lds + lv0 + (bf) * 128 * A_VP) = r2; *(LAS u32x4*)(lds + lv1 + (bf) * 128 * A_VP) = r3; \
        if (tid < 64) ((LAS float*)(lds + A_RK))[(bf) * 64 + tid] = rkv; } while (0)
    __syncthreads();
    A_GLOAD(j0); A_LSTORE(j0 & 1);
    __syncthreads();
    for (int j = j0; j < 12; ++j) {
        if (j < 11) A_GLOAD(j + 1);
        const int tjr = j - wch;
        if (tjr >= 0 && tjr <= 8) {
            const LAS unsigned char* kb = lds + A_KBUF + (j & 1) * 64 * A_KP + c * A_KP + rq * 16;
            const LAS unsigned char* vb = lds + A_VBUF + (j & 1) * 128 * A_VP + c * A_VP + rq * 16;
            const LAS float* rkb = (const LAS float*)(lds + A_RK) + (j & 1) * 64;
            f32x4 sa[2][2][2];
#pragma unroll
            for (int g = 0; g < 2; ++g)
#pragma unroll
                for (int ab = 0; ab < 2; ++ab) { f32x4 a0 = (f32x4){0.f, 0.f, 0.f, 0.f}, a1 = (f32x4){0.f, 0.f, 0.f, 0.f};
#pragma unroll
                    for (int ks = 0; ks < 4; ++ks) { const bf16x8 kf = *(const LAS bf16x8*)(kb + (32 * g + 16 * ab) * A_KP + ks * 64); a0 = mfma16(kf, Qf[0][ks], a0); a1 = mfma16(kf, Qf[1][ks], a1); }
                    sa[0][g][ab] = a0; sa[1][g][ab] = a1; }
            const int relbase = 64 * (8 - tjr);
            float mx[2] = {-1e30f, -1e30f};
            if (tjr <= 5) {
                const float bc = bh[256];
#pragma unroll
                for (int g = 0; g < 2; ++g)
#pragma unroll
                    for (int ab = 0; ab < 2; ++ab) {
                        const f32x4 rk = *(const LAS f32x4*)(rkb + 32 * g + 8 * rq + 4 * ab);
#pragma unroll
                        for (int qb = 0; qb < 2; ++qb)
#pragma unroll
                            for (int e = 0; e < 4; ++e) { const float sv = sa[qb][g][ab][e] * rk[e] + bc; sa[qb][g][ab][e] = sv; mx[qb] = fmaxf(mx[qb], sv); }
                    }
            } else {
#pragma unroll
                for (int g = 0; g < 2; ++g)
#pragma unroll
                    for (int ab = 0; ab < 2; ++ab) {
                        const int kk0 = 32 * g + 8 * rq + 4 * ab;
                        const f32x4 rk = *(const LAS f32x4*)(rkb + kk0);
#pragma unroll
                        for (int qb = 0; qb < 2; ++qb)
#pragma unroll
                            for (int e = 0; e < 4; ++e) {
                                int rel = qi0 + qb * 16 - (kk0 + e) + relbase; rel = rel > 128 ? 128 : (rel < -128 ? -128 : rel);
                                const float sv = sa[qb][g][ab][e] * rk[e] + bh[rel + 128];
                                sa[qb][g][ab][e] = sv; mx[qb] = fmaxf(mx[qb], sv);
                            }
                    }
            }
            bf16x8 Pf[2][2];
            bool moved = false;
            float alpha[2];
#pragma unroll
            for (int qb = 0; qb < 2; ++qb) {
                const float mxr = rq_max(mx[qb]);
                const float mn = fmaxf(m_run[qb], mxr); alpha[qb] = fexp2(m_run[qb] - mn);
                moved = moved || (mn > m_run[qb]);
                float ps = 0.f;
#pragma unroll
                for (int g = 0; g < 2; ++g) {
#pragma unroll
                    for (int ab = 0; ab < 2; ++ab)
#pragma unroll
                        for (int e = 0; e < 4; ++e) { const float p = fexp2(sa[qb][g][ab][e] - mn); sa[qb][g][ab][e] = p; ps += p; }
                    Pf[qb][g] = pack8(sa[qb][g][0], sa[qb][g][1]);
                }
                l_run[qb] = l_run[qb] * alpha[qb] + ps; m_run[qb] = mn;
            }
            if (__any(moved)) {
#pragma unroll
                for (int qb = 0; qb < 2; ++qb)
#pragma unroll
                    for (int db = 0; db < 8; ++db) O[qb][db] *= alpha[qb];
            }
#pragma unroll
            for (int g = 0; g < 2; ++g)
#pragma unroll
                for (int db = 0; db < 8; ++db) { const bf16x8 vf = *(const LAS bf16x8*)(vb + db * 16 * A_VP + g * 64); O[0][db] = mfma16(vf, Pf[0][g], O[0][db]); O[1][db] = mfma16(vf, Pf[1][g], O[1][db]); }
        }
        if (j < 11) A_LSTORE((j + 1) & 1);
        __syncthreads();
    }
#undef A_GLOAD
#undef A_LSTORE
#pragma unroll
    for (int qb = 0; qb < 2; ++qb) {
        const int tq = tq0 + qb * 16;
        const float inv = 1.0f / rq_sum(l_run[qb]);
        float ss = 0.f;
#pragma unroll
        for (int db = 0; db < 8; ++db) { O[qb][db] *= inv; ss += (O[qb][db][0] * O[qb][db][0] + O[qb][db][1] * O[qb][db][1]) + (O[qb][db][2] * O[qb][db][2] + O[qb][db][3] * O[qb][db][3]); }
        const float rstd = frsq(rq_sum(ss) * (1.f / HD) + EPS);
#pragma unroll
        for (int db = 0; db < 8; ++db) {
            const int d0 = h * HD + db * 16 + rq * 4;
            const f32x4 g4 = ld_f4(F.attn_g + l * 1024 + d0);
            u32x2 o; o.x = pk2(O[qb][db][0] * rstd * g4[0], O[qb][db][1] * rstd * g4[1]); o.y = pk2(O[qb][db][2] * rstd * g4[2], O[qb][db][3] * rstd * g4[3]);
            st_u2(MIX + (size_t)tq * D + d0, o);
        }
    }
}

constexpr int SC_PITCH = 36, SC_WAVE_BYTES = 64 * SC_PITCH, SC_OFF = A_END;
static_assert(SC_OFF % 4 == 0 && SC_OFF + NWAVES * SC_WAVE_BYTES <= RING_BYTES, "scan LDS map");
struct ScanOps { u32x4 kp[2]; bf16x8 va[4][2]; };
__device__ __forceinline__ void scan_load(ScanOps& o, const bf16* kg, const bf16* vrow, int n) {
#pragma unroll
    for (int i = 0; i < 2; ++i) o.kp[i] = ld_u4(kg + (size_t)(n * CH + i * 32) * TOKP);
#pragma unroll
    for (int eb = 0; eb < 4; ++eb)
#pragma unroll
        for (int ks = 0; ks < 2; ++ks) o.va[eb][ks] = ld_b8(vrow + (size_t)eb * 16 * SWPP + n * CH + ks * 32);
}
__device__ __forceinline__ void scan_step(f32x4 (&st)[4], const ScanOps& o, const float (&dec)[16], LAS unsigned char* kw, const LAS unsigned char* kr, bf16* sp, int n, float cd) {
#pragma unroll
    for (int eb = 0; eb < 4; ++eb) { u32x2 w; w.x = pk2(st[eb][0], st[eb][1]); w.y = pk2(st[eb][2], st[eb][3]); st_u2(sp + (size_t)n * HD * HD + eb * 16 * HD, w); }
#pragma unroll
    for (int i = 0; i < 2; ++i)
#pragma unroll
        for (int d = 0; d < 4; ++d) *(LAS unsigned*)(kw + i * 32 * SC_PITCH + d * 4) = o.kp[i][d];
    LDS_WAIT(); asm volatile("" ::: "memory");
    bf16x8 ka[2];
#pragma unroll
    for (int ks = 0; ks < 2; ++ks) { u32x4 w;
#pragma unroll
        for (int j = 0; j < 4; ++j) { const unsigned e0 = *(const LAS unsigned short*)(kr + (ks * 32 + 2 * j) * SC_PITCH), e1 = *(const LAS unsigned short*)(kr + (ks * 32 + 2 * j + 1) * SC_PITCH);
            w[j] = pk2(bf_lo(e0) * dec[ks * 8 + 2 * j], bf_lo(e1) * dec[ks * 8 + 2 * j + 1]); }
        ka[ks] = __builtin_bit_cast(bf16x8, w); }
    LDS_WAIT(); asm volatile("" ::: "memory");
#pragma unroll
    for (int eb = 0; eb < 4; ++eb) { st[eb] *= cd;
#pragma unroll
        for (int ks = 0; ks < 2; ++ks) st[eb] = mfma16(ka[ks], o.va[eb][ks], st[eb]); }
}
__device__ __forceinline__ void scan_task(const Frame& F, int task) {
    int lane = lane_id(); asm volatile("" : "+v"(lane));
    const int c = lane & 15, rq = lane >> 4;
    const int eh = task & 1, db = (task >> 1) & 7, h = (task >> 4) & 7, b = task >> 7, bhh = b * NH + h;
    const bf16* TOK = (const bf16*)(F.ws + WS_TOK); const bf16* SWP = (const bf16*)(F.ws + WS_SWP); bf16* ST = (bf16*)(F.ws + WS_ST);
    const bf16* kg = TOK + (size_t)(b * S + (lane >> 1)) * TOKP + TK_KR + h * HD + db * 16 + (lane & 1) * 8;
    const bf16* vrow = SWP + (size_t)(SW_VR + h * HD + eh * 64 + c) * SWPP + b * S + rq * 8;
    bf16* sp = ST + ((size_t)bhh * NCH * HD + eh * 64 + c) * HD + db * 16 + rq * 4;
    LAS unsigned char* kt = F.lds + RING_OFF + SC_OFF + F.wave * SC_WAVE_BYTES;
    LAS unsigned char* kw = kt + (lane >> 1) * SC_PITCH + (lane & 1) * 16;
    const LAS unsigned char* kr = kt + (rq * 8) * SC_PITCH + c * 2;
    f32x4 st[4];
#pragma unroll
    for (int eb = 0; eb < 4; ++eb) st[eb] = (f32x4){0.f, 0.f, 0.f, 0.f};
    const float lg = pg8::lg2gamma(h), cd = fexp2(64.f * lg);
    float dec[16];
#pragma unroll
    for (int i = 0; i < 16; ++i) dec[i] = fexp2((float)(63 - ((i >> 3) * 32 + rq * 8 + (i & 7))) * lg);
    ScanOps o0, o1, o2;
    scan_load(o0, kg, vrow, 0); scan_load(o1, kg, vrow, 1);
    for (int n = 0; n < NCH - 1; n += 3) {
        if (n + 2 < NCH - 1) scan_load(o2, kg, vrow, n + 2);
        scan_step(st, o0, dec, kw, kr, sp, n, cd);
        if (n + 1 < NCH - 1) { if (n + 3 < NCH - 1) scan_load(o0, kg, vrow, n + 3); scan_step(st, o1, dec, kw, kr, sp, n + 1, cd); }
        if (n + 2 < NCH - 1) { if (n + 4 < NCH - 1) scan_load(o1, kg, vrow, n + 4); scan_step(st, o2, dec, kw, kr, sp, n + 2, cd); }
    }
#pragma unroll
    for (int eb = 0; eb < 4; ++eb) { u32x2 w; w.x = pk2(st[eb][0], st[eb][1]); w.y = pk2(st[eb][2], st[eb][3]); st_u2(sp + (size_t)(NCH - 1) * HD * HD + eb * 16 * HD, w); }
}

__device__ __forceinline__ void ret_task(const Frame& F, int l, int task) {
    int lane = lane_id(); asm volatile("" : "+v"(lane));
    const int c = lane & 15, rq = lane >> 4;
    const int qb2 = task & 1, n = (task >> 1) & 31, h = (task >> 6) & 7, b = task >> 9, bhh = b * NH + h;
    const bf16* TOK = (const bf16*)(F.ws + WS_TOK); const bf16* SWP = (const bf16*)(F.ws + WS_SWP); const bf16* ST = (const bf16*)(F.ws + WS_ST);
    bf16* MIX = (bf16*)(F.ws + WS_MIX);
    const int tc0 = b * S + n * CH, tq0 = tc0 + qb2 * 32;
    const float lg = pg8::lg2gamma(h);
    bf16x8 Qf[2][4], Kf[2][2][4];
#pragma unroll
    for (int qb = 0; qb < 2; ++qb)
#pragma unroll
        for (int ks = 0; ks < 4; ++ks) Qf[qb][ks] = ld_b8(TOK + (size_t)(tq0 + qb * 16 + c) * TOKP + TK_QR + h * HD + ks * 32 + rq * 8);
#pragma unroll
    for (int g = 0; g < 2; ++g)
#pragma unroll
        for (int ab = 0; ab < 2; ++ab) { const int key = 32 * g + (c >> 2) * 8 + 4 * ab + (c & 3);
#pragma unroll
            for (int ks = 0; ks < 4; ++ks) Kf[g][ab][ks] = ld_b8(TOK + (size_t)(tc0 + key) * TOKP + TK_KR + h * HD + rq * 8 + ks * 32); }
    f32x4 acc[2][8];
#pragma unroll
    for (int qb = 0; qb < 2; ++qb)
#pragma unroll
        for (int eb = 0; eb < 8; ++eb) acc[qb][eb] = (f32x4){0.f, 0.f, 0.f, 0.f};
    const bf16* sp = ST + (((size_t)bhh * NCH + n) * HD + c) * HD + rq * 8;
#pragma unroll
    for (int eb = 0; eb < 8; ++eb)
#pragma unroll
        for (int ks = 0; ks < 4; ++ks) { const bf16x8 sf = ld_b8(sp + eb * 16 * HD + ks * 32);
#pragma unroll
            for (int qb = 0; qb < 2; ++qb) acc[qb][eb] = mfma16(sf, Qf[qb][ks], acc[qb][eb]); }
    bf16x8 Vf[8];
#pragma unroll
    for (int eb = 0; eb < 8; ++eb) Vf[eb] = ld_b8(SWP + (size_t)(SW_VR + h * HD + eb * 16 + c) * SWPP + tc0 + 8 * rq);
#pragma unroll
    for (int qb = 0; qb < 2; ++qb) { const float f = fexp2((float)(qb2 * 32 + qb * 16 + c + 1) * lg);
#pragma unroll
        for (int eb = 0; eb < 8; ++eb) acc[qb][eb] *= f; }
    f32x4 g4[8]; u32x2 gwq[2][8];
#pragma unroll
    for (int g = 0; g < 2; ++g) {
        if (g <= qb2) {
            f32x4 sa[2][2];
#pragma unroll
            for (int qb = 0; qb < 2; ++qb)
#pragma unroll
                for (int ab = 0; ab < 2; ++ab) sa[qb][ab] = (f32x4){0.f, 0.f, 0.f, 0.f};
#pragma unroll
            for (int ab = 0; ab < 2; ++ab)
#pragma unroll
                for (int ks = 0; ks < 4; ++ks)
#pragma unroll
                    for (int qb = 0; qb < 2; ++qb) sa[qb][ab] = mfma16(Kf[g][ab][ks], Qf[qb][ks], sa[qb][ab]);
            bf16x8 Pf[2];
#pragma unroll
            for (int qb = 0; qb < 2; ++qb) {
                const int i = qb2 * 32 + qb * 16 + c;
#pragma unroll
                for (int ab = 0; ab < 2; ++ab)
#pragma unroll
                    for (int e = 0; e < 4; ++e) { const int diff = i - (32 * g + 8 * rq + 4 * ab + e);
                        sa[qb][ab][e] = diff >= 0 ? sa[qb][ab][e] * fexp2((float)diff * lg) : 0.f; }
                Pf[qb] = pack8(sa[qb][0], sa[qb][1]);
            }
#pragma unroll
            for (int eb = 0; eb < 8; ++eb)
#pragma unroll
                for (int qb = 0; qb < 2; ++qb) acc[qb][eb] = mfma16(Vf[eb], Pf[qb], acc[qb][eb]);
        }
        if (g == 0) {
            if (qb2) {
#pragma unroll
                for (int eb = 0; eb < 8; ++eb) Vf[eb] = ld_b8(SWP + (size_t)(SW_VR + h * HD + eb * 16 + c) * SWPP + tc0 + 32 + 8 * rq);
            }
#pragma unroll
            for (int eb = 0; eb < 8; ++eb) { const int e0 = h * HD + eb * 16 + rq * 4; g4[eb] = ld_f4(F.ret_g + l * 1024 + e0);
#pragma unroll
                for (int qb = 0; qb < 2; ++qb) gwq[qb][eb] = ld_u2(TOK + (size_t)(tq0 + qb * 16 + c) * TOKP + TK_GR + e0); }
        }
    }
#pragma unroll
    for (int qb = 0; qb < 2; ++qb) {
        const int t = tq0 + qb * 16 + c;
        float ss = 0.f;
#pragma unroll
        for (int eb = 0; eb < 8; ++eb) ss += (acc[qb][eb][0] * acc[qb][eb][0] + acc[qb][eb][1] * acc[qb][eb][1]) + (acc[qb][eb][2] * acc[qb][eb][2] + acc[qb][eb][3] * acc[qb][eb][3]);
        const float rstd = frsq(rq_sum(ss) * (1.f / HD) + EPS);
#pragma unroll
        for (int eb = 0; eb < 8; ++eb) {
            const int e0 = h * HD + eb * 16 + rq * 4;
            const f32x4 gg = g4[eb]; const u32x2 gw = gwq[qb][eb];
            u32x2 o; o.x = pk2(acc[qb][eb][0] * rstd * gg[0] * bf_lo(gw.x), acc[qb][eb][1] * rstd * gg[1] * bf_hi(gw.x));
            o.y = pk2(acc[qb][eb][2] * rstd * gg[2] * bf_lo(gw.y), acc[qb][eb][3] * rstd * gg[3] * bf_hi(gw.y));
            st_u2(MIX + (size_t)t * D + 1024 + e0, o);
        }
    }
}

__device__ __constant__ unsigned char kCandAB[64] = {0, 1, 2, 3, 4, 5, 6, 7, 8, 9, 10, 11, 12, 13, 14, 15, 16, 17, 18, 19, 20, 21, 22, 23, 32, 33, 34, 35, 36, 48, 49, 50, 51, 64, 65, 66, 80, 81, 96, 97,
                                                   112, 113, 128, 144, 160, 176, 192, 208, 224, 240, 0, 0, 0, 0, 0, 0, 0, 0, 0, 0, 0, 0, 0, 0};
template <unsigned MASK> __device__ __forceinline__ float embed_idx(float x, unsigned idx) {
    const unsigned u = __builtin_bit_cast(unsigned, x); const unsigned low = (u >> 31) ? idx : (MASK - idx);
    return __builtin_bit_cast(float, (u & ~MASK) | low);
}
template <unsigned MASK> __device__ __forceinline__ unsigned decode_idx(float y) {
    const unsigned u = __builtin_bit_cast(unsigned, y); const unsigned low = u & MASK; return (u >> 31) ? low : (MASK - low);
}
template <int N> __device__ __forceinline__ void sortdesc(float (&v)[N]) {
#pragma unroll
    for (int k = 2; k <= N; k <<= 1)
#pragma unroll
        for (int j = k >> 1; j > 0; j >>= 1)
#pragma unroll
            for (int i = 0; i < N; ++i) { const int p = i ^ j;
                if (p > i) { const bool desc = ((i & k) == 0); const float a = v[i], b = v[p], hi = fmaxf(a, b), lo = fminf(a, b); v[i] = desc ? hi : lo; v[p] = desc ? lo : hi; } }
}
__device__ __forceinline__ void merge16(float (&v)[16]) {
#pragma unroll
    for (int j = 8; j > 0; j >>= 1)
#pragma unroll
        for (int i = 0; i < 16; ++i) { const int p = i ^ j; if (p > i) { const float a = v[i], b = v[p]; v[i] = fmaxf(a, b); v[p] = fminf(a, b); } }
}
__device__ __forceinline__ void top16_of_group(float (&a)[16]) {
#pragma unroll
    for (int sh = 16; sh <= 32; sh <<= 1) {
        float cc[16];
#pragma unroll
        for (int i = 0; i < 16; ++i) cc[i] = fmaxf(a[i], __shfl_xor(a[15 - i], sh));
        merge16(cc);
#pragma unroll
        for (int i = 0; i < 16; ++i) a[i] = cc[i];
    }
}
constexpr int TL_STRIDE = 17, TL_WAVE_FLOATS = 2 * 16 * TL_STRIDE;
constexpr int KL_PITCH = 272, KL_BYTES = 2 * 128 * KL_PITCH;
static_assert(KL_BYTES + NWAVES * TL_WAVE_FLOATS * 4 <= RING_BYTES, "top-k LDS map");
__device__ __forceinline__ void topk_task(const Frame& F, int l, int tb, int h, const LAS unsigned char* kl, LAS float* tl, const LAS unsigned char* cab) {
    int lane = lane_id(); asm volatile("" : "+v"(lane));
    const int c = lane & 15, rq = lane >> 4;
    const int t0 = tb * 16;
    const bf16* QP = (const bf16*)(F.ws + WS_QP);
    int* EXPI = (int*)(F.ws + WS_EXP); float* GATE = (float*)(F.ws + WS_GATE);
    const float NEG = -__builtin_inff();
    bf16x8 Qall[2][4];
#pragma unroll
    for (int p = 0; p < 2; ++p)
#pragma unroll
        for (int ks = 0; ks < 4; ++ks) Qall[p][ks] = ld_b8(QP + (size_t)(t0 + c) * QPP + h * 256 + p * 128 + ks * 32 + rq * 8);
    float rsp[8];
    { const float* SS2 = (const float*)(F.ws + WS_SS2) + (t0 + c);
#pragma unroll
        for (int i = 0; i < 8; ++i) rsp[i] = *(const GAS float*)(SS2 + (size_t)(rq * 8 + i) * T); }
#pragma unroll
    for (int p = 0; p < 2; ++p) {
        bf16x8 Qf[4];
#pragma unroll
        for (int ks = 0; ks < 4; ++ks) Qf[ks] = Qall[p][ks];
        float v[32];
        const LAS unsigned char* kbase = kl + (p * 128 + c) * KL_PITCH + rq * 16;
#pragma unroll
        for (int kb = 0; kb < 8; ++kb) {
            f32x4 a = (f32x4){0.f, 0.f, 0.f, 0.f};
#pragma unroll
            for (int ks = 0; ks < 4; ++ks) a = mfma16(*(const LAS bf16x8*)(kbase + kb * 16 * KL_PITCH + ks * 64), Qf[ks], a);
#pragma unroll
            for (int e = 0; e < 4; ++e) v[kb * 4 + e] = embed_idx<127u>(a[e], (unsigned)(kb * 16 + rq * 4 + e));
        }
        sortdesc<32>(v);
        float top[16];
#pragma unroll
        for (int i = 0; i < 16; ++i) top[i] = v[i];
        top16_of_group(top);
        if (rq == 0) {
#pragma unroll
            for (int it = 0; it < 16; ++it) tl[(p * 16 + c) * TL_STRIDE + it] = top[it];
        }
    }
    LDS_WAIT(); asm volatile("" ::: "memory");
    const LAS float* t0l = tl + (0 * 16 + c) * TL_STRIDE; const LAS float* t1l = tl + (16 + c) * TL_STRIDE;
    float res[16];
#pragma unroll
    for (int j = 0; j < 16; ++j) {
        const int cid = j * 4 + rq; const unsigned ab = cab[cid < 50 ? cid : 0];
        const float sum = t0l[ab >> 4] + t1l[ab & 15];
        res[j] = (j < 13 && cid < 50) ? embed_idx<63u>(sum, (unsigned)cid) : NEG;
    }
    sortdesc<16>(res);
    top16_of_group(res);
    float rs2 = 0.f;
#pragma unroll
    for (int i = 0; i < 8; ++i) rs2 += rsp[i];
    const float lsc = frsq(rq_sum(rs2) * (1.f / D) + EPS) * LOG2E;
    float den = 0.f;
#pragma unroll
    for (int it = 0; it < 16; ++it) den += fexp2((res[it] - res[0]) * lsc);
    const float rden = 1.0f / den;
#pragma unroll
    for (int it = 0; it < 16; ++it) {
        if ((it >> 2) == rq) {
            const unsigned cid = decode_idx<63u>(res[it]); const unsigned ab = cab[cid];
            const unsigned i1 = decode_idx<127u>(t0l[ab >> 4]), i2 = decode_idx<127u>(t1l[ab & 15]);
            const size_t o = (size_t)(t0 + c) * 128 + h * 16 + it;
            *(GAS int*)(EXPI + o) = (int)(i1 * 128u + i2);
            *(GAS float*)(GATE + o) = fexp2((res[it] - res[0]) * lsc) * rden;
        }
    }
    LDS_WAIT(); asm volatile("" ::: "memory");
}

__device__ __forceinline__ float reduce16(const float (&p)[16], int lane) {
    const bool b5 = lane & 32, b4 = lane & 16, b3 = lane & 8, b2 = lane & 4;
    float q[8], r4[4], s2[2];
#pragma unroll
    for (int k = 0; k < 8; ++k) { const float send = b5 ? p[k] : p[k + 8], keep = b5 ? p[k + 8] : p[k]; q[k] = keep + __shfl_xor(send, 32); }
#pragma unroll
    for (int k = 0; k < 4; ++k) { const float send = b4 ? q[k] : q[k + 4], keep = b4 ? q[k + 4] : q[k]; r4[k] = keep + __shfl_xor(send, 16); }
#pragma unroll
    for (int k = 0; k < 2; ++k) { const float send = b3 ? r4[k] : r4[k + 2], keep = b3 ? r4[k + 2] : r4[k]; s2[k] = keep + __shfl_xor(send, 8); }
    const float send = b2 ? s2[0] : s2[1], keep = b2 ? s2[1] : s2[0];
    float v = keep + __shfl_xor(send, 4);
    v += __shfl_xor(v, 1); v += __shfl_xor(v, 2);
    return v;
}
struct RowBuf { u32x4 r[8]; };
__device__ __forceinline__ void rows_load(RowBuf& B, const unsigned char* tab, int ids, int lane_base, int lane) {
#pragma unroll
    for (int r = 0; r < 8; ++r) {
        const int e = __builtin_amdgcn_readlane(ids, lane_base + r);
        B.r[r] = ld_u4(tab + (size_t)e * (D / 2) + lane * 16);
    }
}
__device__ __forceinline__ float dot8f4(unsigned w, const float* hv) {
    const f32x2 a = __builtin_amdgcn_cvt_scalef32_pk_f32_fp4(w, 1.0f, 0), b = __builtin_amdgcn_cvt_scalef32_pk_f32_fp4(w, 1.0f, 1),
                c = __builtin_amdgcn_cvt_scalef32_pk_f32_fp4(w, 1.0f, 2), d = __builtin_amdgcn_cvt_scalef32_pk_f32_fp4(w, 1.0f, 3);
    return ((a[0] * hv[0] + a[1] * hv[1]) + (b[0] * hv[2] + b[1] * hv[3])) + ((c[0] * hv[4] + c[1] * hv[5]) + (d[0] * hv[6] + d[1] * hv[7]));
}
__device__ __forceinline__ float dot32(const u32x4 w, const float* hv) { return (dot8f4(w.x, hv) + dot8f4(w.y, hv + 8)) + (dot8f4(w.z, hv + 16) + dot8f4(w.w, hv + 24)); }
__device__ __forceinline__ void axpy8f4(unsigned w, float s, float* o) {
    const f32x2 a = __builtin_amdgcn_cvt_scalef32_pk_f32_fp4(w, 1.0f, 0), b = __builtin_amdgcn_cvt_scalef32_pk_f32_fp4(w, 1.0f, 1),
                c = __builtin_amdgcn_cvt_scalef32_pk_f32_fp4(w, 1.0f, 2), d = __builtin_amdgcn_cvt_scalef32_pk_f32_fp4(w, 1.0f, 3);
    o[0] += s * a[0]; o[1] += s * a[1]; o[2] += s * b[0]; o[3] += s * b[1]; o[4] += s * c[0]; o[5] += s * c[1]; o[6] += s * d[0]; o[7] += s * d[1];
}
__device__ __forceinline__ void axpy32(const u32x4 w, float s, float* o) { axpy8f4(w.x, s, o); axpy8f4(w.y, s, o + 8); axpy8f4(w.z, s, o + 16); axpy8f4(w.w, s, o + 24); }
constexpr size_t XSL_BYTES = (size_t)NEXP * 128;
constexpr int XW_S = 0, XW_SQ = 8192, XW_RS = 10240, XW_B = 10304, XW_ID = 10816, XW_BYTES = 13312;
constexpr int XZ_OFF = NWAVES * XW_BYTES, XZ_BYTES = 512;
constexpr int XG_OFF = XZ_OFF + XZ_BYTES;
typedef int i32x8 __attribute__((ext_vector_type(8)));
struct URows { u32x4 r[16]; };
__device__ __forceinline__ f32x4 reduce32to4(const float (&p)[32], int lane) {
    const bool b5 = (lane & 32) != 0, b4 = (lane & 16) != 0, b3 = (lane & 8) != 0;
    float q[16], r8[8]; f32x4 o;
#pragma unroll
    for (int k = 0; k < 16; ++k) { const float send = b5 ? p[k] : p[k + 16], keep = b5 ? p[k + 16] : p[k]; q[k] = keep + __shfl_xor(send, 32); }
#pragma unroll
    for (int k = 0; k < 8; ++k) { const float send = b4 ? q[k] : q[k + 8], keep = b4 ? q[k + 8] : q[k]; r8[k] = keep + __shfl_xor(send, 16); }
#pragma unroll
    for (int k = 0; k < 4; ++k) { const float send = b3 ? r8[k] : r8[k + 4], keep = b3 ? r8[k + 4] : r8[k]; o[k] = keep + __shfl_xor(send, 8); }
    return o;
}
#define XFENCE() asm volatile("" ::: "memory")
__device__ __forceinline__ u32x4 ldo_u4(const void* base, unsigned off) { return *(const GAS u32x4*)((const GAS unsigned char*)base + off); }
__device__ __forceinline__ u32x2 ldo_u2(const void* base, unsigned off) { return *(const GAS u32x2*)((const GAS unsigned char*)base + off); }
__device__ __forceinline__ void sto_u2(void* base, unsigned off, u32x2 v) { *(GAS u32x2*)((GAS unsigned char*)base + off) = v; }
__device__ __forceinline__ void sto_f4(void* base, unsigned off, f32x4 v) { *(GAS f32x4*)((GAS unsigned char*)base + off) = v; }
__device__ __forceinline__ void expert_phase(const Frame& F, int l, int xcc, LAS unsigned char* wl, const LAS unsigned char* zb) {
    int lane = lane_id(); asm volatile("" : "+v"(lane));
    const int c = lane & 15, rq = lane >> 4, rr = lane >> 3, pc = lane & 7;
    LAS float* SA = (LAS float*)(wl + XW_S); LAS float* SQ = (LAS float*)(wl + XW_SQ); LAS float* RS = (LAS float*)(wl + XW_RS); LAS unsigned char* BI = wl + XW_B; LAS unsigned char* IDL = wl + XW_ID;
    const unsigned char* UBl = (const unsigned char*)(F.ws + WS_UB) + (size_t)l * NEXP * (D / 2); const unsigned char* VBl = (const unsigned char*)(F.ws + WS_VB) + (size_t)l * NEXP * (D / 2);
    const unsigned* SUV = (const unsigned*)(F.ws + WS_SU) + (size_t)l * NEXP;
    const bf16* X1 = (const bf16*)(F.ws + WS_H2); bf16* XR = (bf16*)(F.ws + WS_XR);
    const int* EXPI = (const int*)(F.ws + WS_EXP); const float* GATE = (const float*)(F.ws + WS_GATE);
    const LAS float* G2 = (const LAS float*)(zb + XZ_BYTES);
    for (int tb = F.gw; tb < T; tb += 8 * F.ngw) {
        auto tok = [&](int k) { const int t = tb + k * F.ngw; return t < T ? t : tb; };
        auto slice_of = [&](int i) { return ((i >> 3) + xcc) & 7; };
        {
            float zf = 0.f; asm volatile("" : "+v"(zf)); const f32x4 z = (f32x4){zf, zf, zf, zf};
#pragma unroll
            for (int i = 0; i < 8; ++i) *(LAS f32x4*)(SA + (i * 64 + lane) * 4) = z;
#pragma unroll
            for (int i = 0; i < 2; ++i) *(LAS f32x4*)(SQ + (i * 64 + lane) * 4) = z;
#pragma unroll
            for (int k = 0; k < 8; ++k) { const u32x2 e2 = ldo_u2(EXPI + (size_t)tok(k) * 128, 8u * lane); *(LAS unsigned*)(IDL + k * 256 + lane * 4) = e2.x | (e2.y << 16); }
            const float* SS2 = (const float*)(F.ws + WS_SS2);
            float ss[8];
#pragma unroll
            for (int k = 0; k < 8; ++k) ss[k] = *(const GAS float*)(SS2 + (size_t)(lane & 31) * T + tok(k));
#pragma unroll
            for (int k = 0; k < 8; ++k) { const float tot = wave_sum(ss[k]) * 0.5f; if (lane == 0) RS[k] = frsq(tot * (1.f / D) + EPS); }
            LDS_WAIT(); XFENCE();
        }
#ifndef U_REP
#define U_REP 1
#endif
#ifndef V_REP
#define V_REP 1
#endif
        for (int urep = 0; urep < U_REP; ++urep) {
            if (urep) { float zf = 0.f; asm volatile("" : "+v"(zf)); const f32x4 z = (f32x4){zf, zf, zf, zf};
#pragma unroll
                for (int i = 0; i < 8; ++i) *(LAS f32x4*)(SA + (i * 64 + lane) * 4) = z;
                LDS_WAIT(); XFENCE(); }
            const LAS unsigned char* bbase = c < 2 ? BI + c * 128 + rq * 32 : zb;
            LAS unsigned char* bw = BI + (lane >> 5) * 256 + (((lane & 31) >> 2) & 3) * 32 + ((lane & 31) >> 4) * 16 + (lane & 3) * 4;
            auto u_x = [&](int i) { return ldo_u2(X1 + (size_t)tok(i & 7) * D + slice_of(i) * 256, 8u * lane); };
            struct HRows { u32x4 r[8]; };
            auto u_rows_h = [&](int hs, HRows& H) {
                const int i = hs >> 1, mg = hs & 1;
                const unsigned char* Usl = UBl + (size_t)slice_of(i) * XSL_BYTES;
                const u32x2 id = *(const LAS u32x2*)(IDL + (i & 7) * 256 + c * 16 + mg * 8);
#ifdef U_PROBE_MASK
                const unsigned pm = (U_REP > 1 && urep == 0) ? (unsigned)(U_PROBE_MASK) : 0xffffu;
#else
                const unsigned pm = 0xffffu;
#endif
                const unsigned i0 = id.x, i1 = id.y;
#pragma unroll
                for (int mm = 0; mm < 4; ++mm) { const unsigned w = mm < 2 ? i0 : i1; const unsigned e = (mm & 1) ? (w >> 16) : (w & 0xffffu); const unsigned off = (e & pm) * 128u + 16u * rq;
                    H.r[2 * mm] = ldo_u4(Usl, off); H.r[2 * mm + 1] = ldo_u4(Usl + 64, off); }
            };
            i32x8 B0, B1;
            auto u_bbuild = [&](int i, const u32x2& xw) {
                const int k = i & 7;
                const f32x4 gg = *(const LAS f32x4*)(G2 + slice_of(i) * 256 + 4 * lane);
                const float rstd = RS[k];
                const float h0 = bf_lo(xw.x) * rstd * gg[0], h1 = bf_hi(xw.x) * rstd * gg[1], h2 = bf_lo(xw.y) * rstd * gg[2], h3 = bf_hi(xw.y) * rstd * gg[3];
                int w = __builtin_amdgcn_cvt_pk_fp8_f32(h0, h1, 0, false); w = __builtin_amdgcn_cvt_pk_fp8_f32(h2, h3, w, true);
                const f32x2 b0 = __builtin_amdgcn_cvt_pk_f32_fp8(w, false), b1 = __builtin_amdgcn_cvt_pk_f32_fp8(w, true);
                int v = __builtin_amdgcn_cvt_pk_fp8_f32(h0 - b0[0], h1 - b0[1], 0, false); v = __builtin_amdgcn_cvt_pk_fp8_f32(h2 - b1[0], h3 - b1[1], v, true);
                *(LAS int*)(bw) = w; *(LAS int*)(bw + 128) = v;
                LDS_WAIT(); XFENCE();
                const u32x4 b0l = *(const LAS u32x4*)(bbase), b0h = *(const LAS u32x4*)(bbase + 16), b1l = *(const LAS u32x4*)(bbase + 256), b1h = *(const LAS u32x4*)(bbase + 272);
                B0 = (i32x8){(int)b0l.x, (int)b0l.y, (int)b0l.z, (int)b0l.w, (int)b0h.x, (int)b0h.y, (int)b0h.z, (int)b0h.w};
                B1 = (i32x8){(int)b1l.x, (int)b1l.y, (int)b1l.z, (int)b1l.w, (int)b1h.x, (int)b1h.y, (int)b1h.z, (int)b1h.w};
            };
            auto u_comp_h = [&](int hs, HRows& H) {
                const int k = (hs >> 1) & 7, mg = hs & 1;
                LAS f32x4* tp = (LAS f32x4*)(SA + k * 256 + (c & 1) * 16 + 4 * rq) + mg * 32;
                f32x4 acc[4];
#pragma unroll
                for (int mm = 0; mm < 4; ++mm) acc[mm] = (f32x4){0.f, 0.f, 0.f, 0.f};
                if (c < 2) {
#pragma unroll
                    for (int mm = 0; mm < 4; ++mm) acc[mm] = tp[mm * 8];
                }
#pragma unroll
                for (int mm = 0; mm < 4; ++mm) {
                    const i32x8 a0 = {(int)H.r[2 * mm].x, (int)H.r[2 * mm].y, (int)H.r[2 * mm].z, (int)H.r[2 * mm].w, 0, 0, 0, 0};
                    const i32x8 a1 = {(int)H.r[2 * mm + 1].x, (int)H.r[2 * mm + 1].y, (int)H.r[2 * mm + 1].z, (int)H.r[2 * mm + 1].w, 0, 0, 0, 0};
                    acc[mm] = __builtin_amdgcn_mfma_scale_f32_16x16x128_f8f6f4(a0, B0, acc[mm], 4, 0, 0, 0x7F7F7F7F, 0, 0x7F7F7F7F);
                    acc[mm] = __builtin_amdgcn_mfma_scale_f32_16x16x128_f8f6f4(a1, B1, acc[mm], 4, 0, 0, 0x7F7F7F7F, 0, 0x7F7F7F7F);
                }
                if (c < 2) {
#pragma unroll
                    for (int mm = 0; mm < 4; ++mm) tp[mm * 8] = acc[mm];
                }
            };
            HRows H0, H1, H2, H3;
            u32x2 xe, xo;
            xe = u_x(0);
            u_rows_h(0, H0); u_rows_h(1, H1); u_rows_h(2, H2);
            xo = u_x(1);
            XFENCE();
#pragma unroll 1
            for (int hs = 0; hs < 128; hs += 4) {
                const int i = hs >> 1;
                const int h3 = hs + 3, h4 = hs + 4 < 128 ? hs + 4 : 127, h5 = hs + 5 < 128 ? hs + 5 : 127, h6 = hs + 6 < 128 ? hs + 6 : 127;
                u_rows_h(h3, H3);
                XFENCE();
                u_bbuild(i, xe); u_comp_h(hs, H0);
                XFENCE();
                u_rows_h(h4, H0); xe = u_x(i + 2 < 64 ? i + 2 : 63);
                XFENCE();
                u_comp_h(hs + 1, H1);
                XFENCE();
                u_rows_h(h5, H1);
                XFENCE();
                u_bbuild(i + 1, xo); u_comp_h(hs + 2, H2);
                XFENCE();
                u_rows_h(h6, H2); xo = u_x(i + 3 < 64 ? i + 3 : 63);
                XFENCE();
                u_comp_h(hs + 3, H3);
                XFENCE();
            }
        }
        LDS_WAIT(); XFENCE();
        {
            unsigned suvq[8][2]; float gtq[8][2];
#pragma unroll
            for (int k = 0; k < 8; ++k)
#pragma unroll
                for (int hf = 0; hf < 2; ++hf) { const unsigned e = *(const LAS unsigned short*)(IDL + k * 256 + (hf * 64 + lane) * 2);
                    suvq[k][hf] = *(const GAS unsigned*)(SUV + e); gtq[k][hf] = *(const GAS float*)(GATE + (size_t)tok(k) * 128 + hf * 64 + lane); }
#pragma unroll
            for (int k = 0; k < 8; ++k) {
                float wq[2];
#pragma unroll
                for (int hf = 0; hf < 2; ++hf) {
                    const unsigned suv = suvq[k][hf];
                    const int kk = hf * 64 + lane;
                    const float a = (SA[k * 256 + (kk & 7) * 32 + (kk >> 3)] + SA[k * 256 + (kk & 7) * 32 + 16 + (kk >> 3)]) * bf_lo(suv);
                    wq[hf] = gtq[k][hf] * bf_hi(suv) * 0.5f * a * (1.0f + erff(a * 0.7071067811865476f));
                }
                XFENCE();
                float wm = fmaxf(__builtin_fabsf(wq[0]), __builtin_fabsf(wq[1]));
#pragma unroll
                for (int o = 1; o < 64; o <<= 1) wm = fmaxf(wm, __shfl_xor(wm, o));
                const float sc = __builtin_bit_cast(float, __builtin_bit_cast(unsigned, fminf(42.0f / fmaxf(wm, 1e-30f), 1.0e18f)) & 0x7f800000u);
                const unsigned h0 = (unsigned)__builtin_bit_cast(unsigned short, (_Float16)(wq[0] * sc)), h1 = (unsigned)__builtin_bit_cast(unsigned short, (_Float16)(wq[1] * sc));
                ((LAS unsigned*)SA)[k * 256 + lane] = h0 | (h0 << 16); ((LAS unsigned*)SA)[k * 256 + 64 + lane] = h1 | (h1 << 16);
                if (lane == 0) RS[8 + k] = 1.0f / sc;
            }
        }
        LDS_WAIT(); XFENCE();
        for (int vrep = 0; vrep < V_REP; ++vrep) {
            if (vrep) { float zf = 0.f; asm volatile("" : "+v"(zf)); const f32x4 z = (f32x4){zf, zf, zf, zf};
#pragma unroll
                for (int i = 0; i < 2; ++i) *(LAS f32x4*)(SQ + (i * 64 + lane) * 4) = z;
                LDS_WAIT(); XFENCE(); }
            auto v_rows = [&](int i, URows& R) {
                const unsigned char* Vsl = VBl + (size_t)slice_of(i) * XSL_BYTES;
                const u32x4 ia = *(const LAS u32x4*)(IDL + (i & 7) * 256 + rr * 32), ib = *(const LAS u32x4*)(IDL + (i & 7) * 256 + rr * 32 + 16);
#pragma unroll
                for (int j = 0; j < 16; ++j) { const unsigned w = j < 8 ? ia[(j >> 1) & 3] : ib[(j >> 1) & 3]; const unsigned e = (j & 1) ? (w >> 16) : (w & 0xffffu);
                    R.r[j] = ldo_u4(Vsl, e * 128u + 16u * pc); }
            };
            auto v_comp = [&](int i, const URows& R) {
                const int k = i & 7, t = tok(k), sl = slice_of(i);
                const unsigned col = 32u * pc + 4u * rr;
                u32x2 xw;
                typedef _Float16 hf2 __attribute__((ext_vector_type(2)));
                const LAS u32x4* wp = (const LAS u32x4*)(SA + k * 256 + 16 * rr);
                const u32x4 wall[4] = {wp[0], wp[1], wp[2], wp[3]};
                unsigned out[16];
#pragma unroll
                for (int j = 0; j < 16; ++j) out[j] = 0u;
#pragma unroll
                for (int j = 0; j < 16; ++j) {
                    if (j == 8) xw = ldo_u2(X1 + (size_t)t * D + sl * 256, 2u * col);
                    u32x4 rj = R.r[j];
                    asm volatile("" : "+v"(rj.x), "+v"(rj.y), "+v"(rj.z), "+v"(rj.w) :: "memory");
                    const unsigned wj = wall[j >> 2][j & 3]; const hf2 w2 = __builtin_bit_cast(hf2, wj);
#pragma unroll
                    for (int d = 0; d < 4; ++d) {
                        const hf2 a = __builtin_amdgcn_cvt_scalef32_pk_f16_fp4(rj[d], 1.0f, 0), b = __builtin_amdgcn_cvt_scalef32_pk_f16_fp4(rj[d], 1.0f, 1),
                                  cc = __builtin_amdgcn_cvt_scalef32_pk_f16_fp4(rj[d], 1.0f, 2), dd = __builtin_amdgcn_cvt_scalef32_pk_f16_fp4(rj[d], 1.0f, 3);
                        out[4 * d] = __builtin_bit_cast(unsigned, __builtin_elementwise_fma(a, w2, __builtin_bit_cast(hf2, out[4 * d])));
                        out[4 * d + 1] = __builtin_bit_cast(unsigned, __builtin_elementwise_fma(b, w2, __builtin_bit_cast(hf2, out[4 * d + 1])));
                        out[4 * d + 2] = __builtin_bit_cast(unsigned, __builtin_elementwise_fma(cc, w2, __builtin_bit_cast(hf2, out[4 * d + 2])));
                        out[4 * d + 3] = __builtin_bit_cast(unsigned, __builtin_elementwise_fma(dd, w2, __builtin_bit_cast(hf2, out[4 * d + 3])));
                    }
                    if ((j & 3) == 3) asm volatile("" : "+v"(out[0]), "+v"(out[1]), "+v"(out[2]), "+v"(out[3]), "+v"(out[4]), "+v"(out[5]), "+v"(out[6]), "+v"(out[7]), "+v"(out[8]), "+v"(out[9]), "+v"(out[10]), "+v"(out[11]), "+v"(out[12]), "+v"(out[13]), "+v"(out[14]), "+v"(out[15]) :: "memory");
                }
                unsigned o2[2];
                {
                    const bool b5 = (lane & 32) != 0, b4 = (lane & 16) != 0, b3 = (lane & 8) != 0;
                    unsigned q8[8], q4[4];
                    auto hadd = [](unsigned x, unsigned y) { return __builtin_bit_cast(unsigned, __builtin_bit_cast(hf2, x) + __builtin_bit_cast(hf2, y)); };
#pragma unroll
                    for (int n = 0; n < 8; ++n) { const unsigned send = b5 ? out[n] : out[n + 8], keep = b5 ? out[n + 8] : out[n]; q8[n] = hadd(keep, (unsigned)__shfl_xor((int)send, 32)); }
#pragma unroll
                    for (int n = 0; n < 4; ++n) { const unsigned send = b4 ? q8[n] : q8[n + 4], keep = b4 ? q8[n + 4] : q8[n]; q4[n] = hadd(keep, (unsigned)__shfl_xor((int)send, 16)); }
#pragma unroll
                    for (int n = 0; n < 2; ++n) { const unsigned send = b3 ? q4[n] : q4[n + 2], keep = b3 ? q4[n + 2] : q4[n]; o2[n] = hadd(keep, (unsigned)__shfl_xor((int)send, 8)); }
                }
                const float isc = RS[8 + k];
                const hf2 oa = __builtin_bit_cast(hf2, o2[0]), ob = __builtin_bit_cast(hf2, o2[1]);
                const float y0 = bf_lo(xw.x) + (float)oa[0] * isc, y1 = bf_hi(xw.x) + (float)oa[1] * isc, y2 = bf_lo(xw.y) + (float)ob[0] * isc, y3 = bf_hi(xw.y) + (float)ob[1] * isc;
                if (l + 1 < DEPTH) {
                    u32x2 w; w.x = pk2(y0, y1); w.y = pk2(y2, y3);
                    sto_u2(XR + (size_t)t * D + sl * 256, 2u * col, w);
                    const float s = (y0 * y0 + y1 * y1) + (y2 * y2 + y3 * y3);
                    (void)__hip_atomic_fetch_add(SQ + k * 64 + lane, s, __ATOMIC_RELAXED, __HIP_MEMORY_SCOPE_WAVEFRONT);
                } else sto_f4(F.out + (size_t)t * D + sl * 256, 4u * col, (f32x4){y0, y1, y2, y3});
            };
            URows RA, RB;
            v_rows(0, RA);
            XFENCE();
#pragma unroll 1
            for (int i = 0; i < 64; i += 2) {
                const int i2 = i + 2 < 64 ? i + 2 : 63;
                v_rows(i + 1, RB);
                XFENCE();
                v_comp(i, RA);
                XFENCE();
                v_rows(i2, RA);
                XFENCE();
                v_comp(i + 1, RB);
                XFENCE();
            }
        }
        if (l + 1 < DEPTH) {
            float* RSTD = (float*)(F.ws + WS_RSTD);
#pragma unroll
            for (int k = 0; k < 8; ++k) { const float r1 = frsq(wave_sum(SQ[k * 64 + lane]) * (1.f / D) + EPS); if (lane == 0) *(GAS float*)(RSTD + tok(k)) = r1; }
        }
        LDS_WAIT(); XFENCE();
    }
}

#ifndef PG8_SP2
#define PG8_SP2 true
#endif
#ifndef PG8_ALIGN
#define PG8_ALIGN true
#endif
struct Args { const float* in[14]; float* out; unsigned char* ws; int ph_lo, ph_hi, use_bar, pad; };
__global__ void __launch_bounds__(NWAVES * 64, 2) hybrid_fwd(Args args) {
    extern __shared__ __attribute__((aligned(16))) unsigned char lds_raw[];
    Frame F;
    F.lds = (LAS unsigned char*)lds_raw;
    F.wave = __builtin_amdgcn_readfirstlane((int)threadIdx.x >> 6);
    F.G = gridDim.x; F.gw = blockIdx.x * NWAVES + F.wave; F.ngw = F.G * NWAVES;
    F.x = args.in[0]; F.norm1_g = args.in[1]; F.w_in = args.in[2]; F.qa_g = args.in[3]; F.ka_g = args.in[4]; F.rel_bias = args.in[5]; F.attn_g = args.in[6]; F.ret_g = args.in[7];
    F.w_out = args.in[8]; F.norm2_g = args.in[9]; F.peer_wq = args.in[10]; F.peer_keys = args.in[11]; F.peer_u = args.in[12]; F.peer_v = args.in[13];
    F.out = args.out; F.ws = args.ws;
    for (int u = threadIdx.x; u < (LDS_BYTES - LDSCTL_OFF) / 4; u += NWAVES * 64) ((LAS unsigned*)(F.lds + LDSCTL_OFF))[u] = 0u;
    __syncthreads();
    unsigned* barw = (unsigned*)(args.ws + WS_CTL) + CW_BAR;
    XcdBarrier bar; bar.bar = barw; bar.x = 0; bar.st = nullptr;
    if (args.use_bar) bar = xcd_barrier_post(barw, (volatile LAS unsigned*)(F.lds + MISC_OFF) + 8);
    const int lo = args.ph_lo, hi = args.ph_hi;
#define IN(k) (lo <= (k) && (k) < hi)
#define SEAM(k) do { if (IN((k) + 1)) xcd_barrier(bar, F.wave); } while (0)

#ifndef REP_MASK
#define REP_MASK 0
#endif
#ifndef REP_N
#define REP_N 1
#endif
#define REPS(k) (((REP_MASK >> (k)) & 1) ? REP_N : 1)
#ifndef ONLY
#define PH_ON(k) 1
#else
#define PH_ON(k) ((k)==ONLY)
#endif
    if (PH_ON(0) && IN(0)) { for (int rep = 0; rep < REPS(0); ++rep) p0_prologue(F); SEAM(0); }

    for (int l = 0; l < DEPTH; ++l) {
        const int pb = 1 + l * PH_PER_LAYER;
        if (PH_ON(1) && IN(pb + 0)) for (int rep = 0; rep < REPS(1); ++rep) {
            {
                pg8::Gemm g{(const pg8::bf16_t*)(F.ws + WS_XR), (const pg8::bf16_t*)(F.ws + WS_WTOK) + (size_t)l * TOKC * D, T, TOKC, D};
                pg8::StaticOrder So; So.init(T, TOKC, F.G, (int)blockIdx.x);
                pg8::EpiTok E{(pg8::bf16_t*)(F.ws + WS_TOK), (const pg8::f32x2*)(F.ws + WS_ROPE_TOK), (float*)(F.ws + WS_SSQ), (const float*)(F.ws + WS_RSTD)};
                pg8::gemm_phase<pg8::EpiTok, pg8::StaticOrder, PG8_ALIGN, PG8_SP2>(F.lds + RING_OFF, g, So, E, F.wave);
            }
            {
                pg8::Gemm g{(const pg8::bf16_t*)(F.ws + WS_WSWP) + (size_t)l * SWPR * D, (const pg8::bf16_t*)(F.ws + WS_XR), SWPR, T, D};
                pg8::StaticOrder So; So.init(SWPR, T, F.G, (int)blockIdx.x);
                pg8::EpiSwp E{(pg8::bf16_t*)(F.ws + WS_SWP), SWPP, (const float*)(F.ws + WS_RSTD)};
                pg8::gemm_phase<pg8::EpiSwp, pg8::StaticOrder, PG8_ALIGN, PG8_SP2>(F.lds + RING_OFF, g, So, E, F.wave);
            }
            SEAM(pb + 0);
        }
        if (PH_ON(2) && IN(pb + 1)) for (int rep = 0; rep < REPS(2); ++rep) {
            LAS float* biasL = (LAS float*)(F.lds + RING_OFF + A_BIAS);
            int tid2 = F.wave * 64 + lane_id(); asm volatile("" : "+v"(tid2));
            for (int i = tid2; i < NH * 257; i += NWAVES * 64) biasL[i] = *(const GAS float*)(F.rel_bias + (size_t)l * NH * 257 + i) * LOG2E;
#ifndef SCAN_REP
#define SCAN_REP 1
#endif
            for (int srep = 0; srep < SCAN_REP; ++srep)
            for (int task = F.gw; task < NBATCH * NH * 8 * 2; task += F.ngw) scan_task(F, task);
            {
                constexpr int NAT = NBATCH * NH * 8;
                const int g = (int)blockIdx.x;
                if (F.G == 256) {
                    const int n = g < 128 ? 1 : 3, first = g < 128 ? g : 128 + (g - 128) * 3;
                    for (int i = 0; i < n; ++i) attn_wg_task(F, l, first + i);
                } else {
                    for (int task = g; task < NAT; task += F.G) attn_wg_task(F, l, task);
                }
            }
            SEAM(pb + 1);
        }
        if (PH_ON(3) && IN(pb + 2)) for (int rep = 0; rep < REPS(3); ++rep) {
            for (int task = F.gw; task < NBATCH * NH * NCH * 2; task += F.ngw) ret_task(F, l, task);
            SEAM(pb + 2);
        }
        if (PH_ON(4) && IN(pb + 3)) for (int rep = 0; rep < REPS(4); ++rep) {
            pg8::Gemm g{(const pg8::bf16_t*)(F.ws + WS_MIX), (const pg8::bf16_t*)(F.ws + WS_WOUT) + (size_t)l * D * D, T, D, D};
            pg8::StaticOrder So; So.init(T, D, F.G, (int)blockIdx.x);
            pg8::EpiRes E{l == 0 ? F.x : (const float*)nullptr, (const pg8::bf16_t*)(F.ws + WS_XR), (pg8::bf16_t*)(F.ws + WS_H2), (float*)(F.ws + WS_SS2)};
            pg8::gemm_phase<pg8::EpiRes, pg8::StaticOrder, PG8_ALIGN, PG8_SP2>(F.lds + RING_OFF, g, So, E, F.wave);
            SEAM(pb + 3);
        }
        if (PH_ON(6) && IN(pb + 5)) for (int rep = 0; rep < REPS(6); ++rep) {
            pg8::Gemm g{(const pg8::bf16_t*)(F.ws + WS_H2), (const pg8::bf16_t*)(F.ws + WS_WQ) + (size_t)l * D * D, T, D, D};
            pg8::StaticOrder So; So.init(T, D, F.G, (int)blockIdx.x);
            pg8::EpiB16 E{(pg8::bf16_t*)(F.ws + WS_QP), QPP};
            pg8::gemm_phase<pg8::EpiB16, pg8::StaticOrder, PG8_ALIGN, PG8_SP2>(F.lds + RING_OFF, g, So, E, F.wave);
            SEAM(pb + 5);
        }
        if (PH_ON(7) && IN(pb + 6)) for (int rep = 0; rep < REPS(7); ++rep) {
            LAS unsigned char* kl = F.lds + RING_OFF; LAS float* tl = (LAS float*)(F.lds + RING_OFF + KL_BYTES) + F.wave * TL_WAVE_FLOATS;
            int tid3 = F.wave * 64 + lane_id(); asm volatile("" : "+v"(tid3));
            LAS unsigned char* cab = F.lds + RING_OFF + KL_BYTES + NWAVES * TL_WAVE_FLOATS * 4;
            if (tid3 < 64) cab[tid3] = kCandAB[tid3];
            const bf16* KEYS = (const bf16*)(F.ws + WS_KEYS) + (size_t)l * 8 * 256 * 128;
            for (int wt = blockIdx.x; wt < 256; wt += F.G) {
                const int tg = wt >> 1, hg = wt & 1;
                for (int hi = 0; hi < 4; ++hi) {
                    const int h = hg * 4 + hi;
                    __syncthreads();
#pragma unroll
                    for (int i = 0; i < 8; ++i) { const int idx = tid3 + 512 * i, row = idx >> 4, c16 = idx & 15;
                        *(LAS u32x4*)(kl + row * KL_PITCH + c16 * 16) = ld_u4(KEYS + ((size_t)h * 256 + row) * 128 + c16 * 8); }
                    __syncthreads();
                    topk_task(F, l, tg * 8 + F.wave, h, kl, tl, cab);
                }
            }
            SEAM(pb + 6);
        }
        if (PH_ON(8) && IN(pb + 7)) for (int rep = 0; rep < REPS(8); ++rep) {
            LAS unsigned char* wl = F.lds + RING_OFF + F.wave * XW_BYTES; const LAS unsigned char* zb = F.lds + RING_OFF + XZ_OFF;
            { int tid4 = F.wave * 64 + lane_id(); asm volatile("" : "+v"(tid4)); for (int i = tid4; i < XZ_BYTES / 4; i += NWAVES * 64) ((LAS unsigned*)zb)[i] = 0u;
              for (int i = tid4; i < D; i += NWAVES * 64) ((LAS float*)(F.lds + RING_OFF + XG_OFF))[i] = *(const GAS float*)(F.norm2_g + l * D + i); }
            __syncthreads();
            expert_phase(F, l, (int)xb_xcc_id(), wl, zb);
            SEAM(pb + 7);
        }
    }
#undef IN
#undef SEAM
}

extern "C" void kernel_launch(void* const* d_in, const int* in_sizes, int n_in, void* d_out, int out_size, void* d_ws, size_t ws_size, hipStream_t stream) {
    static int grid = 0;
    if (grid == 0) {
        if (n_in != 14 || in_sizes[0] != T * D || out_size != T * D || ws_size < WS_END) {
            fprintf(stderr, "kernel_launch: unexpected problem (n_in %d, in0 %d, out %d, ws %zu; need ws >= %zu); nothing launched\n", n_in, n_in > 0 ? in_sizes[0] : -1, out_size, ws_size, (size_t)WS_END); grid = -1; return; }
        int dev = 0, cus = 0, per_cu = 0;
        if (hipGetDevice(&dev) != hipSuccess || hipDeviceGetAttribute(&cus, hipDeviceAttributeMultiprocessorCount, dev) != hipSuccess) { fprintf(stderr, "kernel_launch: device query failed\n"); grid = -1; return; }
        if (hipFuncSetAttribute((const void*)hybrid_fwd, hipFuncAttributeMaxDynamicSharedMemorySize, LDS_BYTES) != hipSuccess) { fprintf(stderr, "kernel_launch: hipFuncSetAttribute failed\n"); grid = -1; return; }
        if (hipOccupancyMaxActiveBlocksPerMultiprocessor(&per_cu, (const void*)hybrid_fwd, NWAVES * 64, LDS_BYTES) != hipSuccess || per_cu < 1)
            fprintf(stderr, "kernel_launch: note: occupancy query reports %d workgroups per CU\n", per_cu);
        (void)hipGetLastError();
        grid = cus;
    }
    if (grid < 0) return;
    if (hipMemsetAsync((char*)d_ws + WS_CTL, 0, CTL_ZERO_BYTES, stream) != hipSuccess) { fprintf(stderr, "kernel_launch: memset failed\n"); return; }
    Args a{};
    for (int i = 0; i < 14; ++i) a.in[i] = (const float*)d_in[i];
    a.out = (float*)d_out; a.ws = (unsigned char*)d_ws; a.pad = 0;
#if MK_ONE_LAUNCH
    a.ph_lo = 0; a.ph_hi = N_PHASES; a.use_bar = 1;
    hipLaunchKernelGGL(hybrid_fwd, dim3(grid), dim3(NWAVES * 64), LDS_BYTES, stream, a);
    { const hipError_t le = hipPeekAtLastError(); if (le != hipSuccess) fprintf(stderr, "kernel_launch: launch failed: %s\n", hipGetErrorName(le)); }
#else
    for (int p = 0; p < N_PHASES; ++p) {
        a.ph_lo = p; a.ph_hi = p + 1; a.use_bar = 0;
        hipLaunchKernelGGL(hybrid_fwd, dim3(grid), dim3(NWAVES * 64), LDS_BYTES, stream, a);
        const hipError_t le = hipPeekAtLastError(); if (le != hipSuccess) { fprintf(stderr, "kernel_launch: launch %d failed: %s\n", p, hipGetErrorName(le)); break; }
    }
#endif
}
```

```cpp
#include <hip/hip_runtime.h>
#include <cstdio>
#include <cstdint>

#ifndef MK_ONE_LAUNCH
#define MK_ONE_LAUNCH 1
#endif

namespace pg8 {
#define PG8_LAS __attribute__((address_space(3)))
typedef unsigned short bf16_t;
typedef short bf16x8 __attribute__((ext_vector_type(8)));
typedef float f32x4 __attribute__((ext_vector_type(4)));
typedef unsigned u32x4 __attribute__((ext_vector_type(4)));
constexpr int BM = 256, BK = 64, HALF = 128, HTB = HALF * BK * 2  , STAGE_BYTES = 8 * HTB, NXCD = 8, WGM = 8;

__host__ __device__ __forceinline__ int lds_byte(int r, int c) { const int st = (r >> 4) * 2 + (c >> 5), rr = r & 15, cc = c & 31, ob = rr * 64 + cc * 2; return st * 1024 + (ob ^ (((ob >> 9) & 1) << 5)); }
__host__ __device__ __forceinline__ void stage_rc(int b, int& R, int& C) { const int st = b / 1024, sb = b % 1024, swz = sb ^ (((sb >> 9) & 1) << 5); R = (st >> 1) * 16 + swz / 64; C = (st & 1) * 32 + (swz % 64) / 2; }
__host__ __device__ __forceinline__ int perm32(int rho) { const int n = rho >> 4, i = rho & 15; return 8 * (i >> 2) + 4 * n + (i & 3); }

struct Unit { int pm, pn; };
struct Gemm { const bf16_t* A; const bf16_t* Bt; int M, N, K; };

struct StaticOrder {
    int nM, nN, nwg, G, c;
    __host__ __device__ void init(int M, int N, int G_, int c_) { nM = M / BM; nN = N / BM; nwg = nM * nN; G = G_; c = c_; }
    __host__ __device__ bool next(int i, Unit& u) const {
        const long L = (long)i * G + c; if (L >= nwg) return false;
        int wgid = (int)L; { const int q = nwg / NXCD, r = nwg % NXCD, xcd = wgid % NXCD, off = wgid / NXCD; wgid = (xcd < r ? xcd * (q + 1) : r * (q + 1) + (xcd - r) * q) + off; }
        const int nig = WGM * nN, gid = wgid / nig, fm = gid * WGM, gsz = (nM - fm) < WGM ? (nM - fm) : WGM;
        u.pm = fm + ((wgid % nig) % gsz); u.pn = (wgid % nig) / gsz; return true;
    }
    __device__ __forceinline__ void a_ready(const Unit&) const {}
    __device__ __forceinline__ void done(const Unit&) const {}
};
__device__ __forceinline__ unsigned cvt_pk_bf16(float lo, float hi) { unsigned r; asm volatile("v_cvt_pk_bf16_f32 %0, %1, %2" : "=v"(r) : "v"(lo), "v"(hi)); return r; }

typedef float f32x2 __attribute__((ext_vector_type(2)));
constexpr int MT = 16384, MS = 2048;
constexpr int TOKC = 5120;
constexpr int TOKP = 5248, SWPP = 16512, QPP = 2176;
constexpr float KSCALE = 0.08838834764831845f;
__device__ __forceinline__ float lg2gamma(int h) {
    return h == 0 ? -0.04580368961312479f : h == 1 ? -0.02272007650008353f : h == 2 ? -0.011315313227834146f : h == 3 ? -0.005646563141142063f :
           h == 4 ? -0.0028205190623786626f : h == 5 ? -0.0014095702546713536f : h == 6 ? -0.0007046129765893727f : -0.0003522634716290214f;
}

struct EpiTok {
    static constexpr bool PERM = true, AFTER_DRAIN = false;
    bf16_t* O; const f32x2* cs; float* ssq; const float* rstd;
    __device__ __forceinline__ void operator()(const f32x4 (&acc)[2][2][4][2], const Unit& u, int wr, int wc, int fr, int fq) const {
        const int row0 = u.pm * BM + wr * 64 + fr, kind = u.pn >> 2;
#pragma unroll
        for (int ai = 0; ai < 2; ++ai)
#pragma unroll
            for (int m = 0; m < 4; ++m) {
                const int row = row0 + ai * HALF + m * 16, pos = row & (MS - 1);
                const float rs = rstd[row];
#pragma unroll
                for (int bj = 0; bj < 2; ++bj) {
                    const int c0 = u.pn * BM + bj * HALF + wc * 32 + 8 * fq;
                    f32x4 v0 = acc[ai][bj][m][0] * rs, v1 = acc[ai][bj][m][1] * rs;
                    if (kind <= 1) {
                        float s = (v0[0] * v0[0] + v0[1] * v0[1]) + (v0[2] * v0[2] + v0[3] * v0[3]) + (v1[0] * v1[0] + v1[1] * v1[1]) + (v1[2] * v1[2] + v1[3] * v1[3]);
                        s += __shfl_xor(s, 16); s += __shfl_xor(s, 32);
                        const int head = (u.pn & 3) * 2 + bj;
                        if (fq == 0) ssq[(size_t)((kind * 8 + head) * 4 + wc) * MT + row] = s;
                    } else if (kind <= 3) {
                        const int i0 = (c0 & 127) >> 1;
                        const f32x4 csa = *(const f32x4*)(cs + (size_t)pos * 64 + i0), csb = *(const f32x4*)(cs + (size_t)pos * 64 + i0 + 2);
                        const float sc = (kind == 3) ? KSCALE : 1.0f;
                        f32x4 w0, w1;
                        w0[0] = (v0[0] * csa[0] - v0[1] * csa[1]) * sc; w0[1] = (v0[1] * csa[0] + v0[0] * csa[1]) * sc;
                        w0[2] = (v0[2] * csa[2] - v0[3] * csa[3]) * sc; w0[3] = (v0[3] * csa[2] + v0[2] * csa[3]) * sc;
                        w1[0] = (v1[0] * csb[0] - v1[1] * csb[1]) * sc; w1[1] = (v1[1] * csb[0] + v1[0] * csb[1]) * sc;
                        w1[2] = (v1[2] * csb[2] - v1[3] * csb[3]) * sc; w1[3] = (v1[3] * csb[2] + v1[2] * csb[3]) * sc;
                        v0 = w0; v1 = w1;
                    } else {
#pragma unroll
                        for (int j = 0; j < 4; ++j) { v0[j] = v0[j] * __builtin_amdgcn_rcpf(1.0f + __builtin_amdgcn_exp2f(-1.4426950408889634f * v0[j]));
                                                      v1[j] = v1[j] * __builtin_amdgcn_rcpf(1.0f + __builtin_amdgcn_exp2f(-1.4426950408889634f * v1[j])); }
                    }
                    u32x4 w; w.x = cvt_pk_bf16(v0[0], v0[1]); w.y = cvt_pk_bf16(v0[2], v0[3]); w.z = cvt_pk_bf16(v1[0], v1[1]); w.w = cvt_pk_bf16(v1[2], v1[3]);
                    *(u32x4*)(O + (size_t)row * TOKP + c0) = w;
                }
            }
    }
};
struct EpiRes {
    static constexpr bool PERM = false, AFTER_DRAIN = false;
    const float* R32; const bf16_t* R16; bf16_t* XB; float* ss2;
    __device__ __forceinline__ void operator()(const f32x4 (&acc)[2][2][4][2], const Unit& u, int wr, int wc, int fr, int fq) const {
        const int row0 = u.pm * BM + wr * 64 + fr, col0 = u.pn * BM + wc * 32 + 4 * fq;
#pragma unroll
        for (int ai = 0; ai < 2; ++ai)
#pragma unroll
            for (int m = 0; m < 4; ++m) { const int row = row0 + ai * HALF + m * 16; const size_t ro = (size_t)row * 2048 + col0;
                float s = 0.f;
#pragma unroll
                for (int bj = 0; bj < 2; ++bj)
#pragma unroll
                    for (int n = 0; n < 2; ++n) { f32x4 r;
                        if (R32) r = *(const f32x4*)(R32 + ro + bj * HALF + n * 16);
                        else { typedef unsigned u32x2_t __attribute__((ext_vector_type(2))); const u32x2_t rw = *(const u32x2_t*)(R16 + ro + bj * HALF + n * 16); const unsigned r0 = rw.x, r1 = rw.y;
                            r = (f32x4){__builtin_bit_cast(float, r0 << 16), __builtin_bit_cast(float, r0 & 0xffff0000u), __builtin_bit_cast(float, r1 << 16), __builtin_bit_cast(float, r1 & 0xffff0000u)}; }
                        const f32x4 v = acc[ai][bj][m][n] + r;
                        typedef unsigned u32x2_s __attribute__((ext_vector_type(2))); u32x2_s w; w.x = cvt_pk_bf16(v[0], v[1]); w.y = cvt_pk_bf16(v[2], v[3]);
                        *(u32x2_s*)(XB + ro + bj * HALF + n * 16) = w;
                        s += (v[0] * v[0] + v[1] * v[1]) + (v[2] * v[2] + v[3] * v[3]); }
                s += __shfl_xor(s, 16); s += __shfl_xor(s, 32);
                if (fq == 0) ss2[(size_t)(u.pn * 4 + wc) * MT + row] = s; }
    }
};
struct EpiB16 {
    static constexpr bool PERM = true, AFTER_DRAIN = false;
    bf16_t* O; int ldc;
    __device__ __forceinline__ void operator()(const f32x4 (&acc)[2][2][4][2], const Unit& u, int wr, int wc, int fr, int fq) const {
        const int row0 = u.pm * BM + wr * 64 + fr, col0 = u.pn * BM + wc * 32 + 8 * fq;
#pragma unroll
        for (int ai = 0; ai < 2; ++ai)
#pragma unroll
            for (int m = 0; m < 4; ++m) { bf16_t* rowp = O + (size_t)(row0 + ai * HALF + m * 16) * ldc + col0;
#pragma unroll
                for (int bj = 0; bj < 2; ++bj) { const f32x4 v0 = acc[ai][bj][m][0], v1 = acc[ai][bj][m][1];
                    u32x4 w; w.x = cvt_pk_bf16(v0[0], v0[1]); w.y = cvt_pk_bf16(v0[2], v0[3]); w.z = cvt_pk_bf16(v1[0], v1[1]); w.w = cvt_pk_bf16(v1[2], v1[3]);
                    *(u32x4*)(rowp + bj * HALF) = w; } }
    }
};
struct EpiSwp {
    static constexpr bool PERM = true, AFTER_DRAIN = false;
    bf16_t* O; int ldc; const float* rstd;
    __device__ __forceinline__ void operator()(const f32x4 (&acc)[2][2][4][2], const Unit& u, int wr, int wc, int fr, int fq) const {
        const int row0 = u.pm * BM + wr * 64 + fr, col0 = u.pn * BM + wc * 32 + 8 * fq;
        f32x4 ra[2], rb[2];
#pragma unroll
        for (int bj = 0; bj < 2; ++bj) { ra[bj] = *(const f32x4*)(rstd + col0 + bj * HALF); rb[bj] = *(const f32x4*)(rstd + col0 + bj * HALF + 4); }
#pragma unroll
        for (int ai = 0; ai < 2; ++ai)
#pragma unroll
            for (int m = 0; m < 4; ++m) { bf16_t* rowp = O + (size_t)(row0 + ai * HALF + m * 16) * ldc + col0;
#pragma unroll
                for (int bj = 0; bj < 2; ++bj) { const f32x4 v0 = acc[ai][bj][m][0] * ra[bj], v1 = acc[ai][bj][m][1] * rb[bj];
                    u32x4 w; w.x = cvt_pk_bf16(v0[0], v0[1]); w.y = cvt_pk_bf16(v0[2], v0[3]); w.z = cvt_pk_bf16(v1[0], v1[1]); w.w = cvt_pk_bf16(v1[2], v1[3]);
                    *(u32x4*)(rowp + bj * HALF) = w; } }
    }
};
template <class Epi, class Sched, bool ALIGN_EPI = false, bool SP2 = false>
__device__ __forceinline__ void gemm_phase(PG8_LAS unsigned char* lds, const Gemm g, const Sched& S, const Epi& E, int wave_in) {
    int tid_ = wave_in * 64 + (int)__builtin_amdgcn_mbcnt_hi(~0u, __builtin_amdgcn_mbcnt_lo(~0u, 0u)); asm volatile("" : "+v"(tid_));
    const int tid = tid_, wid = __builtin_amdgcn_readfirstlane(tid >> 6), lane = tid & 63, wr = wid >> 2, wc = wid & 3, fr = lane & 15, fq = lane >> 4;
    const int K = g.K, nt = K / BK;
    unsigned voffA[2], voffB[2];
#pragma unroll
    for (int i = 0; i < 2; ++i) { int R, C; stage_rc(tid * 16 + i * 8192, R, C); const int Rb = Epi::PERM ? ((R & ~31) + perm32(R & 31)) : R;
        voffA[i] = (unsigned)(R * K + C) * 2u; voffB[i] = (unsigned)(Rb * K + C) * 2u; }
    const size_t kstep = (size_t)(BK * 2);
    const size_t hstep = (size_t)HALF * K * 2;
    const size_t tstep = 2 * hstep;
    const unsigned ldsw = (unsigned)wid * 1024u;
    const int aoff = lds_byte(wr * 64 + fr, fq * 8), boff = lds_byte(wc * 32 + fr, fq * 8);
#define PG8_SA(b, h) (((b) * 2 + (h)) * HTB)
#define PG8_SB(b, h) ((4 + (b) * 2 + (h)) * HTB)
#define PG8_STAGE(bufoff, gbase, voff) do { _Pragma("unroll") for (int _i = 0; _i < 2; ++_i) \
        __builtin_amdgcn_global_load_lds((const unsigned*)((const char*)(gbase) + (voff)[_i]), (PG8_LAS unsigned*)(lds + (bufoff) + ldsw + _i * 8192), 16, 0, 0); } while (0)
#define PG8_LDA(dst, b, h) do { _Pragma("unroll") for (int m = 0; m < 4; ++m) _Pragma("unroll") for (int k = 0; k < 2; ++k) dst[m][k] = *(const PG8_LAS bf16x8*)(lds + PG8_SA(b, h) + aoff + m * 2048 + k * 1024); } while (0)
#define PG8_LDB(dst, b, h) do { _Pragma("unroll") for (int n = 0; n < 2; ++n) _Pragma("unroll") for (int k = 0; k < 2; ++k) dst[n][k] = *(const PG8_LAS bf16x8*)(lds + PG8_SB(b, h) + boff + n * 2048 + k * 1024); } while (0)
#define PG8_MMA(ai, bj, At, Bt) do { __builtin_amdgcn_s_setprio(1); _Pragma("unroll") for (int m = 0; m < 4; ++m) _Pragma("unroll") for (int n = 0; n < 2; ++n) _Pragma("unroll") for (int k = 0; k < 2; ++k) \
        acc[ai][bj][m][n] = __builtin_amdgcn_mfma_f32_16x16x32_bf16(Bt[n][k], At[m][k], acc[ai][bj][m][n], 0, 0, 0); __builtin_amdgcn_s_setprio(0); } while (0)
#define PG8_WAIT_V(n) asm volatile("s_waitcnt vmcnt(" #n ")" ::: "memory")
#define PG8_WAIT_L(n) asm volatile("s_waitcnt lgkmcnt(" #n ")" ::: "memory")
#define PG8_BAR __builtin_amdgcn_s_barrier()
#define PG8_SCHED __builtin_amdgcn_sched_barrier(0)
    Unit cur, nxt; int ui = 0;
    if (!S.next(0, cur)) return;
    f32x4 acc[2][2][4][2];
#pragma unroll
    for (int a = 0; a < 2; ++a)
#pragma unroll
        for (int b = 0; b < 2; ++b)
#pragma unroll
            for (int m = 0; m < 4; ++m)
#pragma unroll
                for (int n = 0; n < 2; ++n) acc[a][b][m][n] = (f32x4){0.f, 0.f, 0.f, 0.f};
    bf16x8 At[4][2], B0[2][2], B1[2][2];
    const char* cA = (const char*)g.A + (size_t)cur.pm * tstep; const char* cB = (const char*)g.Bt + (size_t)cur.pn * tstep;
    S.a_ready(cur);
    if constexpr (SP2) {
        PG8_STAGE(PG8_SB(0, 0), cB, voffB); PG8_STAGE(PG8_SB(0, 1), cB + hstep, voffB); PG8_STAGE(PG8_SA(0, 0), cA, voffA); PG8_STAGE(PG8_SA(0, 1), cA + hstep, voffA);
        if (wr == 1) PG8_BAR;
        PG8_WAIT_V(2); PG8_BAR;
        PG8_STAGE(PG8_SB(1, 0), cB + kstep, voffB); PG8_STAGE(PG8_SA(1, 0), cA + kstep, voffA); PG8_STAGE(PG8_SB(1, 1), cB + hstep + kstep, voffB);
        PG8_WAIT_V(6); PG8_BAR;
    } else {
        PG8_STAGE(PG8_SB(0, 0), cB, voffB); PG8_STAGE(PG8_SA(0, 0), cA, voffA); PG8_STAGE(PG8_SB(0, 1), cB + hstep, voffB); PG8_STAGE(PG8_SA(0, 1), cA + hstep, voffA);
        if (wr == 1) PG8_BAR;
        PG8_WAIT_V(4); PG8_BAR;
        PG8_STAGE(PG8_SB(1, 0), cB + kstep, voffB); PG8_STAGE(PG8_SA(1, 0), cA + kstep, voffA); PG8_STAGE(PG8_SB(1, 1), cB + hstep + kstep, voffB);
        PG8_WAIT_V(6); PG8_BAR;
    }
    for (;;) {
        const bool has_next = S.next(ui + 1, nxt);
        const char* nA = has_next ? (const char*)g.A + (size_t)nxt.pm * tstep : cA; const char* nB = has_next ? (const char*)g.Bt + (size_t)nxt.pn * tstep : cB;
        for (int t = 0; t < nt; t += 2) {
            const bool last = (t == nt - 2);
            const char* a1 = cA + (size_t)(t + 1) * kstep;
            const char* a2 = last ? nA : cA + (size_t)(t + 2) * kstep; const char* b2 = last ? nB : cB + (size_t)(t + 2) * kstep;
            const char* a3 = a2 + kstep; const char* b3 = b2 + kstep;
            if (last && has_next) S.a_ready(nxt);
            if constexpr (SP2) {
            PG8_LDB(B0, 0, 0); PG8_LDB(B1, 0, 1); PG8_SCHED; PG8_LDA(At, 0, 0); PG8_STAGE(PG8_SA(1, 1), a1 + hstep, voffA);
            PG8_WAIT_V(8); PG8_WAIT_L(0); PG8_BAR; PG8_MMA(0, 0, At, B0); PG8_MMA(0, 1, At, B1); PG8_BAR; PG8_SCHED;
            PG8_LDA(At, 0, 1); PG8_STAGE(PG8_SB(0, 0), b2, voffB); PG8_STAGE(PG8_SB(0, 1), b2 + hstep, voffB); PG8_STAGE(PG8_SA(0, 0), a2, voffA);
            PG8_WAIT_V(8); PG8_WAIT_L(0); PG8_BAR; PG8_MMA(1, 0, At, B0); PG8_MMA(1, 1, At, B1); PG8_BAR; PG8_SCHED;
            PG8_LDB(B0, 1, 0); PG8_LDB(B1, 1, 1); PG8_SCHED; PG8_LDA(At, 1, 0); PG8_STAGE(PG8_SA(0, 1), a2 + hstep, voffA);
            PG8_WAIT_V(8); PG8_WAIT_L(0); PG8_BAR; PG8_MMA(0, 0, At, B0); PG8_MMA(0, 1, At, B1); PG8_BAR; PG8_SCHED;
            PG8_LDA(At, 1, 1); PG8_STAGE(PG8_SB(1, 0), b3, voffB); PG8_STAGE(PG8_SB(1, 1), b3 + hstep, voffB); PG8_STAGE(PG8_SA(1, 0), a3, voffA);
            PG8_WAIT_V(8); PG8_WAIT_L(0); PG8_BAR; PG8_MMA(1, 0, At, B0); PG8_MMA(1, 1, At, B1); PG8_BAR; PG8_SCHED;
            } else {
            PG8_LDB(B0, 0, 0); PG8_SCHED; PG8_LDA(At, 0, 0); PG8_STAGE(PG8_SA(1, 1), a1 + hstep, voffA);
            PG8_WAIT_L(8); PG8_BAR; PG8_WAIT_L(0); PG8_MMA(0, 0, At, B0); PG8_BAR; PG8_SCHED;
            PG8_LDB(B1, 0, 1); PG8_STAGE(PG8_SB(0, 0), b2, voffB);
            PG8_BAR; PG8_WAIT_L(0); PG8_MMA(0, 1, At, B1); PG8_BAR;
            PG8_LDA(At, 0, 1); PG8_STAGE(PG8_SA(0, 0), a2, voffA);
            PG8_BAR; PG8_WAIT_L(0); PG8_MMA(1, 0, At, B0); PG8_BAR; PG8_SCHED;
            PG8_STAGE(PG8_SB(0, 1), b2 + hstep, voffB);
            PG8_WAIT_V(6); PG8_BAR; PG8_MMA(1, 1, At, B1); PG8_BAR;
            PG8_LDB(B0, 1, 0); PG8_SCHED; PG8_LDA(At, 1, 0); PG8_STAGE(PG8_SA(0, 1), a2 + hstep, voffA);
            PG8_WAIT_L(8); PG8_BAR; PG8_WAIT_L(0); PG8_MMA(0, 0, At, B0); PG8_BAR; PG8_SCHED;
            PG8_LDB(B1, 1, 1); PG8_STAGE(PG8_SB(1, 0), b3, voffB);
            PG8_BAR; PG8_WAIT_L(0); PG8_MMA(0, 1, At, B1); PG8_BAR;
            PG8_LDA(At, 1, 1); PG8_STAGE(PG8_SA(1, 0), a3, voffA);
            PG8_BAR; PG8_WAIT_L(0); PG8_MMA(1, 0, At, B0); PG8_BAR; PG8_SCHED;
            PG8_STAGE(PG8_SB(1, 1), b3 + hstep, voffB);
            PG8_WAIT_V(6); PG8_BAR; PG8_MMA(1, 1, At, B1); PG8_BAR;
            }
        }
        if constexpr (ALIGN_EPI) { if (wr == 0) PG8_BAR; }
        if constexpr (!Epi::AFTER_DRAIN) { E(acc, cur, wr, wc, fr, fq); S.done(cur); }
        if (!has_next) break;
#pragma unroll
        for (int a = 0; a < 2; ++a)
#pragma unroll
            for (int b = 0; b < 2; ++b)
#pragma unroll
                for (int m = 0; m < 4; ++m)
#pragma unroll
                    for (int n = 0; n < 2; ++n) acc[a][b][m][n] = (f32x4){0.f, 0.f, 0.f, 0.f};
        cur = nxt; cA = nA; cB = nB; ++ui;
        if constexpr (ALIGN_EPI) { if (wr == 1) PG8_BAR; }
    }
    PG8_WAIT_V(0);
    if constexpr (!ALIGN_EPI) { if (wr == 0) PG8_BAR; }
    PG8_BAR;
    if constexpr (Epi::AFTER_DRAIN) { E.fused(acc, cur, wr, wc, fr, fq, lds, wid, lane); S.done(cur); }
#undef PG8_SA
#undef PG8_SB
#undef PG8_STAGE
#undef PG8_LDA
#undef PG8_LDB
#undef PG8_MMA
#undef PG8_WAIT_V
#undef PG8_WAIT_L
#undef PG8_BAR
#undef PG8_SCHED
}
}

constexpr int NWAVES = 8;
constexpr int T = 16384, D = 2048, S = 2048, NBATCH = 8, CH = 64, NCH = 32, NH = 8, HD = 128, DEPTH = 4, NEXP = 16384;
constexpr int TOKC = pg8::TOKC, SWPR = 2048, TOKP = pg8::TOKP, SWPP = pg8::SWPP, QPP = pg8::QPP;
constexpr int TK_QA = 0, TK_KA = 1024, TK_QR = 2048, TK_KR = 3072, TK_GR = 4096;
constexpr int SW_VA = 0, SW_VR = 1024;
constexpr float EPS = 1e-6f, LOG2E = 1.4426950408889634f;
constexpr int PH_PER_LAYER = 8, N_PHASES = 1 + DEPTH * PH_PER_LAYER;

constexpr size_t MiB = 1u << 20;
constexpr size_t WS_CTL = 0, CTL_ZERO_BYTES = 1 * MiB;
constexpr size_t WS_ROPE_TOK = 1 * MiB, WS_ROPE_TR = 2 * MiB, WS_KEYS = 3 * MiB, WS_SSQ = 5 * MiB, WS_EXP = 9 * MiB, WS_GATE = 17 * MiB, WS_SS2 = 25 * MiB;
constexpr size_t WS_WTOK = 32 * MiB, WS_WSWP = 112 * MiB, WS_WOUT = 160 * MiB, WS_WQ = 192 * MiB;
constexpr size_t WS_HN = 224 * MiB, WS_TOK = 288 * MiB, WS_SWP = 456 * MiB, WS_ST = 556 * MiB, WS_MIX = 620 * MiB, WS_XR = 684 * MiB, WS_QP = 812 * MiB, WS_H2 = 884 * MiB;
constexpr size_t WS_UB = 948 * MiB, WS_VB = 1012 * MiB, WS_SU = 1076 * MiB, WS_SV = 1077 * MiB, WS_END = 1078 * MiB;
static_assert(WS_KEYS + (size_t)DEPTH * 16 * 128 * 128 * 2 <= WS_SSQ && WS_SSQ + (size_t)16 * 4 * T * 4 <= WS_EXP && WS_EXP + (size_t)T * 128 * 4 <= WS_GATE && WS_GATE + (size_t)T * 128 * 4 <= WS_SS2 && WS_SS2 + (size_t)32 * T * 4 <= WS_WTOK, "ws map 1");
static_assert(WS_WTOK + (size_t)DEPTH * TOKC * D * 2 <= WS_WSWP && WS_WSWP + (size_t)DEPTH * SWPR * D * 2 <= WS_WOUT && WS_WOUT + (size_t)DEPTH * D * D * 2 <= WS_WQ && WS_WQ + (size_t)DEPTH * D * D * 2 <= WS_HN, "ws map 2");
static_assert(WS_HN + (size_t)T * D * 2 <= WS_TOK && WS_TOK + (size_t)T * TOKP * 2 <= WS_SWP && WS_SWP + (size_t)SWPR * SWPP * 2 <= WS_ST && WS_ST + (size_t)64 * 32 * 128 * 128 * 2 <= WS_MIX, "ws map 3");
static_assert(WS_MIX + (size_t)T * D * 2 <= WS_XR && WS_XR + (size_t)T * D * 2 <= WS_QP && WS_QP + (size_t)T * QPP * 2 <= WS_H2 && WS_H2 + (size_t)T * D * 2 <= WS_UB, "ws map 4");
static_assert(WS_UB + (size_t)DEPTH * NEXP * D / 2 <= WS_VB && WS_VB + (size_t)DEPTH * NEXP * D / 2 <= WS_SU && WS_SU + (size_t)DEPTH * NEXP * 4 <= WS_SV && WS_SV + (size_t)DEPTH * NEXP * 4 <= WS_END, "ws map 5");
constexpr size_t WS_RSTD = WS_SV;
constexpr int CW_BAR = 4096;

constexpr int RING_OFF = 0, RING_BYTES = 131072;
constexpr int LDSCTL_OFF = RING_BYTES, MISC_OFF = LDSCTL_OFF + 320;
constexpr int LDS_BYTES = 147456;

#define GAS __attribute__((address_space(1)))
#define LAS __attribute__((address_space(3)))
typedef unsigned short bf16;
typedef short bf16x8 __attribute__((ext_vector_type(8)));
typedef float f32x4 __attribute__((ext_vector_type(4)));
typedef float f32x2 __attribute__((ext_vector_type(2)));
typedef unsigned u32x4 __attribute__((ext_vector_type(4)));
typedef unsigned u32x2 __attribute__((ext_vector_type(2)));
#define LDS_WAIT() asm volatile("s_waitcnt lgkmcnt(0)" ::: "memory")
__device__ __forceinline__ unsigned f2bf(float f) { unsigned u = __builtin_bit_cast(unsigned, f); return (u + 0x7fffu + ((u >> 16) & 1u)) >> 16; }
__device__ __forceinline__ unsigned pk2(float lo, float hi) { return f2bf(lo) | (f2bf(hi) << 16); }
__device__ __forceinline__ float bf_lo(unsigned w) { return __builtin_bit_cast(float, w << 16); }
__device__ __forceinline__ float bf_hi(unsigned w) { return __builtin_bit_cast(float, w & 0xffff0000u); }
__device__ __forceinline__ bf16x8 ld_b8(const bf16* p) { return *(const GAS bf16x8*)p; }
__device__ __forceinline__ u32x4 ld_u4(const void* p) { return *(const GAS u32x4*)p; }
__device__ __forceinline__ u32x2 ld_u2(const void* p) { return *(const GAS u32x2*)p; }
__device__ __forceinline__ f32x4 ld_f4(const float* p) { return *(const GAS f32x4*)p; }
__device__ __forceinline__ void st_u2(void* p, u32x2 v) { *(GAS u32x2*)p = v; }
__device__ __forceinline__ void st_u4(void* p, u32x4 v) { *(GAS u32x4*)p = v; }
__device__ __forceinline__ void st_f4(float* p, f32x4 v) { *(GAS f32x4*)p = v; }
__device__ __forceinline__ f32x4 mfma16(bf16x8 a, bf16x8 b, f32x4 c) { return __builtin_amdgcn_mfma_f32_16x16x32_bf16(a, b, c, 0, 0, 0); }
__device__ __forceinline__ bf16x8 pack8(f32x4 a, f32x4 b) {
    u32x4 w; w.x = pk2(a[0], a[1]); w.y = pk2(a[2], a[3]); w.z = pk2(b[0], b[1]); w.w = pk2(b[2], b[3]); return __builtin_bit_cast(bf16x8, w);
}
__device__ __forceinline__ float wave_sum(float v) {
#pragma unroll
    for (int o = 1; o < 64; o <<= 1) v += __shfl_xor(v, o);
    return v;
}
__device__ __forceinline__ float rq_sum(float v) { v += __shfl_xor(v, 16); v += __shfl_xor(v, 32); return v; }
__device__ __forceinline__ float rq_max(float v) { v = fmaxf(v, __shfl_xor(v, 16)); v = fmaxf(v, __shfl_xor(v, 32)); return v; }
__device__ __forceinline__ int lane_id() { return (int)__builtin_amdgcn_mbcnt_hi(~0u, __builtin_amdgcn_mbcnt_lo(~0u, 0u)); }
__device__ __forceinline__ float fexp2(float x) { return __builtin_amdgcn_exp2f(x); }
__device__ __forceinline__ float frsq(float x) { return __builtin_amdgcn_rsqf(x); }

#define XB_TMO      128
#define XB_XCNT(j)  (256  + 64 * (j))
#define XB_XSUB(j)  (1280 + 64 * (j))
#define XB_XGEN(j)  (2304 + 64 * (j))
#define XB_TOP      3328
#define XB_TOPGEN   3392
#define XCD_BAR_WORDS 3456
#define XB_SPIN_CAP (1u << 20)
__device__ __forceinline__ unsigned xb_ld(unsigned* p)              { return __hip_atomic_load(p, __ATOMIC_RELAXED, __HIP_MEMORY_SCOPE_AGENT); }
__device__ __forceinline__ unsigned xb_add(unsigned* p, unsigned v) { return __hip_atomic_fetch_add(p, v, __ATOMIC_RELAXED, __HIP_MEMORY_SCOPE_AGENT); }
__device__ __forceinline__ unsigned xb_xcc_id() { return (unsigned)__builtin_amdgcn_s_getreg((3 << 11) | 20) & 0xFu; }
#define XB_SPIN(cond, bar) do { unsigned _sp = 0; while (cond) { __builtin_amdgcn_s_sleep(1); \
    if ((++_sp & 255u) == 0u) { if (xb_ld(&(bar)[XB_TMO])) break; if (_sp > XB_SPIN_CAP) { atomicAdd(&(bar)[XB_TMO], 1u); break; } } } } while (0)
struct XcdBarrier { unsigned* bar; unsigned x; volatile LAS unsigned* st; };
__device__ __forceinline__ XcdBarrier xcd_barrier_post(unsigned* bar, volatile LAS unsigned* st) {
    XcdBarrier b; b.bar = bar; b.x = xb_xcc_id(); b.st = st;
    if (threadIdx.x == 0) (void)xb_add(&bar[XB_XCNT(b.x)], 1u);
    return b;
}
__device__ __forceinline__ void xcd_barrier_complete(unsigned* bar, unsigned x, unsigned& nloc, unsigned& nx) {
    const unsigned G = gridDim.x * gridDim.y * gridDim.z;
    unsigned sum, cnt, mine, sp = 0u;
    for (;;) {
        sum = 0u; cnt = 0u; mine = 0u;
#pragma unroll
        for (unsigned j = 0; j < 16; ++j) { const unsigned c = xb_ld(&bar[XB_XCNT(j)]); sum += c; cnt += (c > 0u) ? 1u : 0u; mine = (j == x) ? c : mine; }
        if (sum == G) break;
        __builtin_amdgcn_s_sleep(1);
        if ((++sp & 255u) == 0u) { if (xb_ld(&bar[XB_TMO])) break; if (sp > XB_SPIN_CAP) { atomicAdd(&bar[XB_TMO], 1u); break; } }
    }
    nloc = mine > 0u ? mine : 1u; nx = cnt > 0u ? cnt : 1u;
}
__device__ __forceinline__ void xcd_barrier(const XcdBarrier& b, int wave) {
    asm volatile("s_waitcnt vmcnt(0)" ::: "memory");
    __syncthreads();
    if (wave == 0 && lane_id() == 0) {
        unsigned* bar = b.bar;
        __builtin_amdgcn_s_waitcnt(0);
        unsigned nloc = b.st[0], nx = b.st[1];
        if (nloc == 0u) { xcd_barrier_complete(bar, b.x, nloc, nx); b.st[0] = nloc; b.st[1] = nx; }
        const unsigned old = xb_add(&bar[XB_XSUB(b.x)], 1u);
        const unsigned gen = old / nloc;
        if (old + 1u == (gen + 1u) * nloc) {
            __builtin_amdgcn_fence(__ATOMIC_RELEASE, "agent");
            asm volatile("s_waitcnt vmcnt(0)" ::: "memory");
            const unsigned og = xb_add(&bar[XB_TOP], 1u);
            const unsigned tg = og / nx;
            if (og + 1u == (tg + 1u) * nx) xb_add(&bar[XB_TOPGEN], 1u);
            else XB_SPIN(xb_ld(&bar[XB_TOPGEN]) == tg, bar);
            __builtin_amdgcn_fence(__ATOMIC_ACQUIRE, "agent");
            xb_add(&bar[XB_XGEN(b.x)], 1u);
            asm volatile("s_waitcnt vmcnt(0)" ::: "memory");
        } else {
            XB_SPIN(xb_ld(&bar[XB_XGEN(b.x)]) == gen, bar);
            __builtin_amdgcn_fence(__ATOMIC_ACQUIRE, "agent");
            asm volatile("s_waitcnt vmcnt(0)" ::: "memory");
        }
    }
    __syncthreads();
}

struct Frame {
    LAS unsigned char* lds;
    int wave, G, gw, ngw;
    const float *x, *norm1_g, *w_in, *qa_g, *ka_g, *rel_bias, *attn_g, *ret_g, *w_out, *norm2_g, *peer_wq, *peer_keys, *peer_u, *peer_v;
    float* out; unsigned char* ws;
};

template <class DstFn>
__device__ __forceinline__ void transpose_item(const float* W, int K, int N, LAS float* scr, int item, int lane, DstFn dst, const float* kscale = nullptr) {
    const int nblk = N / 32, kb = item / nblk, nb = item % nblk, k0 = 64 * kb, n0 = 32 * nb;
#pragma unroll
    for (int i = 0; i < 32; ++i) { const int kk = 2 * i + (lane >> 5); float wv = *(const GAS float*)(W + (size_t)(k0 + kk) * N + n0 + (lane & 31));
        scr[kk * 33 + (lane & 31)] = wv; }
    LDS_WAIT(); asm volatile("" ::: "memory");
    const int c = lane & 7;
    f32x4 ka = (f32x4){1.f, 1.f, 1.f, 1.f}, kb4 = ka;
    if (kscale) { ka = ld_f4(kscale + k0 + 8 * c); kb4 = ld_f4(kscale + k0 + 8 * c + 4); }
#pragma unroll
    for (int j = 0; j < 4; ++j) { const int n = (lane >> 3) + 8 * j; const LAS float* s = scr + (8 * c) * 33 + n;
        u32x4 o; o.x = pk2(s[0 * 33] * ka[0], s[1 * 33] * ka[1]); o.y = pk2(s[2 * 33] * ka[2], s[3 * 33] * ka[3]); o.z = pk2(s[4 * 33] * kb4[0], s[5 * 33] * kb4[1]); o.w = pk2(s[6 * 33] * kb4[2], s[7 * 33] * kb4[3]);
        dst(n0 + n, k0 + 8 * c, o); }
    LDS_WAIT(); asm volatile("" ::: "memory");
}
__device__ __forceinline__ void rms_row_to_bf16(const float* xrow, const float* g, bf16* orow, int lane) {
    asm volatile("" : "+v"(lane));
    f32x4 v[8]; float s = 0.f;
#pragma unroll
    for (int j = 0; j < 8; ++j) { v[j] = ld_f4(xrow + (j * 64 + lane) * 4); s += (v[j][0] * v[j][0] + v[j][1] * v[j][1]) + (v[j][2] * v[j][2] + v[j][3] * v[j][3]); }
    const float rstd = frsq(wave_sum(s) * (1.f / D) + EPS);
#pragma unroll
    for (int j = 0; j < 8; ++j) { const f32x4 gg = ld_f4(g + (j * 64 + lane) * 4);
        u32x2 o; o.x = pk2(v[j][0] * rstd * gg[0], v[j][1] * rstd * gg[1]); o.y = pk2(v[j][2] * rstd * gg[2], v[j][3] * rstd * gg[3]);
        st_u2(orow + (j * 64 + lane) * 4, o); }
}
__device__ __forceinline__ void row_to_fp4(const float* src, unsigned char* dst, size_t slice_stride, unsigned short* scale_out, int lane) {
    f32x4 v[8]; float mx = 0.f;
#pragma unroll
    for (int q = 0; q < 8; ++q) { v[q] = ld_f4(src + q * 256 + lane * 4);
        mx = fmaxf(mx, fmaxf(fmaxf(__builtin_fabsf(v[q][0]), __builtin_fabsf(v[q][1])), fmaxf(__builtin_fabsf(v[q][2]), __builtin_fabsf(v[q][3])))); }
#pragma unroll
    for (int o = 1; o < 64; o <<= 1) mx = fmaxf(mx, __shfl_xor(mx, o));
    const float sc = mx > 0.f ? bf_lo(f2bf(mx * (1.0f / 6.0f)) ) : 1.0f, inv = 1.0f / sc;
#pragma unroll
    for (int q = 0; q < 8; ++q) { const f32x4 a = v[q] * inv;
        unsigned w = 0u;
        w = __builtin_amdgcn_cvt_scalef32_pk_fp4_f32(w, a[0], a[1], 1.0f, 0); w = __builtin_amdgcn_cvt_scalef32_pk_fp4_f32(w, a[2], a[3], 1.0f, 1);
        *(GAS unsigned short*)(dst + (size_t)q * slice_stride + lane * 2) = (unsigned short)w; }
    if (lane == 0) *(GAS unsigned short*)scale_out = (unsigned short)f2bf(sc);
}
__device__ __forceinline__ void p0_prologue(const Frame& F) {
    LAS float* scr = (LAS float*)(F.lds + RING_OFF + F.wave * 16384);
    int lane = lane_id(); asm volatile("" : "+v"(lane));
    bf16* Wtok = (bf16*)(F.ws + WS_WTOK); bf16* Wswp = (bf16*)(F.ws + WS_WSWP); bf16* Wout = (bf16*)(F.ws + WS_WOUT); bf16* Wq = (bf16*)(F.ws + WS_WQ);
    constexpr int IN_COLS = 7168;
    constexpr int I_IN = (D / 64) * (IN_COLS / 32), I_SQ = (D / 64) * (D / 32), I_L = I_IN + 2 * I_SQ, NITEMS = DEPTH * I_L;
    for (int it = F.gw; it < NITEMS; it += F.ngw) {
        const int l = it / I_L; int r = it % I_L;
        if (r < I_IN) {
            bf16* wt = Wtok + (size_t)l * TOKC * D; bf16* wsw = Wswp + (size_t)l * SWPR * D;
            transpose_item(F.w_in + (size_t)l * D * IN_COLS, D, IN_COLS, scr, r, lane, [=](int n, int k, u32x4 o) {
                const int seg = n >> 10, nn = n & 1023, dd = n & 127, dp = (n & 896) + 2 * (dd & 63) + (dd >> 6);
                if (seg == 0) st_u4(wt + (size_t)(TK_QA + nn) * D + k, o);
                else if (seg == 1) st_u4(wt + (size_t)(TK_KA + nn) * D + k, o);
                else if (seg == 2) st_u4(wsw + (size_t)(SW_VA + nn) * D + k, o);
                else if (seg == 3) st_u4(wt + (size_t)(TK_QR + dp) * D + k, o);
                else if (seg == 4) st_u4(wt + (size_t)(TK_KR + dp) * D + k, o);
                else if (seg == 5) st_u4(wsw + (size_t)(SW_VR + nn) * D + k, o);
                else st_u4(wt + (size_t)(TK_GR + nn) * D + k, o);
            }, F.norm1_g + l * D);
            continue;
        }
        r -= I_IN;
        if (r < I_SQ) { bf16* wo = Wout + (size_t)l * D * D;
            transpose_item(F.w_out + (size_t)l * D * D, D, D, scr, r, lane, [=](int n, int k, u32x4 o) { st_u4(wo + (size_t)n * D + k, o); }); continue; }
        r -= I_SQ;
        { bf16* wq = Wq + (size_t)l * D * D;
            transpose_item(F.peer_wq + (size_t)l * D * D, D, D, scr, r, lane, [=](int n, int k, u32x4 o) { st_u4(wq + (size_t)n * D + k, o); }, F.norm2_g + l * D); }
    }
    {
        bf16* XR0 = (bf16*)(F.ws + WS_XR); float* RSTD = (float*)(F.ws + WS_RSTD);
        for (int m = F.gw; m < T; m += F.ngw) {
            const float* xrow = F.x + (size_t)m * D;
            f32x4 v[8]; float s = 0.f;
#pragma unroll
            for (int j = 0; j < 8; ++j) { v[j] = ld_f4(xrow + (j * 64 + lane) * 4); s += (v[j][0] * v[j][0] + v[j][1] * v[j][1]) + (v[j][2] * v[j][2] + v[j][3] * v[j][3]); }
            const float rstd = frsq(wave_sum(s) * (1.f / D) + EPS);
#pragma unroll
            for (int j = 0; j < 8; ++j) { u32x2 o; o.x = pk2(v[j][0], v[j][1]); o.y = pk2(v[j][2], v[j][3]); st_u2(XR0 + (size_t)m * D + (j * 64 + lane) * 4, o); }
            if (lane == 0) *(GAS float*)(RSTD + m) = rstd;
        }
    }
    {
        unsigned char* UB = (unsigned char*)(F.ws + WS_UB); unsigned char* VB = (unsigned char*)(F.ws + WS_VB);
        unsigned short* SUV = (unsigned short*)(F.ws + WS_SU);
        const int nrows = DEPTH * NEXP;
        for (int r = F.gw; r < 2 * nrows; r += F.ngw) {
            const bool isv = r >= nrows; const int rr = isv ? r - nrows : r;
            row_to_fp4((isv ? F.peer_v : F.peer_u) + (size_t)rr * D, (isv ? VB : UB) + (size_t)(rr / NEXP) * NEXP * (D / 2) + (size_t)(rr % NEXP) * 128, (size_t)NEXP * 128, SUV + 2 * (size_t)rr + (isv ? 1 : 0), lane);
        }
        const size_t nK = (size_t)DEPTH * 16 * 128 * 128 / 8;
        bf16* KB = (bf16*)(F.ws + WS_KEYS);
        const size_t stride = (size_t)F.ngw * 64, start = (size_t)F.gw * 64 + lane;
        for (size_t i = start; i < nK; i += stride) {
            const f32x4 a = ld_f4(F.peer_keys + i * 8), b = ld_f4(F.peer_keys + i * 8 + 4);
            u32x4 o; o.x = pk2(a[0], a[1]); o.y = pk2(a[2], a[3]); o.z = pk2(b[0], b[1]); o.w = pk2(b[2], b[3]); st_u4(KB + i * 8, o);
        }
    }
    {
        f32x2* ct = (f32x2*)(F.ws + WS_ROPE_TOK);
        for (int e = F.gw * 64 + lane; e < S * 64; e += F.ngw * 64) {
            const int pos = e >> 6, i = e & 63;
            const float invf = exp2f(-(float)i * 0.20762050593046014f);
            const double rev = (double)pos * (double)invf * 0.15915494309189535;
            const float fr = (float)(rev - __builtin_floor(rev));
            const f32x2 v = {__builtin_amdgcn_cosf(fr), __builtin_amdgcn_sinf(fr)};
            ct[(size_t)pos * 64 + i] = v;
        }
    }
}

constexpr int A_KP = 272, A_VP = 144;
constexpr int A_KBUF = 0, A_VBUF = A_KBUF + 2 * 64 * A_KP, A_RK = A_VBUF + 2 * 128 * A_VP, A_BIAS = A_RK + 2 * 64 * 4, A_END = A_BIAS + NH * 257 * 4;
static_assert(A_END <= RING_BYTES, "attention LDS map");
__device__ __forceinline__ void attn_wg_task(const Frame& F, int l, int task) {
    int tid = F.wave * 64 + lane_id(); asm volatile("" : "+v"(tid));
    const int lane = tid & 63, c = lane & 15, rq = lane >> 4, wave = F.wave;
    const int cq = task & 7, h = (task >> 3) & 7, b = task >> 6;
    const bf16* TOK = (const bf16*)(F.ws + WS_TOK); const bf16* SWP = (const bf16*)(F.ws + WS_SWP); const float* SSQ = (const float*)(F.ws + WS_SSQ);
    bf16* MIX = (bf16*)(F.ws + WS_MIX);
    LAS unsigned char* lds = F.lds + RING_OFF;
    const LAS float* bh = (const LAS float*)(lds + A_BIAS) + h * 257;
    const int wch = wave >> 1;
    const int qi0 = (wave & 1) * 32 + c;
    const int tq0 = b * S + (4 * cq + wch) * CH + qi0;
    bf16x8 Qf[2][4];
#pragma unroll
    for (int qb = 0; qb < 2; ++qb) {
        const int tq = tq0 + qb * 16;
        float ssq = 0.f;
#pragma unroll
        for (int w = 0; w < 4; ++w) ssq += *(const GAS float*)(SSQ + (size_t)((0 * 8 + h) * 4 + w) * T + tq);
        const float rs = frsq(ssq * (1.f / HD) + EPS) * (pg8::KSCALE * LOG2E);
#pragma unroll
        for (int ks = 0; ks < 4; ++ks) {
            const float* gp = F.qa_g + l * HD + ks * 32 + rq * 8; const float* kp = F.ka_g + l * HD + ks * 32 + rq * 8;
            const f32x4 a0 = ld_f4(gp), a1 = ld_f4(gp + 4), b0 = ld_f4(kp), b1 = ld_f4(kp + 4);
            const u32x4 raw = ld_u4(TOK + (size_t)tq * TOKP + TK_QA + h * HD + ks * 32 + rq * 8);
            u32x4 o;
            o.x = pk2(bf_lo(raw.x) * rs * (a0[0] * b0[0]), bf_hi(raw.x) * rs * (a0[1] * b0[1])); o.y = pk2(bf_lo(raw.y) * rs * (a0[2] * b0[2]), bf_hi(raw.y) * rs * (a0[3] * b0[3]));
            o.z = pk2(bf_lo(raw.z) * rs * (a1[0] * b1[0]), bf_hi(raw.z) * rs * (a1[1] * b1[1])); o.w = pk2(bf_lo(raw.w) * rs * (a1[2] * b1[2]), bf_hi(raw.w) * rs * (a1[3] * b1[3]));
            Qf[qb][ks] = __builtin_bit_cast(bf16x8, o);
        }
    }
    float m_run[2] = {-1e30f, -1e30f}, l_run[2] = {0.f, 0.f};
    f32x4 O[2][8];
#pragma unroll
    for (int qb = 0; qb < 2; ++qb)
#pragma unroll
        for (int db = 0; db < 8; ++db) O[qb][db] = (f32x4){0.f, 0.f, 0.f, 0.f};
    const int p0 = tid, p1 = tid + 512;
    const int kr0 = p0 >> 4, kr1 = p1 >> 4;
    const int kl0 = (kr0 & 32) + ((kr0 >> 2) & 1) * 16 + ((kr0 >> 3) & 3) * 4 + (kr0 & 3), kl1 = (kr1 & 32) + ((kr1 >> 2) & 1) * 16 + ((kr1 >> 3) & 3) * 4 + (kr1 & 3);
    const bf16* gk0 = TOK + (size_t)(b * S + kr0) * TOKP + TK_KA + h * HD + (p0 & 15) * 8; const bf16* gk1 = TOK + (size_t)(b * S + kr1) * TOKP + TK_KA + h * HD + (p1 & 15) * 8;
    const bf16* gv0 = SWP + (size_t)(SW_VA + h * HD + (p0 >> 3)) * SWPP + b * S + (p0 & 7) * 8; const bf16* gv1 = SWP + (size_t)(SW_VA + h * HD + (p1 >> 3)) * SWPP + b * S + (p1 & 7) * 8;
    const int lk0 = A_KBUF + kl0 * A_KP + (p0 & 15) * 16, lk1 = A_KBUF + kl1 * A_KP + (p1 & 15) * 16;
    const int lv0 = A_VBUF + (p0 >> 3) * A_VP + (p0 & 7) * 16, lv1 = A_VBUF + (p1 >> 3) * A_VP + (p1 & 7) * 16;
    const float* gss = SSQ + (size_t)((8 + h) * 4) * T + b * S + (tid & 63);
    u32x4 r0, r1, r2, r3; float rkv = 0.f;
    const int kc0 = 4 * cq - 8, j0 = kc0 < 0 ? -kc0 : 0;
#define A_GLOAD(j) do { const int ko = (kc0 + (j)) * CH; r0 = ld_u4(gk0 + (size_t)ko * TOKP); r1 = ld_u4(gk1 + (size_t)ko * TOKP); r2 = ld_u4(gv0 + ko); r3 = ld_u4(gv1 + ko); \
        if (tid < 64) { float s_ = 0.f; _Pragma("unroll") for (int w = 0; w < 4; ++w) s_ += *(const GAS float*)(gss + (size_t)w * T + ko); rkv = frsq(s_ * (1.f / HD) + EPS); } } while (0)
#define A_LSTORE(bf) do { *(LAS u32x4*)(lds + lk0 + (bf) * 64 * A_KP) = r0; *(LAS u32x4*)(lds + lk1 + (bf) * 64 * A_KP) = r1; *(LAS u32x4*)(lds + lv0 + (bf) * 128 * A_VP) = r2; *(LAS u32x4*)(lds + lv1 + (bf) * 128 * A_VP) = r3; \
        if (tid < 64) ((LAS float*)(lds + A_RK))[(bf) * 64 + tid] = rkv; } while (0)
    __syncthreads();
    A_GLOAD(j0); A_LSTORE(j0 & 1);
    __syncthreads();
    for (int j = j0; j < 12; ++j) {
        if (j < 11) A_GLOAD(j + 1);
        const int tjr = j - wch;
        if (tjr >= 0 && tjr <= 8) {
            const LAS unsigned char* kb = lds + A_KBUF + (j & 1) * 64 * A_KP + c * A_KP + rq * 16;
            const LAS unsigned char* vb = lds + A_VBUF + (j & 1) * 128 * A_VP + c * A_VP + rq * 16;
            const LAS float* rkb = (const LAS float*)(lds + A_RK) + (j & 1) * 64;
            f32x4 sa[2][2][2];
#pragma unroll
            for (int g = 0; g < 2; ++g)
#pragma unroll
                for (int ab = 0; ab < 2; ++ab) { f32x4 a0 = (f32x4){0.f, 0.f, 0.f, 0.f}, a1 = (f32x4){0.f, 0.f, 0.f, 0.f};
#pragma unroll
                    for (int ks = 0; ks < 4; ++ks) { const bf16x8 kf = *(const LAS bf16x8*)(kb + (32 * g + 16 * ab) * A_KP + ks * 64); a0 = mfma16(kf, Qf[0][ks], a0); a1 = mfma16(kf, Qf[1][ks], a1); }
                    sa[0][g][ab] = a0; sa[1][g][ab] = a1; }
            const int relbase = 64 * (8 - tjr);
            float mx[2] = {-1e30f, -1e30f};
            if (tjr <= 5) {
                const float bc = bh[256];
#pragma unroll
                for (int g = 0; g < 2; ++g)
#pragma unroll
                    for (int ab = 0; ab < 2; ++ab) {
                        const f32x4 rk = *(const LAS f32x4*)(rkb + 32 * g + 8 * rq + 4 * ab);
#pragma unroll
                        for (int qb = 0; qb < 2; ++qb)
#pragma unroll
                            for (int e = 0; e < 4; ++e) { const float sv = sa[qb][g][ab][e] * rk[e] + bc; sa[qb][g][ab][e] = sv; mx[qb] = fmaxf(mx[qb], sv); }
                    }
            } else {
#pragma unroll
                for (int g = 0; g < 2; ++g)
#pragma unroll
                    for (int ab = 0; ab < 2; ++ab) {
                        const int kk0 = 32 * g + 8 * rq + 4 * ab;
                        const f32x4 rk = *(const LAS f32x4*)(rkb + kk0);
#pragma unroll
                        for (int qb = 0; qb < 2; ++qb)
#pragma unroll
                            for (int e = 0; e < 4; ++e) {
                                int rel = qi0 + qb * 16 - (kk0 + e) + relbase; rel = rel > 128 ? 128 : (rel < -128 ? -128 : rel);
                                const float sv = sa[qb][g][ab][e] * rk[e] + bh[rel + 128];
                                sa[qb][g][ab][e] = sv; mx[qb] = fmaxf(mx[qb], sv);
                            }
                    }
            }
            bf16x8 Pf[2][2];
            bool moved = false;
            float alpha[2];
#pragma unroll
            for (int qb = 0; qb < 2; ++qb) {
                const float mxr = rq_max(mx[qb]);
                const float mn = fmaxf(m_run[qb], mxr); alpha[qb] = fexp2(m_run[qb] - mn);
                moved = moved || (mn > m_run[qb]);
                float ps = 0.f;
#pragma unroll
                for (int g = 0; g < 2; ++g) {
#pragma unroll
                    for (int ab = 0; ab < 2; ++ab)
#pragma unroll
                        for (int e = 0; e < 4; ++e) { const float p = fexp2(sa[qb][g][ab][e] - mn); sa[qb][g][ab][e] = p; ps += p; }
                    Pf[qb][g] = pack8(sa[qb][g][0], sa[qb][g][1]);
                }
                l_run[qb] = l_run[qb] * alpha[qb] + ps; m_run[qb] = mn;
            }
            if (__any(moved)) {
#pragma unroll
                for (int qb = 0; qb < 2; ++qb)
#pragma unroll
                    for (int db = 0; db < 8; ++db) O[qb][db] *= alpha[qb];
            }
#pragma unroll
            for (int g = 0; g < 2; ++g)
#pragma unroll
                for (int db = 0; db < 8; ++db) { const bf16x8 vf = *(const LAS bf16x8*)(vb + db * 16 * A_VP + g * 64); O[0][db] = mfma16(vf, Pf[0][g], O[0][db]); O[1][db] = mfma16(vf, Pf[1][g], O[1][db]); }
        }
        if (j < 11) A_LSTORE((j + 1) & 1);
        __syncthreads();
    }
#undef A_GLOAD
#undef A_LSTORE
#pragma unroll
    for (int qb = 0; qb < 2; ++qb) {
        const int tq = tq0 + qb * 16;
        const float inv = 1.0f / rq_sum(l_run[qb]);
        float ss = 0.f;
#pragma unroll
        for (int db = 0; db < 8; ++db) { O[qb][db] *= inv; ss += (O[qb][db][0] * O[qb][db][0] + O[qb][db][1] * O[qb][db][1]) + (O[qb][db][2] * O[qb][db][2] + O[qb][db][3] * O[qb][db][3]); }
        const float rstd = frsq(rq_sum(ss) * (1.f / HD) + EPS);
#pragma unroll
        for (int db = 0; db < 8; ++db) {
            const int d0 = h * HD + db * 16 + rq * 4;
            const f32x4 g4 = ld_f4(F.attn_g + l * 1024 + d0);
            u32x2 o; o.x = pk2(O[qb][db][0] * rstd * g4[0], O[qb][db][1] * rstd * g4[1]); o.y = pk2(O[qb][db][2] * rstd * g4[2], O[qb][db][3] * rstd * g4[3]);
            st_u2(MIX + (size_t)tq * D + d0, o);
        }
    }
}

constexpr int SC_PITCH = 36, SC_WAVE_BYTES = 64 * SC_PITCH, SC_OFF = A_END;
static_assert(SC_OFF % 4 == 0 && SC_OFF + NWAVES * SC_WAVE_BYTES <= RING_BYTES, "scan LDS map");
struct ScanOps { u32x4 kp[2]; bf16x8 va[4][2]; };
__device__ __forceinline__ void scan_load(ScanOps& o, const bf16* kg, const bf16* vrow, int n) {
#pragma unroll
    for (int i = 0; i < 2; ++i) o.kp[i] = ld_u4(kg + (size_t)(n * CH + i * 32) * TOKP);
#pragma unroll
    for (int eb = 0; eb < 4; ++eb)
#pragma unroll
        for (int ks = 0; ks < 2; ++ks) o.va[eb][ks] = ld_b8(vrow + (size_t)eb * 16 * SWPP + n * CH + ks * 32);
}
__device__ __forceinline__ void scan_step(f32x4 (&st)[4], const ScanOps& o, const float (&dec)[16], LAS unsigned char* kw, const LAS unsigned char* kr, bf16* sp, int n, float cd) {
#pragma unroll
    for (int eb = 0; eb < 4; ++eb) { u32x2 w; w.x = pk2(st[eb][0], st[eb][1]); w.y = pk2(st[eb][2], st[eb][3]); st_u2(sp + (size_t)n * HD * HD + eb * 16 * HD, w); }
#pragma unroll
    for (int i = 0; i < 2; ++i)
#pragma unroll
        for (int d = 0; d < 4; ++d) *(LAS unsigned*)(kw + i * 32 * SC_PITCH + d * 4) = o.kp[i][d];
    LDS_WAIT(); asm volatile("" ::: "memory");
    bf16x8 ka[2];
#pragma unroll
    for (int ks = 0; ks < 2; ++ks) { u32x4 w;
#pragma unroll
        for (int j = 0; j < 4; ++j) { const unsigned e0 = *(const LAS unsigned short*)(kr + (ks * 32 + 2 * j) * SC_PITCH), e1 = *(const LAS unsigned short*)(kr + (ks * 32 + 2 * j + 1) * SC_PITCH);
            w[j] = pk2(bf_lo(e0) * dec[ks * 8 + 2 * j], bf_lo(e1) * dec[ks * 8 + 2 * j + 1]); }
        ka[ks] = __builtin_bit_cast(bf16x8, w); }
    LDS_WAIT(); asm volatile("" ::: "memory");
#pragma unroll
    for (int eb = 0; eb < 4; ++eb) { st[eb] *= cd;
#pragma unroll
        for (int ks = 0; ks < 2; ++ks) st[eb] = mfma16(ka[ks], o.va[eb][ks], st[eb]); }
}
__device__ __forceinline__ void scan_task(const Frame& F, int task) {
    int lane = lane_id(); asm volatile("" : "+v"(lane));
    const int c = lane & 15, rq = lane >> 4;
    const int eh = task & 1, db = (task >> 1) & 7, h = (task >> 4) & 7, b = task >> 7, bhh = b * NH + h;
    const bf16* TOK = (const bf16*)(F.ws + WS_TOK); const bf16* SWP = (const bf16*)(F.ws + WS_SWP); bf16* ST = (bf16*)(F.ws + WS_ST);
    const bf16* kg = TOK + (size_t)(b * S + (lane >> 1)) * TOKP + TK_KR + h * HD + db * 16 + (lane & 1) * 8;
    const bf16* vrow = SWP + (size_t)(SW_VR + h * HD + eh * 64 + c) * SWPP + b * S + rq * 8;
    bf16* sp = ST + ((size_t)bhh * NCH * HD + eh * 64 + c) * HD + db * 16 + rq * 4;
    LAS unsigned char* kt = F.lds + RING_OFF + SC_OFF + F.wave * SC_WAVE_BYTES;
    LAS unsigned char* kw = kt + (lane >> 1) * SC_PITCH + (lane & 1) * 16;
    const LAS unsigned char* kr = kt + (rq * 8) * SC_PITCH + c * 2;
    f32x4 st[4];
#pragma unroll
    for (int eb = 0; eb < 4; ++eb) st[eb] = (f32x4){0.f, 0.f, 0.f, 0.f};
    const float lg = pg8::lg2gamma(h), cd = fexp2(64.f * lg);
    float dec[16];
#pragma unroll
    for (int i = 0; i < 16; ++i) dec[i] = fexp2((float)(63 - ((i >> 3) * 32 + rq * 8 + (i & 7))) * lg);
    ScanOps o0, o1, o2;
    scan_load(o0, kg, vrow, 0); scan_load(o1, kg, vrow, 1);
    for (int n = 0; n < NCH - 1; n += 3) {
        if (n + 2 < NCH - 1) scan_load(o2, kg, vrow, n + 2);
        scan_step(st, o0, dec, kw, kr, sp, n, cd);
        if (n + 1 < NCH - 1) { if (n + 3 < NCH - 1) scan_load(o0, kg, vrow, n + 3); scan_step(st, o1, dec, kw, kr, sp, n + 1, cd); }
        if (n + 2 < NCH - 1) { if (n + 4 < NCH - 1) scan_load(o1, kg, vrow, n + 4); scan_step(st, o2, dec, kw, kr, sp, n + 2, cd); }
    }
#pragma unroll
    for (int eb = 0; eb < 4; ++eb) { u32x2 w; w.x = pk2(st[eb][0], st[eb][1]); w.y = pk2(st[eb][2], st[eb][3]); st_u2(sp + (size_t)(NCH - 1) * HD * HD + eb * 16 * HD, w); }
}

__device__ __forceinline__ void ret_task(const Frame& F, int l, int task) {
    int lane = lane_id(); asm volatile("" : "+v"(lane));
    const int c = lane & 15, rq = lane >> 4;
    const int qb2 = task & 1, n = (task >> 1) & 31, h = (task >> 6) & 7, b = task >> 9, bhh = b * NH + h;
    const bf16* TOK = (const bf16*)(F.ws + WS_TOK); const bf16* SWP = (const bf16*)(F.ws + WS_SWP); const bf16* ST = (const bf16*)(F.ws + WS_ST);
    bf16* MIX = (bf16*)(F.ws + WS_MIX);
    const int tc0 = b * S + n * CH, tq0 = tc0 + qb2 * 32;
    const float lg = pg8::lg2gamma(h);
    bf16x8 Qf[2][4], Kf[2][2][4];
#pragma unroll
    for (int qb = 0; qb < 2; ++qb)
#pragma unroll
        for (int ks = 0; ks < 4; ++ks) Qf[qb][ks] = ld_b8(TOK + (size_t)(tq0 + qb * 16 + c) * TOKP + TK_QR + h * HD + ks * 32 + rq * 8);
#pragma unroll
    for (int g = 0; g < 2; ++g)
#pragma unroll
        for (int ab = 0; ab < 2; ++ab) { const int key = 32 * g + (c >> 2) * 8 + 4 * ab + (c & 3);
#pragma unroll
            for (int ks = 0; ks < 4; ++ks) Kf[g][ab][ks] = ld_b8(TOK + (size_t)(tc0 + key) * TOKP + TK_KR + h * HD + rq * 8 + ks * 32); }
    f32x4 acc[2][8];
#pragma unroll
    for (int qb = 0; qb < 2; ++qb)
#pragma unroll
        for (int eb = 0; eb < 8; ++eb) acc[qb][eb] = (f32x4){0.f, 0.f, 0.f, 0.f};
    const bf16* sp = ST + (((size_t)bhh * NCH + n) * HD + c) * HD + rq * 8;
#pragma unroll
    for (int eb = 0; eb < 8; ++eb)
#pragma unroll
        for (int ks = 0; ks < 4; ++ks) { const bf16x8 sf = ld_b8(sp + eb * 16 * HD + ks * 32);
#pragma unroll
            for (int qb = 0; qb < 2; ++qb) acc[qb][eb] = mfma16(sf, Qf[qb][ks], acc[qb][eb]); }
    bf16x8 Vf[8];
#pragma unroll
    for (int eb = 0; eb < 8; ++eb) Vf[eb] = ld_b8(SWP + (size_t)(SW_VR + h * HD + eb * 16 + c) * SWPP + tc0 + 8 * rq);
#pragma unroll
    for (int qb = 0; qb < 2; ++qb) { const float f = fexp2((float)(qb2 * 32 + qb * 16 + c + 1) * lg);
#pragma unroll
        for (int eb = 0; eb < 8; ++eb) acc[qb][eb] *= f; }
    f32x4 g4[8]; u32x2 gwq[2][8];
#pragma unroll
    for (int g = 0; g < 2; ++g) {
        if (g <= qb2) {
            f32x4 sa[2][2];
#pragma unroll
            for (int qb = 0; qb < 2; ++qb)
#pragma unroll
                for (int ab = 0; ab < 2; ++ab) sa[qb][ab] = (f32x4){0.f, 0.f, 0.f, 0.f};
#pragma unroll
            for (int ab = 0; ab < 2; ++ab)
#pragma unroll
                for (int ks = 0; ks < 4; ++ks)
#pragma unroll
                    for (int qb = 0; qb < 2; ++qb) sa[qb][ab] = mfma16(Kf[g][ab][ks], Qf[qb][ks], sa[qb][ab]);
            bf16x8 Pf[2];
#pragma unroll
            for (int qb = 0; qb < 2; ++qb) {
                const int i = qb2 * 32 + qb * 16 + c;
#pragma unroll
                for (int ab = 0; ab < 2; ++ab)
#pragma unroll
                    for (int e = 0; e < 4; ++e) { const int diff = i - (32 * g + 8 * rq + 4 * ab + e);
                        sa[qb][ab][e] = diff >= 0 ? sa[qb][ab][e] * fexp2((float)diff * lg) : 0.f; }
                Pf[qb] = pack8(sa[qb][0], sa[qb][1]);
            }
#pragma unroll
            for (int eb = 0; eb < 8; ++eb)
#pragma unroll
                for (int qb = 0; qb < 2; ++qb) acc[qb][eb] = mfma16(Vf[eb], Pf[qb], acc[qb][eb]);
        }
        if (g == 0) {
            if (qb2) {
#pragma unroll
                for (int eb = 0; eb < 8; ++eb) Vf[eb] = ld_b8(SWP + (size_t)(SW_VR + h * HD + eb * 16 + c) * SWPP + tc0 + 32 + 8 * rq);
            }
#pragma unroll
            for (int eb = 0; eb < 8; ++eb) { const int e0 = h * HD + eb * 16 + rq * 4; g4[eb] = ld_f4(F.ret_g + l * 1024 + e0);
#pragma unroll
                for (int qb = 0; qb < 2; ++qb) gwq[qb][eb] = ld_u2(TOK + (size_t)(tq0 + qb * 16 + c) * TOKP + TK_GR + e0); }
        }
    }
#pragma unroll
    for (int qb = 0; qb < 2; ++qb) {
        const int t = tq0 + qb * 16 + c;
        float ss = 0.f;
#pragma unroll
        for (int eb = 0; eb < 8; ++eb) ss += (acc[qb][eb][0] * acc[qb][eb][0] + acc[qb][eb][1] * acc[qb][eb][1]) + (acc[qb][eb][2] * acc[qb][eb][2] + acc[qb][eb][3] * acc[qb][eb][3]);
        const float rstd = frsq(rq_sum(ss) * (1.f / HD) + EPS);
#pragma unroll
        for (int eb = 0; eb < 8; ++eb) {
            const int e0 = h * HD + eb * 16 + rq * 4;
            const f32x4 gg = g4[eb]; const u32x2 gw = gwq[qb][eb];
            u32x2 o; o.x = pk2(acc[qb][eb][0] * rstd * gg[0] * bf_lo(gw.x), acc[qb][eb][1] * rstd * gg[1] * bf_hi(gw.x));
            o.y = pk2(acc[qb][eb][2] * rstd * gg[2] * bf_lo(gw.y), acc[qb][eb][3] * rstd * gg[3] * bf_hi(gw.y));
            st_u2(MIX + (size_t)t * D + 1024 + e0, o);
        }
    }
}

__device__ __constant__ unsigned char kCandAB[64] = {0, 1, 2, 3, 4, 5, 6, 7, 8, 9, 10, 11, 12, 13, 14, 15, 16, 17, 18, 19, 20, 21, 22, 23, 32, 33, 34, 35, 36, 48, 49, 50, 51, 64, 65, 66, 80, 81, 96, 97,
                                                   112, 113, 128, 144, 160, 176, 192, 208, 224, 240, 0, 0, 0, 0, 0, 0, 0, 0, 0, 0, 0, 0, 0, 0};
template <unsigned MASK> __device__ __forceinline__ float embed_idx(float x, unsigned idx) {
    const unsigned u = __builtin_bit_cast(unsigned, x); const unsigned low = (u >> 31) ? idx : (MASK - idx);
    return __builtin_bit_cast(float, (u & ~MASK) | low);
}
template <unsigned MASK> __device__ __forceinline__ unsigned decode_idx(float y) {
    const unsigned u = __builtin_bit_cast(unsigned, y); const unsigned low = u & MASK; return (u >> 31) ? low : (MASK - low);
}
template <int N> __device__ __forceinline__ void sortdesc(float (&v)[N]) {
#pragma unroll
    for (int k = 2; k <= N; k <<= 1)
#pragma unroll
        for (int j = k >> 1; j > 0; j >>= 1)
#pragma unroll
            for (int i = 0; i < N; ++i) { const int p = i ^ j;
                if (p > i) { const bool desc = ((i & k) == 0); const float a = v[i], b = v[p], hi = fmaxf(a, b), lo = fminf(a, b); v[i] = desc ? hi : lo; v[p] = desc ? lo : hi; } }
}
__device__ __forceinline__ void merge16(float (&v)[16]) {
#pragma unroll
    for (int j = 8; j > 0; j >>= 1)
#pragma unroll
        for (int i = 0; i < 16; ++i) { const int p = i ^ j; if (p > i) { const float a = v[i], b = v[p]; v[i] = fmaxf(a, b); v[p] = fminf(a, b); } }
}
__device__ __forceinline__ void top16_of_group(float (&a)[16]) {
#pragma unroll
    for (int sh = 16; sh <= 32; sh <<= 1) {
        float cc[16];
#pragma unroll
        for (int i = 0; i < 16; ++i) cc[i] = fmaxf(a[i], __shfl_xor(a[15 - i], sh));
        merge16(cc);
#pragma unroll
        for (int i = 0; i < 16; ++i) a[i] = cc[i];
    }
}
constexpr int TL_STRIDE = 17, TL_WAVE_FLOATS = 2 * 16 * TL_STRIDE;
constexpr int KL_PITCH = 272, KL_BYTES = 2 * 128 * KL_PITCH;
static_assert(KL_BYTES + NWAVES * TL_WAVE_FLOATS * 4 <= RING_BYTES, "top-k LDS map");
__device__ __forceinline__ void topk_task(const Frame& F, int l, int tb, int h, const LAS unsigned char* kl, LAS float* tl, const LAS unsigned char* cab) {
    int lane = lane_id(); asm volatile("" : "+v"(lane));
    const int c = lane & 15, rq = lane >> 4;
    const int t0 = tb * 16;
    const bf16* QP = (const bf16*)(F.ws + WS_QP);
    int* EXPI = (int*)(F.ws + WS_EXP); float* GATE = (float*)(F.ws + WS_GATE);
    const float NEG = -__builtin_inff();
    bf16x8 Qall[2][4];
#pragma unroll
    for (int p = 0; p < 2; ++p)
#pragma unroll
        for (int ks = 0; ks < 4; ++ks) Qall[p][ks] = ld_b8(QP + (size_t)(t0 + c) * QPP + h * 256 + p * 128 + ks * 32 + rq * 8);
    float rsp[8];
    { const float* SS2 = (const float*)(F.ws + WS_SS2) + (t0 + c);
#pragma unroll
        for (int i = 0; i < 8; ++i) rsp[i] = *(const GAS float*)(SS2 + (size_t)(rq * 8 + i) * T); }
#pragma unroll
    for (int p = 0; p < 2; ++p) {
        bf16x8 Qf[4];
#pragma unroll
        for (int ks = 0; ks < 4; ++ks) Qf[ks] = Qall[p][ks];
        float v[32];
        const LAS unsigned char* kbase = kl + (p * 128 + c) * KL_PITCH + rq * 16;
#pragma unroll
        for (int kb = 0; kb < 8; ++kb) {
            f32x4 a = (f32x4){0.f, 0.f, 0.f, 0.f};
#pragma unroll
            for (int ks = 0; ks < 4; ++ks) a = mfma16(*(const LAS bf16x8*)(kbase + kb * 16 * KL_PITCH + ks * 64), Qf[ks], a);
#pragma unroll
            for (int e = 0; e < 4; ++e) v[kb * 4 + e] = embed_idx<127u>(a[e], (unsigned)(kb * 16 + rq * 4 + e));
        }
        sortdesc<32>(v);
        float top[16];
#pragma unroll
        for (int i = 0; i < 16; ++i) top[i] = v[i];
        top16_of_group(top);
        if (rq == 0) {
#pragma unroll
            for (int it = 0; it < 16; ++it) tl[(p * 16 + c) * TL_STRIDE + it] = top[it];
        }
    }
    LDS_WAIT(); asm volatile("" ::: "memory");
    const LAS float* t0l = tl + (0 * 16 + c) * TL_STRIDE; const LAS float* t1l = tl + (16 + c) * TL_STRIDE;
    float res[16];
#pragma unroll
    for (int j = 0; j < 16; ++j) {
        const int cid = j * 4 + rq; const unsigned ab = cab[cid < 50 ? cid : 0];
        const float sum = t0l[ab >> 4] + t1l[ab & 15];
        res[j] = (j < 13 && cid < 50) ? embed_idx<63u>(sum, (unsigned)cid) : NEG;
    }
    sortdesc<16>(res);
    top16_of_group(res);
    float rs2 = 0.f;
#pragma unroll
    for (int i = 0; i < 8; ++i) rs2 += rsp[i];
    const float lsc = frsq(rq_sum(rs2) * (1.f / D) + EPS) * LOG2E;
    float den = 0.f;
#pragma unroll
    for (int it = 0; it < 16; ++it) den += fexp2((res[it] - res[0]) * lsc);
    const float rden = 1.0f / den;
#pragma unroll
    for (int it = 0; it < 16; ++it) {
        if ((it >> 2) == rq) {
            const unsigned cid = decode_idx<63u>(res[it]); const unsigned ab = cab[cid];
            const unsigned i1 = decode_idx<127u>(t0l[ab >> 4]), i2 = decode_idx<127u>(t1l[ab & 15]);
            const size_t o = (size_t)(t0 + c) * 128 + h * 16 + it;
            *(GAS int*)(EXPI + o) = (int)(i1 * 128u + i2);
            *(GAS float*)(GATE + o) = fexp2((res[it] - res[0]) * lsc) * rden;
        }
    }
    LDS_WAIT(); asm volatile("" ::: "memory");
}

__device__ __forceinline__ float reduce16(const float (&p)[16], int lane) {
    const bool b5 = lane & 32, b4 = lane & 16, b3 = lane & 8, b2 = lane & 4;
    float q[8], r4[4], s2[2];
#pragma unroll
    for (int k = 0; k < 8; ++k) { const float send = b5 ? p[k] : p[k + 8], keep = b5 ? p[k + 8] : p[k]; q[k] = keep + __shfl_xor(send, 32); }
#pragma unroll
    for (int k = 0; k < 4; ++k) { const float send = b4 ? q[k] : q[k + 4], keep = b4 ? q[k + 4] : q[k]; r4[k] = keep + __shfl_xor(send, 16); }
#pragma unroll
    for (int k = 0; k < 2; ++k) { const float send = b3 ? r4[k] : r4[k + 2], keep = b3 ? r4[k + 2] : r4[k]; s2[k] = keep + __shfl_xor(send, 8); }
    const float send = b2 ? s2[0] : s2[1], keep = b2 ? s2[1] : s2[0];
    float v = keep + __shfl_xor(send, 4);
    v += __shfl_xor(v, 1); v += __shfl_xor(v, 2);
    return v;
}
struct RowBuf { u32x4 r[8]; };
__device__ __forceinline__ void rows_load(RowBuf& B, const unsigned char* tab, int ids, int lane_base, int lane) {
#pragma unroll
    for (int r = 0; r < 8; ++r) {
        const int e = __builtin_amdgcn_readlane(ids, lane_base + r);
        B.r[r] = ld_u4(tab + (size_t)e * (D / 2) + lane * 16);
    }
}
__device__ __forceinline__ float dot8f4(unsigned w, const float* hv) {
    const f32x2 a = __builtin_amdgcn_cvt_scalef32_pk_f32_fp4(w, 1.0f, 0), b = __builtin_amdgcn_cvt_scalef32_pk_f32_fp4(w, 1.0f, 1),
                c = __builtin_amdgcn_cvt_scalef32_pk_f32_fp4(w, 1.0f, 2), d = __builtin_amdgcn_cvt_scalef32_pk_f32_fp4(w, 1.0f, 3);
    return ((a[0] * hv[0] + a[1] * hv[1]) + (b[0] * hv[2] + b[1] * hv[3])) + ((c[0] * hv[4] + c[1] * hv[5]) + (d[0] * hv[6] + d[1] * hv[7]));
}
__device__ __forceinline__ float dot32(const u32x4 w, const float* hv) { return (dot8f4(w.x, hv) + dot8f4(w.y, hv + 8)) + (dot8f4(w.z, hv + 16) + dot8f4(w.w, hv + 24)); }
__device__ __forceinline__ void axpy8f4(unsigned w, float s, float* o) {
    const f32x2 a = __builtin_amdgcn_cvt_scalef32_pk_f32_fp4(w, 1.0f, 0), b = __builtin_amdgcn_cvt_scalef32_pk_f32_fp4(w, 1.0f, 1),
                c = __builtin_amdgcn_cvt_scalef32_pk_f32_fp4(w, 1.0f, 2), d = __builtin_amdgcn_cvt_scalef32_pk_f32_fp4(w, 1.0f, 3);
    o[0] += s * a[0]; o[1] += s * a[1]; o[2] += s * b[0]; o[3] += s * b[1]; o[4] += s * c[0]; o[5] += s * c[1]; o[6] += s * d[0]; o[7] += s * d[1];
}
__device__ __forceinline__ void axpy32(const u32x4 w, float s, float* o) { axpy8f4(w.x, s, o); axpy8f4(w.y, s, o + 8); axpy8f4(w.z, s, o + 16); axpy8f4(w.w, s, o + 24); }
constexpr size_t XSL_BYTES = (size_t)NEXP * 128;
constexpr int XW_S = 0, XW_SQ = 8192, XW_RS = 10240, XW_B = 10304, XW_ID = 10816, XW_BYTES = 13312;
constexpr int XZ_OFF = NWAVES * XW_BYTES, XZ_BYTES = 512;
constexpr int XG_OFF = XZ_OFF + XZ_BYTES;
typedef int i32x8 __attribute__((ext_vector_type(8)));
struct URows { u32x4 r[16]; };
__device__ __forceinline__ f32x4 reduce32to4(const float (&p)[32], int lane) {
    const bool b5 = (lane & 32) != 0, b4 = (lane & 16) != 0, b3 = (lane & 8) != 0;
    float q[16], r8[8]; f32x4 o;
#pragma unroll
    for (int k = 0; k < 16; ++k) { const float send = b5 ? p[k] : p[k + 16], keep = b5 ? p[k + 16] : p[k]; q[k] = keep + __shfl_xor(send, 32); }
#pragma unroll
    for (int k = 0; k < 8; ++k) { const float send = b4 ? q[k] : q[k + 8], keep = b4 ? q[k + 8] : q[k]; r8[k] = keep + __shfl_xor(send, 16); }
#pragma unroll
    for (int k = 0; k < 4; ++k) { const float send = b3 ? r8[k] : r8[k + 4], keep = b3 ? r8[k + 4] : r8[k]; o[k] = keep + __shfl_xor(send, 8); }
    return o;
}
#define XFENCE() asm volatile("" ::: "memory")
__device__ __forceinline__ u32x4 ldo_u4(const void* base, unsigned off) { return *(const GAS u32x4*)((const GAS unsigned char*)base + off); }
__device__ __forceinline__ u32x2 ldo_u2(const void* base, unsigned off) { return *(const GAS u32x2*)((const GAS unsigned char*)base + off); }
__device__ __forceinline__ void sto_u2(void* base, unsigned off, u32x2 v) { *(GAS u32x2*)((GAS unsigned char*)base + off) = v; }
__device__ __forceinline__ void sto_f4(void* base, unsigned off, f32x4 v) { *(GAS f32x4*)((GAS unsigned char*)base + off) = v; }
__device__ __forceinline__ void expert_phase(const Frame& F, int l, int xcc, LAS unsigned char* wl, const LAS unsigned char* zb) {
    int lane = lane_id(); asm volatile("" : "+v"(lane));
    const int c = lane & 15, rq = lane >> 4, rr = lane >> 3, pc = lane & 7;
    LAS float* SA = (LAS float*)(wl + XW_S); LAS float* SQ = (LAS float*)(wl + XW_SQ); LAS float* RS = (LAS float*)(wl + XW_RS); LAS unsigned char* BI = wl + XW_B; LAS unsigned char* IDL = wl + XW_ID;
    const unsigned char* UBl = (const unsigned char*)(F.ws + WS_UB) + (size_t)l * NEXP * (D / 2); const unsigned char* VBl = (const unsigned char*)(F.ws + WS_VB) + (size_t)l * NEXP * (D / 2);
    const unsigned* SUV = (const unsigned*)(F.ws + WS_SU) + (size_t)l * NEXP;
    const bf16* X1 = (const bf16*)(F.ws + WS_H2); bf16* XR = (bf16*)(F.ws + WS_XR);
    const int* EXPI = (const int*)(F.ws + WS_EXP); const float* GATE = (const float*)(F.ws + WS_GATE);
    const LAS float* G2 = (const LAS float*)(zb + XZ_BYTES);
    for (int tb = F.gw; tb < T; tb += 8 * F.ngw) {
        auto tok = [&](int k) { const int t = tb + k * F.ngw; return t < T ? t : tb; };
        auto slice_of = [&](int i) { return ((i >> 3) + xcc) & 7; };
        {
            float zf = 0.f; asm volatile("" : "+v"(zf)); const f32x4 z = (f32x4){zf, zf, zf, zf};
#pragma unroll
            for (int i = 0; i < 8; ++i) *(LAS f32x4*)(SA + (i * 64 + lane) * 4) = z;
#pragma unroll
            for (int i = 0; i < 2; ++i) *(LAS f32x4*)(SQ + (i * 64 + lane) * 4) = z;
#pragma unroll
            for (int k = 0; k < 8; ++k) { const u32x2 e2 = ldo_u2(EXPI + (size_t)tok(k) * 128, 8u * lane); *(LAS unsigned*)(IDL + k * 256 + lane * 4) = e2.x | (e2.y << 16); }
            const float* SS2 = (const float*)(F.ws + WS_SS2);
            float ss[8];
#pragma unroll
            for (int k = 0; k < 8; ++k) ss[k] = *(const GAS float*)(SS2 + (size_t)(lane & 31) * T + tok(k));
#pragma unroll
            for (int k = 0; k < 8; ++k) { const float tot = wave_sum(ss[k]) * 0.5f; if (lane == 0) RS[k] = frsq(tot * (1.f / D) + EPS); }
            LDS_WAIT(); XFENCE();
        }
#ifndef U_REP
#define U_REP 1
#endif
#ifndef V_REP
#define V_REP 1
#endif
        for (int urep = 0; urep < U_REP; ++urep) {
            if (urep) { float zf = 0.f; asm volatile("" : "+v"(zf)); const f32x4 z = (f32x4){zf, zf, zf, zf};
#pragma unroll
                for (int i = 0; i < 8; ++i) *(LAS f32x4*)(SA + (i * 64 + lane) * 4) = z;
                LDS_WAIT(); XFENCE(); }
            const LAS unsigned char* bbase = c < 2 ? BI + c * 128 + rq * 32 : zb;
            LAS unsigned char* bw = BI + (lane >> 5) * 256 + (((lane & 31) >> 2) & 3) * 32 + ((lane & 31) >> 4) * 16 + (lane & 3) * 4;
            auto u_x = [&](int i) { return ldo_u2(X1 + (size_t)tok(i & 7) * D + slice_of(i) * 256, 8u * lane); };
            struct HRows { u32x4 r[8]; };
            auto u_rows_h = [&](int hs, HRows& H) {
                const int i = hs >> 1, mg = hs & 1;
                const unsigned char* Usl = UBl + (size_t)slice_of(i) * XSL_BYTES;
                const u32x2 id = *(const LAS u32x2*)(IDL + (i & 7) * 256 + c * 16 + mg * 8);
#ifdef U_PROBE_MASK
                const unsigned pm = (U_REP > 1 && urep == 0) ? (unsigned)(U_PROBE_MASK) : 0xffffu;
#else
                const unsigned pm = 0xffffu;
#endif
                const unsigned i0 = id.x, i1 = id.y;
#pragma unroll
                for (int mm = 0; mm < 4; ++mm) { const unsigned w = mm < 2 ? i0 : i1; const unsigned e = (mm & 1) ? (w >> 16) : (w & 0xffffu); const unsigned off = (e & pm) * 128u + 16u * rq;
                    H.r[2 * mm] = ldo_u4(Usl, off); H.r[2 * mm + 1] = ldo_u4(Usl + 64, off); }
            };
            i32x8 B0, B1;
            auto u_bbuild = [&](int i, const u32x2& xw) {
                const int k = i & 7;
                const f32x4 gg = *(const LAS f32x4*)(G2 + slice_of(i) * 256 + 4 * lane);
                const float rstd = RS[k];
                const float h0 = bf_lo(xw.x) * rstd * gg[0], h1 = bf_hi(xw.x) * rstd * gg[1], h2 = bf_lo(xw.y) * rstd * gg[2], h3 = bf_hi(xw.y) * rstd * gg[3];
                int w = __builtin_amdgcn_cvt_pk_fp8_f32(h0, h1, 0, false); w = __builtin_amdgcn_cvt_pk_fp8_f32(h2, h3, w, true);
                const f32x2 b0 = __builtin_amdgcn_cvt_pk_f32_fp8(w, false), b1 = __builtin_amdgcn_cvt_pk_f32_fp8(w, true);
                int v = __builtin_amdgcn_cvt_pk_fp8_f32(h0 - b0[0], h1 - b0[1], 0, false); v = __builtin_amdgcn_cvt_pk_fp8_f32(h2 - b1[0], h3 - b1[1], v, true);
                *(LAS int*)(bw) = w; *(LAS int*)(bw + 128) = v;
                LDS_WAIT(); XFENCE();
                const u32x4 b0l = *(const LAS u32x4*)(bbase), b0h = *(const LAS u32x4*)(bbase + 16), b1l = *(const LAS u32x4*)(bbase + 256), b1h = *(const LAS u32x4*)(bbase + 272);
                B0 = (i32x8){(int)b0l.x, (int)b0l.y, (int)b0l.z, (int)b0l.w, (int)b0h.x, (int)b0h.y, (int)b0h.z, (int)b0h.w};
                B1 = (i32x8){(int)b1l.x, (int)b1l.y, (int)b1l.z, (int)b1l.w, (int)b1h.x, (int)b1h.y, (int)b1h.z, (int)b1h.w};
            };
            auto u_comp_h = [&](int hs, HRows& H) {
                const int k = (hs >> 1) & 7, mg = hs & 1;
                LAS f32x4* tp = (LAS f32x4*)(SA + k * 256 + (c & 1) * 16 + 4 * rq) + mg * 32;
                f32x4 acc[4];
#pragma unroll
                for (int mm = 0; mm < 4; ++mm) acc[mm] = (f32x4){0.f, 0.f, 0.f, 0.f};
                if (c < 2) {
#pragma unroll
                    for (int mm = 0; mm < 4; ++mm) acc[mm] = tp[mm * 8];
                }
#pragma unroll
                for (int mm = 0; mm < 4; ++mm) {
                    const i32x8 a0 = {(int)H.r[2 * mm].x, (int)H.r[2 * mm].y, (int)H.r[2 * mm].z, (int)H.r[2 * mm].w, 0, 0, 0, 0};
                    const i32x8 a1 = {(int)H.r[2 * mm + 1].x, (int)H.r[2 * mm + 1].y, (int)H.r[2 * mm + 1].z, (int)H.r[2 * mm + 1].w, 0, 0, 0, 0};
                    acc[mm] = __builtin_amdgcn_mfma_scale_f32_16x16x128_f8f6f4(a0, B0, acc[mm], 4, 0, 0, 0x7F7F7F7F, 0, 0x7F7F7F7F);
                    acc[mm] = __builtin_amdgcn_mfma_scale_f32_16x16x128_f8f6f4(a1, B1, acc[mm], 4, 0, 0, 0x7F7F7F7F, 0, 0x7F7F7F7F);
                }
                if (c < 2) {
#pragma unroll
                    for (int mm = 0; mm < 4; ++mm) tp[mm * 8] = acc[mm];
                }
            };
            HRows H0, H1, H2, H3;
            u32x2 xe, xo;
            xe = u_x(0);
            u_rows_h(0, H0); u_rows_h(1, H1); u_rows_h(2, H2);
            xo = u_x(1);
            XFENCE();
#pragma unroll 1
            for (int hs = 0; hs < 128; hs += 4) {
                const int i = hs >> 1;
                const int h3 = hs + 3, h4 = hs + 4 < 128 ? hs + 4 : 127, h5 = hs + 5 < 128 ? hs + 5 : 127, h6 = hs + 6 < 128 ? hs + 6 : 127;
                u_rows_h(h3, H3);
                XFENCE();
                u_bbuild(i, xe); u_comp_h(hs, H0);
                XFENCE();
                u_rows_h(h4, H0); xe = u_x(i + 2 < 64 ? i + 2 : 63);
                XFENCE();
                u_comp_h(hs + 1, H1);
                XFENCE();
                u_rows_h(h5, H1);
                XFENCE();
                u_bbuild(i + 1, xo); u_comp_h(hs + 2, H2);
                XFENCE();
                u_rows_h(h6, H2); xo = u_x(i + 3 < 64 ? i + 3 : 63);
                XFENCE();
                u_comp_h(hs + 3, H3);
                XFENCE();
            }
        }
        LDS_WAIT(); XFENCE();
        {
            unsigned suvq[8][2]; float gtq[8][2];
#pragma unroll
            for (int k = 0; k < 8; ++k)
#pragma unroll
                for (int hf = 0; hf < 2; ++hf) { const unsigned e = *(const LAS unsigned short*)(IDL + k * 256 + (hf * 64 + lane) * 2);
                    suvq[k][hf] = *(const GAS unsigned*)(SUV + e); gtq[k][hf] = *(const GAS float*)(GATE + (size_t)tok(k) * 128 + hf * 64 + lane); }
#pragma unroll
            for (int k = 0; k < 8; ++k) {
                float wq[2];
#pragma unroll
                for (int hf = 0; hf < 2; ++hf) {
                    const unsigned suv = suvq[k][hf];
                    const int kk = hf * 64 + lane;
                    const float a = (SA[k * 256 + (kk & 7) * 32 + (kk >> 3)] + SA[k * 256 + (kk & 7) * 32 + 16 + (kk >> 3)]) * bf_lo(suv);
                    wq[hf] = gtq[k][hf] * bf_hi(suv) * 0.5f * a * (1.0f + erff(a * 0.7071067811865476f));
                }
                XFENCE();
                float wm = fmaxf(__builtin_fabsf(wq[0]), __builtin_fabsf(wq[1]));
#pragma unroll
                for (int o = 1; o < 64; o <<= 1) wm = fmaxf(wm, __shfl_xor(wm, o));
                const float sc = __builtin_bit_cast(float, __builtin_bit_cast(unsigned, fminf(42.0f / fmaxf(wm, 1e-30f), 1.0e18f)) & 0x7f800000u);
                const unsigned h0 = (unsigned)__builtin_bit_cast(unsigned short, (_Float16)(wq[0] * sc)), h1 = (unsigned)__builtin_bit_cast(unsigned short, (_Float16)(wq[1] * sc));
                ((LAS unsigned*)SA)[k * 256 + lane] = h0 | (h0 << 16); ((LAS unsigned*)SA)[k * 256 + 64 + lane] = h1 | (h1 << 16);
                if (lane == 0) RS[8 + k] = 1.0f / sc;
            }
        }
        LDS_WAIT(); XFENCE();
        for (int vrep = 0; vrep < V_REP; ++vrep) {
            if (vrep) { float zf = 0.f; asm volatile("" : "+v"(zf)); const f32x4 z = (f32x4){zf, zf, zf, zf};
#pragma unroll
                for (int i = 0; i < 2; ++i) *(LAS f32x4*)(SQ + (i * 64 + lane) * 4) = z;
                LDS_WAIT(); XFENCE(); }
            auto v_rows = [&](int i, URows& R) {
                const unsigned char* Vsl = VBl + (size_t)slice_of(i) * XSL_BYTES;
                const u32x4 ia = *(const LAS u32x4*)(IDL + (i & 7) * 256 + rr * 32), ib = *(const LAS u32x4*)(IDL + (i & 7) * 256 + rr * 32 + 16);
#pragma unroll
                for (int j = 0; j < 16; ++j) { const unsigned w = j < 8 ? ia[(j >> 1) & 3] : ib[(j >> 1) & 3]; const unsigned e = (j & 1) ? (w >> 16) : (w & 0xffffu);
                    R.r[j] = ldo_u4(Vsl, e * 128u + 16u * pc); }
            };
            auto v_comp = [&](int i, const URows& R) {
                const int k = i & 7, t = tok(k), sl = slice_of(i);
                const unsigned col = 32u * pc + 4u * rr;
                u32x2 xw;
                typedef _Float16 hf2 __attribute__((ext_vector_type(2)));
                const LAS u32x4* wp = (const LAS u32x4*)(SA + k * 256 + 16 * rr);
                const u32x4 wall[4] = {wp[0], wp[1], wp[2], wp[3]};
                unsigned out[16];
#pragma unroll
                for (int j = 0; j < 16; ++j) out[j] = 0u;
#pragma unroll
                for (int j = 0; j < 16; ++j) {
                    if (j == 8) xw = ldo_u2(X1 + (size_t)t * D + sl * 256, 2u * col);
                    u32x4 rj = R.r[j];
                    asm volatile("" : "+v"(rj.x), "+v"(rj.y), "+v"(rj.z), "+v"(rj.w) :: "memory");
                    const unsigned wj = wall[j >> 2][j & 3]; const hf2 w2 = __builtin_bit_cast(hf2, wj);
#pragma unroll
                    for (int d = 0; d < 4; ++d) {
                        const hf2 a = __builtin_amdgcn_cvt_scalef32_pk_f16_fp4(rj[d], 1.0f, 0), b = __builtin_amdgcn_cvt_scalef32_pk_f16_fp4(rj[d], 1.0f, 1),
                                  cc = __builtin_amdgcn_cvt_scalef32_pk_f16_fp4(rj[d], 1.0f, 2), dd = __builtin_amdgcn_cvt_scalef32_pk_f16_fp4(rj[d], 1.0f, 3);
                        out[4 * d] = __builtin_bit_cast(unsigned, __builtin_elementwise_fma(a, w2, __builtin_bit_cast(hf2, out[4 * d])));
                        out[4 * d + 1] = __builtin_bit_cast(unsigned, __builtin_elementwise_fma(b, w2, __builtin_bit_cast(hf2, out[4 * d + 1])));
                        out[4 * d + 2] = __builtin_bit_cast(unsigned, __builtin_elementwise_fma(cc, w2, __builtin_bit_cast(hf2, out[4 * d + 2])));
                        out[4 * d + 3] = __builtin_bit_cast(unsigned, __builtin_elementwise_fma(dd, w2, __builtin_bit_cast(hf2, out[4 * d + 3])));
                    }
                    if ((j & 3) == 3) asm volatile("" : "+v"(out[0]), "+v"(out[1]), "+v"(out[2]), "+v"(out[3]), "+v"(out[4]), "+v"(out[5]), "+v"(out[6]), "+v"(out[7]), "+v"(out[8]), "+v"(out[9]), "+v"(out[10]), "+v"(out[11]), "+v"(out[12]), "+v"(out[13]), "+v"(out[14]), "+v"(out[15]) :: "memory");
                }
                unsigned o2[2];
                {
                    const bool b5 = (lane & 32) != 0, b4 = (lane & 16) != 0, b3 = (lane & 8) != 0;
                    unsigned q8[8], q4[4];
                    auto hadd = [](unsigned x, unsigned y) { return __builtin_bit_cast(unsigned, __builtin_bit_cast(hf2, x) + __builtin_bit_cast(hf2, y)); };
#pragma unroll
                    for (int n = 0; n < 8; ++n) { const unsigned send = b5 ? out[n] : out[n + 8], keep = b5 ? out[n + 8] : out[n]; q8[n] = hadd(keep, (unsigned)__shfl_xor((int)send, 32)); }
#pragma unroll
                    for (int n = 0; n < 4; ++n) { const unsigned send = b4 ? q8[n] : q8[n + 4], keep = b4 ? q8[n + 4] : q8[n]; q4[n] = hadd(keep, (unsigned)__shfl_xor((int)send, 16)); }
#pragma unroll
                    for (int n = 0; n < 2; ++n) { const unsigned send = b3 ? q4[n] : q4[n + 2], keep = b3 ? q4[n + 2] : q4[n]; o2[n] = hadd(keep, (unsigned)__shfl_xor((int)send, 8)); }
                }
                const float isc = RS[8 + k];
                const hf2 oa = __builtin_bit_cast(hf2, o2[0]), ob = __builtin_bit_cast(hf2, o2[1]);
                const float y0 = bf_lo(xw.x) + (float)oa[0] * isc, y1 = bf_hi(xw.x) + (float)oa[1] * isc, y2 = bf_lo(xw.y) + (float)ob[0] * isc, y3 = bf_hi(xw.y) + (float)ob[1] * isc;
                if (l + 1 < DEPTH) {
                    u32x2 w; w.x = pk2(y0, y1); w.y = pk2(y2, y3);
                    sto_u2(XR + (size_t)t * D + sl * 256, 2u * col, w);
                    const float s = (y0 * y0 + y1 * y1) + (y2 * y2 + y3 * y3);
                    (void)__hip_atomic_fetch_add(SQ + k * 64 + lane, s, __ATOMIC_RELAXED, __HIP_MEMORY_SCOPE_WAVEFRONT);
                } else sto_f4(F.out + (size_t)t * D + sl * 256, 4u * col, (f32x4){y0, y1, y2, y3});
            };
            URows RA, RB;
            v_rows(0, RA);
            XFENCE();
#pragma unroll 1
            for (int i = 0; i < 64; i += 2) {
                const int i2 = i + 2 < 64 ? i + 2 : 63;
                v_rows(i + 1, RB);
                XFENCE();
                v_comp(i, RA);
                XFENCE();
                v_rows(i2, RA);
                XFENCE();
                v_comp(i + 1, RB);
                XFENCE();
            }
        }
        if (l + 1 < DEPTH) {
            float* RSTD = (float*)(F.ws + WS_RSTD);
#pragma unroll
            for (int k = 0; k < 8; ++k) { const float r1 = frsq(wave_sum(SQ[k * 64 + lane]) * (1.f / D) + EPS); if (lane == 0) *(GAS float*)(RSTD + tok(k)) = r1; }
        }
        LDS_WAIT(); XFENCE();
    }
}

#ifndef PG8_SP2
#define PG8_SP2 true
#endif
#ifndef PG8_ALIGN
#define PG8_ALIGN true
#endif
struct Args { const float* in[14]; float* out; unsigned char* ws; int ph_lo, ph_hi, use_bar, pad; };
__global__ void __launch_bounds__(NWAVES * 64, 2) hybrid_fwd(Args args) {
    extern __shared__ __attribute__((aligned(16))) unsigned char lds_raw[];
    Frame F;
    F.lds = (LAS unsigned char*)lds_raw;
    F.wave = __builtin_amdgcn_readfirstlane((int)threadIdx.x >> 6);
    F.G = gridDim.x; F.gw = blockIdx.x * NWAVES + F.wave; F.ngw = F.G * NWAVES;
    F.x = args.in[0]; F.norm1_g = args.in[1]; F.w_in = args.in[2]; F.qa_g = args.in[3]; F.ka_g = args.in[4]; F.rel_bias = args.in[5]; F.attn_g = args.in[6]; F.ret_g = args.in[7];
    F.w_out = args.in[8]; F.norm2_g = args.in[9]; F.peer_wq = args.in[10]; F.peer_keys = args.in[11]; F.peer_u = args.in[12]; F.peer_v = args.in[13];
    F.out = args.out; F.ws = args.ws;
    for (int u = threadIdx.x; u < (LDS_BYTES - LDSCTL_OFF) / 4; u += NWAVES * 64) ((LAS unsigned*)(F.lds + LDSCTL_OFF))[u] = 0u;
    __syncthreads();
    unsigned* barw = (unsigned*)(args.ws + WS_CTL) + CW_BAR;
    XcdBarrier bar; bar.bar = barw; bar.x = 0; bar.st = nullptr;
    if (args.use_bar) bar = xcd_barrier_post(barw, (volatile LAS unsigned*)(F.lds + MISC_OFF) + 8);
    const int lo = args.ph_lo, hi = args.ph_hi;
#define IN(k) (lo <= (k) && (k) < hi)
#define SEAM(k) do { if (IN((k) + 1)) xcd_barrier(bar, F.wave); } while (0)

#ifndef REP_MASK
#define REP_MASK 0
#endif
#ifndef REP_N
#define REP_N 1
#endif
#define REPS(k) (((REP_MASK >> (k)) & 1) ? REP_N : 1)
#ifndef ONLY
#define PH_ON(k) 1
#else
#define PH_ON(k) ((k)==ONLY)
#endif
    if (PH_ON(0) && IN(0)) { for (int rep = 0; rep < REPS(0); ++rep) p0_prologue(F); SEAM(0); }

    for (int l = 0; l < DEPTH; ++l) {
        const int pb = 1 + l * PH_PER_LAYER;
        if (PH_ON(1) && IN(pb + 0)) for (int rep = 0; rep < REPS(1); ++rep) {
            {
                pg8::Gemm g{(const pg8::bf16_t*)(F.ws + WS_XR), (const pg8::bf16_t*)(F.ws + WS_WTOK) + (size_t)l * TOKC * D, T, TOKC, D};
                pg8::StaticOrder So; So.init(T, TOKC, F.G, (int)blockIdx.x);
                pg8::EpiTok E{(pg8::bf16_t*)(F.ws + WS_TOK), (const pg8::f32x2*)(F.ws + WS_ROPE_TOK), (float*)(F.ws + WS_SSQ), (const float*)(F.ws + WS_RSTD)};
                pg8::gemm_phase<pg8::EpiTok, pg8::StaticOrder, PG8_ALIGN, PG8_SP2>(F.lds + RING_OFF, g, So, E, F.wave);
            }
            {
                pg8::Gemm g{(const pg8::bf16_t*)(F.ws + WS_WSWP) + (size_t)l * SWPR * D, (const pg8::bf16_t*)(F.ws + WS_XR), SWPR, T, D};
                pg8::StaticOrder So; So.init(SWPR, T, F.G, (int)blockIdx.x);
                pg8::EpiSwp E{(pg8::bf16_t*)(F.ws + WS_SWP), SWPP, (const float*)(F.ws + WS_RSTD)};
                pg8::gemm_phase<pg8::EpiSwp, pg8::StaticOrder, PG8_ALIGN, PG8_SP2>(F.lds + RING_OFF, g, So, E, F.wave);
            }
            SEAM(pb + 0);
        }
        if (PH_ON(2) && IN(pb + 1)) for (int rep = 0; rep < REPS(2); ++rep) {
            LAS float* biasL = (LAS float*)(F.lds + RING_OFF + A_BIAS);
            int tid2 = F.wave * 64 + lane_id(); asm volatile("" : "+v"(tid2));
            for (int i = tid2; i < NH * 257; i += NWAVES * 64) biasL[i] = *(const GAS float*)(F.rel_bias + (size_t)l * NH * 257 + i) * LOG2E;
#ifndef SCAN_REP
#define SCAN_REP 1
#endif
            for (int srep = 0; srep < SCAN_REP; ++srep)
            for (int task = F.gw; task < NBATCH * NH * 8 * 2; task += F.ngw) scan_task(F, task);
            {
                constexpr int NAT = NBATCH * NH * 8;
                const int g = (int)blockIdx.x;
                if (F.G == 256) {
                    const int n = g < 128 ? 1 : 3, first = g < 128 ? g : 128 + (g - 128) * 3;
                    for (int i = 0; i < n; ++i) attn_wg_task(F, l, first + i);
                } else {
                    for (int task = g; task < NAT; task += F.G) attn_wg_task(F, l, task);
                }
            }
            SEAM(pb + 1);
        }
        if (PH_ON(3) && IN(pb + 2)) for (int rep = 0; rep < REPS(3); ++rep) {
            for (int task = F.gw; task < NBATCH * NH * NCH * 2; task += F.ngw) ret_task(F, l, task);
            SEAM(pb + 2);
        }
        if (PH_ON(4) && IN(pb + 3)) for (int rep = 0; rep < REPS(4); ++rep) {
            pg8::Gemm g{(const pg8::bf16_t*)(F.ws + WS_MIX), (const pg8::bf16_t*)(F.ws + WS_WOUT) + (size_t)l * D * D, T, D, D};
            pg8::StaticOrder So; So.init(T, D, F.G, (int)blockIdx.x);
            pg8::EpiRes E{l == 0 ? F.x : (const float*)nullptr, (const pg8::bf16_t*)(F.ws + WS_XR), (pg8::bf16_t*)(F.ws + WS_H2), (float*)(F.ws + WS_SS2)};
            pg8::gemm_phase<pg8::EpiRes, pg8::StaticOrder, PG8_ALIGN, PG8_SP2>(F.lds + RING_OFF, g, So, E, F.wave);
            SEAM(pb + 3);
        }
        if (PH_ON(6) && IN(pb + 5)) for (int rep = 0; rep < REPS(6); ++rep) {
            pg8::Gemm g{(const pg8::bf16_t*)(F.ws + WS_H2), (const pg8::bf16_t*)(F.ws + WS_WQ) + (size_t)l * D * D, T, D, D};
            pg8::StaticOrder So; So.init(T, D, F.G, (int)blockIdx.x);
            pg8::EpiB16 E{(pg8::bf16_t*)(F.ws + WS_QP), QPP};
            pg8::gemm_phase<pg8::EpiB16, pg8::StaticOrder, PG8_ALIGN, PG8_SP2>(F.lds + RING_OFF, g, So, E, F.wave);
            SEAM(pb + 5);
        }
        if (PH_ON(7) && IN(pb + 6)) for (int rep = 0; rep < REPS(7); ++rep) {
            LAS unsigned char* kl = F.lds + RING_OFF; LAS float* tl = (LAS float*)(F.lds + RING_OFF + KL_BYTES) + F.wave * TL_WAVE_FLOATS;
            int tid3 = F.wave * 64 + lane_id(); asm volatile("" : "+v"(tid3));
            LAS unsigned char* cab = F.lds + RING_OFF + KL_BYTES + NWAVES * TL_WAVE_FLOATS * 4;
            if (tid3 < 64) cab[tid3] = kCandAB[tid3];
            const bf16* KEYS = (const bf16*)(F.ws + WS_KEYS) + (size_t)l * 8 * 256 * 128;
            for (int wt = blockIdx.x; wt < 256; wt += F.G) {
                const int tg = wt >> 1, hg = wt & 1;
                for (int hi = 0; hi < 4; ++hi) {
                    const int h = hg * 4 + hi;
                    __syncthreads();
#pragma unroll
                    for (int i = 0; i < 8; ++i) { const int idx = tid3 + 512 * i, row = idx >> 4, c16 = idx & 15;
                        *(LAS u32x4*)(kl + row * KL_PITCH + c16 * 16) = ld_u4(KEYS + ((size_t)h * 256 + row) * 128 + c16 * 8); }
                    __syncthreads();
                    topk_task(F, l, tg * 8 + F.wave, h, kl, tl, cab);
                }
            }
            SEAM(pb + 6);
        }
        if (PH_ON(8) && IN(pb + 7)) for (int rep = 0; rep < REPS(8); ++rep) {
            LAS unsigned char* wl = F.lds + RING_OFF + F.wave * XW_BYTES; const LAS unsigned char* zb = F.lds + RING_OFF + XZ_OFF;
            { int tid4 = F.wave * 64 + lane_id(); asm volatile("" : "+v"(tid4)); for (int i = tid4; i < XZ_BYTES / 4; i += NWAVES * 64) ((LAS unsigned*)zb)[i] = 0u;
              for (int i = tid4; i < D; i += NWAVES * 64) ((LAS float*)(F.lds + RING_OFF + XG_OFF))[i] = *(const GAS float*)(F.norm2_g + l * D + i); }
            __syncthreads();
            expert_phase(F, l, (int)xb_xcc_id(), wl, zb);
            SEAM(pb + 7);
        }
    }
#undef IN
#undef SEAM
}

extern "C" void kernel_launch(void* const* d_in, const int* in_sizes, int n_in, void* d_out, int out_size, void* d_ws, size_t ws_size, hipStream_t stream) {
    static int grid = 0;
    if (grid == 0) {
        if (n_in != 14 || in_sizes[0] != T * D || out_size != T * D || ws_size < WS_END) {
            fprintf(stderr, "kernel_launch: unexpected problem (n_in %d, in0 %d, out %d, ws %zu; need ws >= %zu); nothing launched\n", n_in, n_in > 0 ? in_sizes[0] : -1, out_size, ws_size, (size_t)WS_END); grid = -1; return; }
        int dev = 0, cus = 0, per_cu = 0;
        if (hipGetDevice(&dev) != hipSuccess || hipDeviceGetAttribute(&cus, hipDeviceAttributeMultiprocessorCount, dev) != hipSuccess) { fprintf(stderr, "kernel_launch: device query failed\n"); grid = -1; return; }
        if (hipFuncSetAttribute((const void*)hybrid_fwd, hipFuncAttributeMaxDynamicSharedMemorySize, LDS_BYTES) != hipSuccess) { fprintf(stderr, "kernel_launch: hipFuncSetAttribute failed\n"); grid = -1; return; }
        if (hipOccupancyMaxActiveBlocksPerMultiprocessor(&per_cu, (const void*)hybrid_fwd, NWAVES * 64, LDS_BYTES) != hipSuccess || per_cu < 1)
            fprintf(stderr, "kernel_launch: note: occupancy query reports %d workgroups per CU\n", per_cu);
        (void)hipGetLastError();
        grid = cus;
    }
    if (grid < 0) return;
    if (hipMemsetAsync((char*)d_ws + WS_CTL, 0, CTL_ZERO_BYTES, stream) != hipSuccess) { fprintf(stderr, "kernel_launch: memset failed\n"); return; }
    Args a{};
    for (int i = 0; i < 14; ++i) a.in[i] = (const float*)d_in[i];
    a.out = (float*)d_out; a.ws = (unsigned char*)d_ws; a.pad = 0;
#if MK_ONE_LAUNCH
    a.ph_lo = 0; a.ph_hi = N_PHASES; a.use_bar = 1;
    hipLaunchKernelGGL(hybrid_fwd, dim3(grid), dim3(NWAVES * 64), LDS_BYTES, stream, a);
    { const hipError_t le = hipPeekAtLastError(); if (le != hipSuccess) fprintf(stderr, "kernel_launch: launch failed: %s\n", hipGetErrorName(le)); }
#else
    for (int p = 0; p < N_PHASES; ++p) {
        a.ph_lo = p; a.ph_hi = p + 1; a.use_bar = 0;
        hipLaunchKernelGGL(hybrid_fwd, dim3(grid), dim3(NWAVES * 64), LDS_BYTES, stream, a);
        const hipError_t le = hipPeekAtLastError(); if (le != hipSuccess) { fprintf(stderr, "kernel_launch: launch %d failed: %s\n", p, hipGetErrorName(le)); break; }
    }
#endif
}
```
